# Optimizing an MI355X kernel written in HIP

```python
import math
import jax
import jax.numpy as jnp
from jax import lax
import numpy as np

D_MODEL = 2048
BATCH = 2
SEQ = 8192
DEPTH = 2

GRID_W = 64
CTX_LEN = 256
N_EVEN = (DEPTH + 1) // 2
N_ODD = DEPTH // 2
MIX_WIDTH = D_MODEL
GROUP_WIDTH = MIX_WIDTH // 2
EPS = 1e-6
F32 = jnp.float32

GLA_HEADS = 4
GLA_DK = GROUP_WIDTH // (2 * GLA_HEADS)
GLA_DV = GROUP_WIDTH // GLA_HEADS
GLA_LOWRANK = 16
GLA_GATE_NORMALIZER = 16.0
GLA_CHUNK = 64

HY_CH = GROUP_WIDTH
HY_ORDER = 2
HY_BANDS = 16
HY_EMB = 1 + 2 * HY_BANDS
HY_FFN = 64
HY_SHIFT = 0.05
HY_MIN_DECAY = math.log(1e-2) / 1.5
HY_MAX_DECAY = math.log(1e-2) / 0.3

RET_HEADS = 4
RET_DK = GROUP_WIDTH // (2 * RET_HEADS)
RET_DV = GROUP_WIDTH // RET_HEADS
RET_CHUNK = 64

ATT_HD = 128
ATT_HEADS = GROUP_WIDTH // ATT_HD
ATT_KV_HEADS = 2
ATT_GROUP = ATT_HEADS // ATT_KV_HEADS
ATT_WINDOW = 128
ATT_BLOCK = 128
ROPE_BASE = 10000.0

N_EXPERTS = 16
N_GROUPS = 4
EXPERTS_PER_GROUP = N_EXPERTS // N_GROUPS
TOP_K = 2
D_FF_EXPERT = D_MODEL // 2

EVEN_SPLITS = (GLA_HEADS * GLA_DK, GLA_HEADS * GLA_DK, GLA_HEADS * GLA_DV, GLA_HEADS * GLA_DV,
               2 * GLA_LOWRANK, (HY_ORDER + 1) * HY_CH)
EVEN_COLS = sum(EVEN_SPLITS)
ODD_SPLITS = (RET_HEADS * RET_DK, RET_HEADS * RET_DK, RET_HEADS * RET_DV, RET_HEADS * RET_DV,
              ATT_HEADS * ATT_HD, ATT_KV_HEADS * ATT_HD, ATT_KV_HEADS * ATT_HD)
ODD_COLS = sum(ODD_SPLITS)

kernel_name = "hybrid_gla_hyena_retention_swa_moe_dit_block"


def rms_norm(x, gain):
    xf = x.astype(F32)
    y = xf * lax.rsqrt(jnp.mean(xf * xf, axis=-1, keepdims=True) + EPS)
    return (y * gain.astype(F32)).astype(x.dtype)


def split_cols(z, sizes):
    offs = np.cumsum([0] + list(sizes))
    return [z[..., int(offs[i]):int(offs[i + 1])] for i in range(len(sizes))]


def to_heads(t, n_heads):
    b, l, _ = t.shape
    return t.reshape(b, l, n_heads, -1).transpose(0, 2, 1, 3)


def from_heads(t):
    b, h, l, d = t.shape
    return t.transpose(0, 2, 1, 3).reshape(b, l, h * d)


def flip(t):
    return t[:, :, ::-1]


def rope(x, pos, inv_freq):
    half = x.shape[-1] // 2
    ang = pos.astype(F32)[:, None] * inv_freq[None, :]
    cos = jnp.cos(ang)[None, :, None, :]
    sin = jnp.sin(ang)[None, :, None, :]
    xf = x.astype(F32)
    x1, x2 = xf[..., :half], xf[..., half:]
    return jnp.concatenate([x1 * cos - x2 * sin, x2 * cos + x1 * sin], axis=-1).astype(x.dtype)


def axial_rope(x):
    L = x.shape[1]
    rows = L // GRID_W
    row = jnp.repeat(jnp.arange(rows), GRID_W)
    col = jnp.tile(jnp.arange(GRID_W), rows)
    h = x.shape[-1] // 2
    quarter = h // 2
    inv = ROPE_BASE ** (-jnp.arange(quarter, dtype=F32) / quarter)
    return jnp.concatenate([rope(x[..., :h], row, inv), rope(x[..., h:], col, inv)], axis=-1)


def decayed_state(k, v, log_a):
    cum = jnp.cumsum(log_a.astype(F32), axis=2)
    w = jnp.exp(cum[:, :, -1:] - cum)
    return jnp.einsum('bhld,bhle->bhde', k.astype(F32) * w, v.astype(F32))


def gla_chunked(q, k, v, log_a, s0):
    b, h, L, dk = q.shape
    dv = v.shape[-1]
    n = L // GLA_CHUNK

    def chunks(t):
        return jnp.moveaxis(t.astype(F32).reshape(b, h, n, GLA_CHUNK, t.shape[-1]), 2, 0)

    mask = jnp.tril(jnp.ones((GLA_CHUNK, GLA_CHUNK), dtype=bool))

    def step(S, inp):
        qc, kc, vc, ac = inp
        cum = jnp.cumsum(ac, axis=2)
        qe = qc * jnp.exp(cum)
        ke = kc * jnp.exp(-cum)
        att = jnp.where(mask, jnp.einsum('bhid,bhjd->bhij', qe, ke), 0.0)
        o = jnp.einsum('bhij,bhje->bhie', att, vc) + jnp.einsum('bhid,bhde->bhie', qe, S)
        last = cum[:, :, -1:, :]
        S = jnp.exp(last[:, :, 0, :])[..., None] * S + jnp.einsum('bhjd,bhje->bhde', kc * jnp.exp(last - cum), vc)
        return S, o

    S, o = lax.scan(step, s0, (chunks(q), chunks(k), chunks(v), chunks(log_a)))
    o = jnp.moveaxis(o, 0, 2).reshape(b, h, L, dv)
    return o.astype(v.dtype), S


def retention_chunked(q, k, v, log_g, s0):
    b, h, L, dk = q.shape
    dv = v.shape[-1]
    n = L // RET_CHUNK
    idx = jnp.arange(RET_CHUNK, dtype=F32)
    diff = idx[:, None] - idx[None, :]
    dmat = jnp.where(diff >= 0, jnp.exp(jnp.maximum(diff, 0.0)[None] * log_g[:, None, None]), 0.0)
    q_dec = jnp.exp((idx + 1.0)[None, :] * log_g[:, None])[..., None]
    k_dec = jnp.exp((RET_CHUNK - 1.0 - idx)[None, :] * log_g[:, None])[..., None]
    c_dec = jnp.exp(RET_CHUNK * log_g)[:, None, None]

    def chunks(t):
        return jnp.moveaxis(t.astype(F32).reshape(b, h, n, RET_CHUNK, t.shape[-1]), 2, 0)

    def step(S, inp):
        qc, kc, vc = inp
        att = jnp.einsum('bhid,bhjd->bhij', qc, kc) * dmat
        o = jnp.einsum('bhij,bhje->bhie', att, vc) + jnp.einsum('bhid,bhde->bhie', qc * q_dec, S)
        S = c_dec * S + jnp.einsum('bhjd,bhje->bhde', kc * k_dec, vc)
        return S, o

    S, o = lax.scan(step, s0, (chunks(q), chunks(k), chunks(v)))
    o = jnp.moveaxis(o, 0, 2).reshape(b, h, L, dv)
    return o.astype(v.dtype), S


def short_conv(u, w, bias):
    L = u.shape[1]
    up = jnp.pad(u, ((0, 0), (1, 1), (0, 0)))
    return up[:, :L] * w[0] + up[:, 1:L + 1] * w[1] + up[:, 2:] * w[2] + bias


def hyena_filters(L, w1, b1, w2, b2, w3):
    t = jnp.linspace(0.0, 1.0, L, dtype=F32)[:, None]
    w = (2.0 * math.pi / L) * jnp.arange(L, dtype=F32)[:, None]
    bands = jnp.linspace(1e-4, HY_BANDS - 1.0, HY_BANDS, dtype=F32)[None, :]
    feats = jnp.concatenate([t, jnp.cos(bands * w), -jnp.sin(bands * w)], axis=-1)
    hdn = jnp.sin(feats @ w1.astype(F32) + b1.astype(F32))
    hdn = jnp.sin(hdn @ w2.astype(F32) + b2.astype(F32))
    filt = (hdn @ w3.astype(F32)).reshape(L, HY_ORDER, 2, HY_CH)
    deltas = jnp.abs(jnp.linspace(HY_MIN_DECAY, HY_MAX_DECAY, HY_CH, dtype=F32))
    filt = filt * (jnp.exp(-t * deltas[None, :]) + HY_SHIFT)[:, None, None, :]
    kern = jnp.concatenate([filt[:, :, 0], jnp.zeros((1, HY_ORDER, HY_CH), F32), filt[:0:-1, :, 1]], axis=0)
    kern = kern / jnp.sum(jnp.abs(kern), axis=0, keepdims=True)
    return jnp.fft.rfft(kern, axis=0)


def fft_conv(u, kf, bias):
    L = u.shape[1]
    uf = jnp.fft.rfft(u.astype(F32), n=2 * L, axis=1)
    y = jnp.fft.irfft(uf * kf[None], n=2 * L, axis=1)[:, :L]
    return (y + u.astype(F32) * bias.astype(F32)).astype(u.dtype)


def context_attention(q, k, v, sink):
    b, lc = q.shape[:2]
    s = jnp.einsum('bqhgd,bkhd->bhgqk', q, k).astype(F32)
    sk = jnp.broadcast_to(sink.astype(F32)[None, :, :, None, None], s.shape[:-1] + (1,))
    p = jax.nn.softmax(jnp.concatenate([s, sk], axis=-1), axis=-1)[..., :-1]
    o = jnp.einsum('bhgqk,bkhd->bqhgd', p.astype(v.dtype), v)
    return o.reshape(b, lc, -1)


def window_attention(q, k, v, kc, vc, sink):
    b, L = q.shape[:2]
    W = ATT_BLOCK
    nb = L // W
    qb = q.reshape(b, nb, W, ATT_KV_HEADS, ATT_GROUP, ATT_HD)
    pad = ((0, 0), (W, W), (0, 0), (0, 0))
    kp = jnp.pad(k, pad).reshape(b, nb + 2, W, ATT_KV_HEADS, ATT_HD)
    vp = jnp.pad(v, pad).reshape(b, nb + 2, W, ATT_KV_HEADS, ATT_HD)
    kw = jnp.concatenate([kp[:, :-2], kp[:, 1:-1], kp[:, 2:]], axis=2)
    vw = jnp.concatenate([vp[:, :-2], vp[:, 1:-1], vp[:, 2:]], axis=2)
    s_win = jnp.einsum('bnqhgd,bnkhd->bhgnqk', qb, kw).astype(F32)
    s_ctx = jnp.einsum('bnqhgd,bkhd->bhgnqk', qb, kc).astype(F32)
    blk = jnp.arange(nb)[:, None, None] * W
    qpos = blk + jnp.arange(W)[None, :, None]
    kpos = blk - W + jnp.arange(3 * W)[None, None, :]
    valid = (jnp.abs(qpos - kpos) <= ATT_WINDOW) & (kpos >= 0) & (kpos < L)
    s_win = jnp.where(valid, s_win, -jnp.inf)
    sk = jnp.broadcast_to(sink.astype(F32)[None, :, :, None, None, None], s_win.shape[:-1] + (1,))
    p = jax.nn.softmax(jnp.concatenate([s_win, s_ctx, sk], axis=-1), axis=-1)
    n_ctx = kc.shape[1]
    p_win = p[..., :3 * W].astype(v.dtype)
    p_ctx = p[..., 3 * W:3 * W + n_ctx].astype(v.dtype)
    o = jnp.einsum('bhgnqk,bnkhd->bnqhgd', p_win, vw) + jnp.einsum('bhgnqk,bkhd->bnqhgd', p_ctx, vc)
    return o.reshape(b, L, -1)


def even_mixer(hc, hl, w_in, w_out, gla_w_gate, gla_b_gate, gla_norm, hy_conv_w, hy_conv_b,
               hy_w1, hy_b1, hy_w2, hy_b2, hy_w3, hy_bias, need_ctx):
    b = hl.shape[0]

    def prep(h):
        q, k, v, g, lr, u = split_cols(h @ w_in, EVEN_SPLITS)
        q = to_heads(q, GLA_HEADS) * (GLA_DK ** -0.5)
        k = to_heads(k, GLA_HEADS)
        v = to_heads(v, GLA_HEADS)
        la = [to_heads(jax.nn.log_sigmoid((lr[..., d * GLA_LOWRANK:(d + 1) * GLA_LOWRANK] @ gla_w_gate[d]
                                          + gla_b_gate[d]).astype(F32)) / GLA_GATE_NORMALIZER, GLA_HEADS)
              for d in range(2)]
        return q, k, v, g, la[0], la[1], u

    def gla_merge(o, g):
        return from_heads(rms_norm(o, gla_norm)) * jax.nn.silu(g)

    def hyena(u):
        L = u.shape[1]
        u = short_conv(u, hy_conv_w, hy_conv_b)
        z, *gates = split_cols(u, (HY_CH,) * (HY_ORDER + 1))
        kf = hyena_filters(L, hy_w1, hy_b1, hy_w2, hy_b2, hy_w3)
        for n, gate in enumerate(gates):
            z = gate * fft_conv(z, kf[:, n], hy_bias[n])
        return z

    cq, ck, cv, cg, ca_f, ca_b, cu = prep(hc)
    lq, lk, lv, lg, la_f, la_b, lu = prep(hl)
    s_zero = jnp.zeros((b, GLA_HEADS, GLA_DK, GLA_DV), F32)
    yc = None
    if need_ctx:
        oc_f, sc_f = gla_chunked(cq, ck, cv, ca_f, s_zero)
        oc_b, sc_b = gla_chunked(flip(cq), flip(ck), flip(cv), flip(ca_b), s_zero)
        yc = jnp.concatenate([gla_merge(oc_f + flip(oc_b), cg), hyena(cu)], axis=-1) @ w_out
    else:
        sc_f = decayed_state(ck, cv, ca_f)
        sc_b = decayed_state(flip(ck), flip(cv), flip(ca_b))
    ol_f, _ = gla_chunked(lq, lk, lv, la_f, sc_f)
    ol_b, _ = gla_chunked(flip(lq), flip(lk), flip(lv), flip(la_b), sc_b)
    yl = jnp.concatenate([gla_merge(ol_f + flip(ol_b), lg), hyena(lu)], axis=-1) @ w_out
    return yc, yl


def odd_mixer(hc, hl, w_in, w_out, ret_norm, att_q_norm, att_k_norm, att_sink, need_ctx):
    b = hl.shape[0]
    ret_inv = ROPE_BASE ** (-jnp.linspace(0.0, 1.0, RET_DK // 2, dtype=F32))
    log_g_f = jnp.log(1.0 - 2.0 ** (-5.0 - jnp.arange(RET_HEADS, dtype=F32)))
    log_g_b = log_g_f[::-1]
    sink = att_sink.reshape(ATT_KV_HEADS, ATT_GROUP)

    def prep(h, latent):
        z = h @ w_in
        L = z.shape[1]
        rq, rk, rv, rg, aq, ak, av = split_cols(z, ODD_SPLITS)
        rq = rq.reshape(b, L, RET_HEADS, RET_DK)
        rk = rk.reshape(b, L, RET_HEADS, RET_DK)
        aq = rms_norm(aq.reshape(b, L, ATT_HEADS, ATT_HD), att_q_norm)
        ak = rms_norm(ak.reshape(b, L, ATT_KV_HEADS, ATT_HD), att_k_norm)
        if latent:
            pos = jnp.arange(L)
            rq, rk = rope(rq, pos, ret_inv), rope(rk, pos, ret_inv)
            aq, ak = axial_rope(aq), axial_rope(ak)
        rq = rq.transpose(0, 2, 1, 3)
        rk = (rk * (RET_DK ** -0.5)).transpose(0, 2, 1, 3)
        rv = to_heads(rv, RET_HEADS)
        aq = (aq * (ATT_HD ** -0.5)).reshape(b, L, ATT_KV_HEADS, ATT_GROUP, ATT_HD)
        av = av.reshape(b, L, ATT_KV_HEADS, ATT_HD)
        return rq, rk, rv, rg, aq, ak, av

    def ret_merge(o, g):
        return from_heads(rms_norm(o, ret_norm)) * jax.nn.silu(g)

    cq, ck, cv, cg, caq, cak, cav = prep(hc, False)
    lq, lk, lv, lg, laq, lak, lav = prep(hl, True)
    s_zero = jnp.zeros((b, RET_HEADS, RET_DK, RET_DV), F32)
    yc = None
    if need_ctx:
        oc_f, sc_f = retention_chunked(cq, ck, cv, log_g_f, s_zero)
        oc_b, sc_b = retention_chunked(flip(cq), flip(ck), flip(cv), log_g_b, s_zero)
        yc = jnp.concatenate([ret_merge(oc_f + flip(oc_b), cg),
                              context_attention(caq, cak, cav, sink)], axis=-1) @ w_out
    else:
        lc = ck.shape[2]
        sc_f = decayed_state(ck, cv, jnp.broadcast_to(log_g_f[None, :, None, None], (1, RET_HEADS, lc, 1)))
        sc_b = decayed_state(flip(ck), flip(cv), jnp.broadcast_to(log_g_b[None, :, None, None], (1, RET_HEADS, lc, 1)))
    ol_f, _ = retention_chunked(lq, lk, lv, log_g_f, sc_f)
    ol_b, _ = retention_chunked(flip(lq), flip(lk), flip(lv), log_g_b, sc_b)
    yl = jnp.concatenate([ret_merge(ol_f + flip(ol_b), lg),
                          window_attention(laq, lak, lav, cak, cav, sink)], axis=-1) @ w_out
    return yc, yl


def moe(h, router_w, router_b, w1, w3, w2):
    n = h.shape[0]
    scores = jax.nn.softmax((h @ router_w).astype(F32), axis=-1)
    sel = scores + router_b.astype(F32)
    gscore = lax.top_k(sel.reshape(n, N_GROUPS, EXPERTS_PER_GROUP), TOP_K)[0].sum(-1)
    g_idx = jnp.argmax(gscore, axis=-1)
    in_group = (jnp.arange(N_EXPERTS) // EXPERTS_PER_GROUP)[None, :] == g_idx[:, None]
    _, e_idx = lax.top_k(jnp.where(in_group, sel, -jnp.inf), TOP_K)
    wts = jnp.take_along_axis(scores, e_idx, axis=-1)
    wts = wts / jnp.sum(wts, axis=-1, keepdims=True)
    comb = jnp.sum(jax.nn.one_hot(e_idx, N_EXPERTS, dtype=F32) * wts[..., None], axis=1).astype(h.dtype)
    out = jnp.zeros_like(h)
    for e in range(N_EXPERTS):
        y = (jax.nn.silu(h @ w1[e]) * (h @ w3[e])) @ w2[e]
        out = out + comb[:, e:e + 1] * y
    return out


def setup_inputs(seed: int = 0) -> dict:
    key = jax.random.key(seed)
    ks = iter(jax.random.split(key, 40))
    D = D_MODEL

    def nrm(shape, scale):
        return scale * jax.random.normal(next(ks), shape, F32)

    def gain(shape):
        return 1.0 + 0.02 * jax.random.normal(next(ks), shape, F32)

    return {
        "x": nrm((BATCH, SEQ, D), 1.0),
        "c": nrm((BATCH, D), 1.0),
        "ctx": nrm((BATCH, CTX_LEN, D), 1.0),
        "c_ctx": nrm((D,), 1.0),
        "ada_w": nrm((DEPTH, D, 6 * D), 0.5 * D ** -0.5),
        "ada_b": nrm((DEPTH, 6 * D), 0.01),
        "norm_mix": gain((DEPTH, D)),
        "norm_ffn": gain((DEPTH, D)),
        "ev_w_in": nrm((N_EVEN, D, EVEN_COLS), D ** -0.5),
        "ev_w_out": nrm((N_EVEN, MIX_WIDTH, D), MIX_WIDTH ** -0.5),
        "gla_w_gate": nrm((N_EVEN, 2, GLA_LOWRANK, GLA_HEADS * GLA_DK), GLA_LOWRANK ** -0.5),
        "gla_b_gate": nrm((N_EVEN, 2, GLA_HEADS * GLA_DK), 0.1),
        "gla_norm": gain((N_EVEN, GLA_DV)),
        "hy_conv_w": nrm((N_EVEN, 3, (HY_ORDER + 1) * HY_CH), 3 ** -0.5),
        "hy_conv_b": nrm((N_EVEN, (HY_ORDER + 1) * HY_CH), 0.01),
        "hy_w1": nrm((N_EVEN, HY_EMB, HY_FFN), 1.0),
        "hy_b1": nrm((N_EVEN, HY_FFN), 0.1),
        "hy_w2": nrm((N_EVEN, HY_FFN, HY_FFN), HY_FFN ** -0.5),
        "hy_b2": nrm((N_EVEN, HY_FFN), 0.1),
        "hy_w3": nrm((N_EVEN, HY_FFN, HY_ORDER * 2 * HY_CH), HY_FFN ** -0.5),
        "hy_bias": nrm((N_EVEN, HY_ORDER, HY_CH), 1.0),
        "od_w_in": nrm((N_ODD, D, ODD_COLS), D ** -0.5),
        "od_w_out": nrm((N_ODD, MIX_WIDTH, D), MIX_WIDTH ** -0.5),
        "ret_norm": gain((N_ODD, RET_DV)),
        "att_q_norm": gain((N_ODD, ATT_HD)),
        "att_k_norm": gain((N_ODD, ATT_HD)),
        "att_sink": nrm((N_ODD, ATT_HEADS), 0.5),
        "router_w": nrm((D, N_EXPERTS), D ** -0.5),
        "router_b": nrm((N_EXPERTS,), 0.01),
        "moe_w1": nrm((DEPTH, N_EXPERTS, D, D_FF_EXPERT), D ** -0.5),
        "moe_w3": nrm((DEPTH, N_EXPERTS, D, D_FF_EXPERT), D ** -0.5),
        "moe_w2": nrm((DEPTH, N_EXPERTS, D_FF_EXPERT, D), D_FF_EXPERT ** -0.5),
    }


def reference(x, c, ctx, c_ctx, ada_w, ada_b, norm_mix, norm_ffn, ev_w_in, ev_w_out, gla_w_gate,
              gla_b_gate, gla_norm, hy_conv_w, hy_conv_b, hy_w1, hy_b1, hy_w2, hy_b2, hy_w3, hy_bias,
              od_w_in, od_w_out, ret_norm, att_q_norm, att_k_norm, att_sink, router_w, router_b,
              moe_w1, moe_w3, moe_w2):
    xl, xc = x, ctx
    n_ctx = ctx.shape[1]
    for layer in range(DEPTH):
        last = layer == DEPTH - 1
        ml = (jax.nn.silu(c) @ ada_w[layer] + ada_b[layer])[:, None, :]
        mc = (jax.nn.silu(c_ctx) @ ada_w[layer] + ada_b[layer])[None, None, :]
        sh1, sc1, g1, sh2, sc2, g2 = jnp.split(ml, 6, axis=-1)
        csh1, csc1, cg1, csh2, csc2, cg2 = jnp.split(mc, 6, axis=-1)
        hl = rms_norm(xl, norm_mix[layer]) * (1.0 + sc1) + sh1
        hc = rms_norm(xc, norm_mix[layer]) * (1.0 + csc1) + csh1
        if layer % 2 == 0:
            i = layer // 2
            oc, ol = even_mixer(hc, hl, ev_w_in[i], ev_w_out[i], gla_w_gate[i], gla_b_gate[i], gla_norm[i],
                                hy_conv_w[i], hy_conv_b[i], hy_w1[i], hy_b1[i], hy_w2[i], hy_b2[i], hy_w3[i],
                                hy_bias[i], not last)
        else:
            i = layer // 2
            oc, ol = odd_mixer(hc, hl, od_w_in[i], od_w_out[i], ret_norm[i], att_q_norm[i], att_k_norm[i],
                               att_sink[i], not last)
        xl = xl + g1 * ol
        hl = rms_norm(xl, norm_ffn[layer]) * (1.0 + sc2) + sh2
        if not last:
            xc = xc + cg1 * oc
            hc = rms_norm(xc, norm_ffn[layer]) * (1.0 + csc2) + csh2
            h = jnp.concatenate([hc, hl], axis=1)
            y = moe(h.reshape(-1, D_MODEL), router_w, router_b, moe_w1[layer], moe_w3[layer],
                    moe_w2[layer]).reshape(h.shape)
            xc = xc + cg2 * y[:, :n_ctx]
            xl = xl + g2 * y[:, n_ctx:]
        else:
            y = moe(hl.reshape(-1, D_MODEL), router_w, router_b, moe_w1[layer], moe_w3[layer],
                    moe_w2[layer]).reshape(hl.shape)
            xl = xl + g2 * y
    return xl
```

```cpp
#include <hip/hip_runtime.h>
#include <cstdio>
#include <cstdint>
#include <cmath>

#ifndef MK_ONE_LAUNCH
#define MK_ONE_LAUNCH 0
#endif
namespace pg8 {
#define PG8_LAS __attribute__((address_space(3)))
typedef unsigned short bf16_t;
typedef short bf16x8 __attribute__((ext_vector_type(8)));
typedef float f32x4 __attribute__((ext_vector_type(4)));
typedef unsigned u32x4 __attribute__((ext_vector_type(4)));
constexpr int BM = 256, BK = 64, HALF = 128, HTB = HALF * BK * 2  , STAGE_BYTES = 8 * HTB, NXCD = 8, WGM = 8;

__host__ __device__ __forceinline__ int lds_byte(int r, int c) { const int st = (r >> 4) * 2 + (c >> 5), rr = r & 15, cc = c & 31, ob = rr * 64 + cc * 2; return st * 1024 + (ob ^ (((ob >> 9) & 1) << 5)); }
__host__ __device__ __forceinline__ void stage_rc(int b, int& R, int& C) { const int st = b / 1024, sb = b % 1024, swz = sb ^ (((sb >> 9) & 1) << 5); R = (st >> 1) * 16 + swz / 64; C = (st & 1) * 32 + (swz % 64) / 2; }
__host__ __device__ __forceinline__ int perm32(int rho) { const int n = rho >> 4, i = rho & 15; return 8 * (i >> 2) + 4 * n + (i & 3); }

struct Unit { int pm, pn; };
struct Gemm { const bf16_t* A; const bf16_t* Bt; int M, N, K; };

struct StaticOrder {
    int nM, nN, nwg, G, c;
    __host__ __device__ void init(int M, int N, int G_, int c_) { nM = M / BM; nN = N / BM; nwg = nM * nN; G = G_; c = c_; }
    __host__ __device__ bool next(int i, Unit& u) const {
        const long L = (long)i * G + c; if (L >= nwg) return false;
        int wgid = (int)L; { const int q = nwg / NXCD, r = nwg % NXCD, xcd = wgid % NXCD, off = wgid / NXCD; wgid = (xcd < r ? xcd * (q + 1) : r * (q + 1) + (xcd - r) * q) + off; }
        const int nig = WGM * nN, gid = wgid / nig, fm = gid * WGM, gsz = (nM - fm) < WGM ? (nM - fm) : WGM;
        u.pm = fm + ((wgid % nig) % gsz); u.pn = (wgid % nig) / gsz; return true;
    }
    __device__ __forceinline__ void a_ready(const Unit&) const {}
    __device__ __forceinline__ void done(const Unit&) const {}
};

__device__ __forceinline__ unsigned cvt_pk_bf16(float lo, float hi) { unsigned r; asm volatile("v_cvt_pk_bf16_f32 %0, %1, %2" : "=v"(r) : "v"(lo), "v"(hi)); return r; }
typedef float f32x2 __attribute__((ext_vector_type(2)));

template <class Epi, class Sched, bool ALIGN_EPI = false, bool SP2 = false>
__device__ __forceinline__ void gemm_phase(PG8_LAS unsigned char* lds, const Gemm g, const Sched& S, const Epi& E) {
    const int tid = threadIdx.x, wid = __builtin_amdgcn_readfirstlane(tid >> 6), lane = tid & 63, wr = wid >> 2, wc = wid & 3, fr = lane & 15, fq = lane >> 4;
    const int K = g.K, nt = K / BK;
    unsigned voffA[2], voffB[2];
#pragma unroll
    for (int i = 0; i < 2; ++i) { int R, C; stage_rc(tid * 16 + i * 8192, R, C); const int Rb = Epi::PERM ? ((R & ~31) + perm32(R & 31)) : R;
        voffA[i] = (unsigned)(R * K + C) * 2u; voffB[i] = (unsigned)(Rb * K + C) * 2u; }
    const size_t kstep = (size_t)(BK * 2);
    const size_t hstep = (size_t)HALF * K * 2;
    const size_t tstep = 2 * hstep;
    const unsigned ldsw = (unsigned)wid * 1024u;
    const int aoff = lds_byte(wr * 64 + fr, fq * 8), boff = lds_byte(wc * 32 + fr, fq * 8);
#define PG8_SA(b, h) (((b) * 2 + (h)) * HTB)
#define PG8_SB(b, h) ((4 + (b) * 2 + (h)) * HTB)
#define PG8_STAGE(bufoff, gbase, voff) do { _Pragma("unroll") for (int _i = 0; _i < 2; ++_i) \
        __builtin_amdgcn_global_load_lds((const unsigned*)((const char*)(gbase) + (voff)[_i]), (PG8_LAS unsigned*)(lds + (bufoff) + ldsw + _i * 8192), 16, 0, 0); } while (0)
#define PG8_LDA(dst, b, h) do { _Pragma("unroll") for (int m = 0; m < 4; ++m) _Pragma("unroll") for (int k = 0; k < 2; ++k) dst[m][k] = *(const PG8_LAS bf16x8*)(lds + PG8_SA(b, h) + aoff + m * 2048 + k * 1024); } while (0)
#define PG8_LDB(dst, b, h) do { _Pragma("unroll") for (int n = 0; n < 2; ++n) _Pragma("unroll") for (int k = 0; k < 2; ++k) dst[n][k] = *(const PG8_LAS bf16x8*)(lds + PG8_SB(b, h) + boff + n * 2048 + k * 1024); } while (0)
#define PG8_MMA(ai, bj, At, Bt) do { __builtin_amdgcn_s_setprio(1); _Pragma("unroll") for (int m = 0; m < 4; ++m) _Pragma("unroll") for (int n = 0; n < 2; ++n) _Pragma("unroll") for (int k = 0; k < 2; ++k) \
        acc[ai][bj][m][n] = __builtin_amdgcn_mfma_f32_16x16x32_bf16(Bt[n][k], At[m][k], acc[ai][bj][m][n], 0, 0, 0); __builtin_amdgcn_s_setprio(0); } while (0)
#define PG8_WAIT_V(n) asm volatile("s_waitcnt vmcnt(" #n ")" ::: "memory")
#define PG8_WAIT_L(n) asm volatile("s_waitcnt lgkmcnt(" #n ")" ::: "memory")
#define PG8_BAR __builtin_amdgcn_s_barrier()
#define PG8_SCHED __builtin_amdgcn_sched_barrier(0)
    Unit cur, nxt; int ui = 0;
    if (!S.next(0, cur)) return;
    f32x4 acc[2][2][4][2];
#pragma unroll
    for (int a = 0; a < 2; ++a)
#pragma unroll
        for (int b = 0; b < 2; ++b)
#pragma unroll
            for (int m = 0; m < 4; ++m)
#pragma unroll
                for (int n = 0; n < 2; ++n) acc[a][b][m][n] = (f32x4){0.f, 0.f, 0.f, 0.f};
    bf16x8 At[4][2], B0[2][2], B1[2][2];
    const char* cA = (const char*)g.A + (size_t)cur.pm * tstep; const char* cB = (const char*)g.Bt + (size_t)cur.pn * tstep;
    S.a_ready(cur);
    if constexpr (SP2) {
        PG8_STAGE(PG8_SB(0, 0), cB, voffB); PG8_STAGE(PG8_SB(0, 1), cB + hstep, voffB); PG8_STAGE(PG8_SA(0, 0), cA, voffA); PG8_STAGE(PG8_SA(0, 1), cA + hstep, voffA);
        if (wr == 1) PG8_BAR;
        PG8_WAIT_V(2); PG8_BAR;
        PG8_STAGE(PG8_SB(1, 0), cB + kstep, voffB); PG8_STAGE(PG8_SA(1, 0), cA + kstep, voffA); PG8_STAGE(PG8_SB(1, 1), cB + hstep + kstep, voffB);
        PG8_WAIT_V(6); PG8_BAR;
    } else {
        PG8_STAGE(PG8_SB(0, 0), cB, voffB); PG8_STAGE(PG8_SA(0, 0), cA, voffA); PG8_STAGE(PG8_SB(0, 1), cB + hstep, voffB); PG8_STAGE(PG8_SA(0, 1), cA + hstep, voffA);
        if (wr == 1) PG8_BAR;
        PG8_WAIT_V(4); PG8_BAR;
        PG8_STAGE(PG8_SB(1, 0), cB + kstep, voffB); PG8_STAGE(PG8_SA(1, 0), cA + kstep, voffA); PG8_STAGE(PG8_SB(1, 1), cB + hstep + kstep, voffB);
        PG8_WAIT_V(6); PG8_BAR;
    }
    for (;;) {
        const bool has_next = S.next(ui + 1, nxt);
        const char* nA = has_next ? (const char*)g.A + (size_t)nxt.pm * tstep : cA; const char* nB = has_next ? (const char*)g.Bt + (size_t)nxt.pn * tstep : cB;
        for (int t = 0; t < nt; t += 2) {
            const bool last = (t == nt - 2);
            const char* a1 = cA + (size_t)(t + 1) * kstep;
            const char* a2 = last ? nA : cA + (size_t)(t + 2) * kstep; const char* b2 = last ? nB : cB + (size_t)(t + 2) * kstep;
            const char* a3 = a2 + kstep; const char* b3 = b2 + kstep;
            if (last && has_next) S.a_ready(nxt);
            if constexpr (SP2) {
            PG8_LDB(B0, 0, 0); PG8_LDB(B1, 0, 1); PG8_SCHED; PG8_LDA(At, 0, 0); PG8_STAGE(PG8_SA(1, 1), a1 + hstep, voffA);
            PG8_WAIT_V(8); PG8_WAIT_L(0); PG8_BAR; PG8_MMA(0, 0, At, B0); PG8_MMA(0, 1, At, B1); PG8_BAR; PG8_SCHED;
            PG8_LDA(At, 0, 1); PG8_STAGE(PG8_SB(0, 0), b2, voffB); PG8_STAGE(PG8_SB(0, 1), b2 + hstep, voffB); PG8_STAGE(PG8_SA(0, 0), a2, voffA);
            PG8_WAIT_V(8); PG8_WAIT_L(0); PG8_BAR; PG8_MMA(1, 0, At, B0); PG8_MMA(1, 1, At, B1); PG8_BAR; PG8_SCHED;
            PG8_LDB(B0, 1, 0); PG8_LDB(B1, 1, 1); PG8_SCHED; PG8_LDA(At, 1, 0); PG8_STAGE(PG8_SA(0, 1), a2 + hstep, voffA);
            PG8_WAIT_V(8); PG8_WAIT_L(0); PG8_BAR; PG8_MMA(0, 0, At, B0); PG8_MMA(0, 1, At, B1); PG8_BAR; PG8_SCHED;
            PG8_LDA(At, 1, 1); PG8_STAGE(PG8_SB(1, 0), b3, voffB); PG8_STAGE(PG8_SB(1, 1), b3 + hstep, voffB); PG8_STAGE(PG8_SA(1, 0), a3, voffA);
            PG8_WAIT_V(8); PG8_WAIT_L(0); PG8_BAR; PG8_MMA(1, 0, At, B0); PG8_MMA(1, 1, At, B1); PG8_BAR; PG8_SCHED;
            } else {
            PG8_LDB(B0, 0, 0); PG8_SCHED; PG8_LDA(At, 0, 0); PG8_STAGE(PG8_SA(1, 1), a1 + hstep, voffA);
            PG8_WAIT_L(8); PG8_BAR; PG8_WAIT_L(0); PG8_MMA(0, 0, At, B0); PG8_BAR; PG8_SCHED;
            PG8_LDB(B1, 0, 1); PG8_STAGE(PG8_SB(0, 0), b2, voffB);
            PG8_BAR; PG8_WAIT_L(0); PG8_MMA(0, 1, At, B1); PG8_BAR;
            PG8_LDA(At, 0, 1); PG8_STAGE(PG8_SA(0, 0), a2, voffA);
            PG8_BAR; PG8_WAIT_L(0); PG8_MMA(1, 0, At, B0); PG8_BAR; PG8_SCHED;
            PG8_STAGE(PG8_SB(0, 1), b2 + hstep, voffB);
            PG8_WAIT_V(6); PG8_BAR; PG8_MMA(1, 1, At, B1); PG8_BAR;
            PG8_LDB(B0, 1, 0); PG8_SCHED; PG8_LDA(At, 1, 0); PG8_STAGE(PG8_SA(0, 1), a2 + hstep, voffA);
            PG8_WAIT_L(8); PG8_BAR; PG8_WAIT_L(0); PG8_MMA(0, 0, At, B0); PG8_BAR; PG8_SCHED;
            PG8_LDB(B1, 1, 1); PG8_STAGE(PG8_SB(1, 0), b3, voffB);
            PG8_BAR; PG8_WAIT_L(0); PG8_MMA(0, 1, At, B1); PG8_BAR;
            PG8_LDA(At, 1, 1); PG8_STAGE(PG8_SA(1, 0), a3, voffA);
            PG8_BAR; PG8_WAIT_L(0); PG8_MMA(1, 0, At, B0); PG8_BAR; PG8_SCHED;
            PG8_STAGE(PG8_SB(1, 1), b3 + hstep, voffB);
            PG8_WAIT_V(6); PG8_BAR; PG8_MMA(1, 1, At, B1); PG8_BAR;
            }
        }
        if constexpr (ALIGN_EPI) { if (wr == 0) PG8_BAR; }
        if constexpr (!Epi::AFTER_DRAIN) { E(acc, cur, wr, wc, fr, fq); S.done(cur); }
        if (!has_next) break;
#pragma unroll
        for (int a = 0; a < 2; ++a)
#pragma unroll
            for (int b = 0; b < 2; ++b)
#pragma unroll
                for (int m = 0; m < 4; ++m)
#pragma unroll
                    for (int n = 0; n < 2; ++n) acc[a][b][m][n] = (f32x4){0.f, 0.f, 0.f, 0.f};
        cur = nxt; cA = nA; cB = nB; ++ui;
        if constexpr (ALIGN_EPI) { if (wr == 1) PG8_BAR; }
    }
    PG8_WAIT_V(0);
    if constexpr (!ALIGN_EPI) { if (wr == 0) PG8_BAR; }
    PG8_BAR;
    if constexpr (Epi::AFTER_DRAIN) { E.fused(acc, cur, wr, wc, fr, fq, lds, wid, lane); S.done(cur); }
#undef PG8_SA
#undef PG8_SB
#undef PG8_STAGE
#undef PG8_LDA
#undef PG8_LDB
#undef PG8_MMA
#undef PG8_WAIT_V
#undef PG8_WAIT_L
#undef PG8_BAR
#undef PG8_SCHED
}
}
namespace pg8 {
struct EpiStore {
    static constexpr bool PERM = true, AFTER_DRAIN = false;
    bf16_t* O; int ldo; int pn_mask; int nz; float* LR;
    __device__ __forceinline__ void operator()(const f32x4 (&acc)[2][2][4][2], const Unit& u, int wr, int wc, int fr, int fq) const {
        const int row0 = u.pm * BM + wr * 64 + fr; const int ct = u.pn & pn_mask;
        if (ct < nz) {
            const int col0 = ct * BM + wc * 32 + 8 * fq;
#pragma unroll
            for (int ai = 0; ai < 2; ++ai)
#pragma unroll
                for (int m = 0; m < 4; ++m) { bf16_t* rowp = O + (size_t)(row0 + ai * HALF + m * 16) * ldo + col0;
#pragma unroll
                    for (int bj = 0; bj < 2; ++bj) { const f32x4 v0 = acc[ai][bj][m][0], v1 = acc[ai][bj][m][1];
                        u32x4 w; w.x = cvt_pk_bf16(v0[0], v0[1]); w.y = cvt_pk_bf16(v0[2], v0[3]); w.z = cvt_pk_bf16(v1[0], v1[1]); w.w = cvt_pk_bf16(v1[2], v1[3]);
                        *(u32x4*)(rowp + bj * HALF) = w; } }
        } else if (wc == 0) {
#pragma unroll
            for (int ai = 0; ai < 2; ++ai)
#pragma unroll
                for (int m = 0; m < 4; ++m) { float* rp = LR + (size_t)(row0 + ai * HALF + m * 16) * 32 + 8 * fq;
                    *(f32x4*)rp = acc[ai][0][m][0]; *(f32x4*)(rp + 4) = acc[ai][0][m][1]; }
        }
    }
};
struct EpiOut {
    static constexpr bool PERM = false, AFTER_DRAIN = false;
    float* X; int row_off; const float* gbase;
    __device__ __forceinline__ void operator()(const f32x4 (&acc)[2][2][4][2], const Unit& u, int wr, int wc, int fr, int fq) const {
        const int rt = row_off + u.pm * BM; const int cls = rt < 512 ? 2 : (rt < 512 + 8192 ? 0 : 1); const float* gate = gbase + cls * 12288;
        const int row0 = rt + wr * 64 + fr, col0 = u.pn * BM + wc * 32 + 4 * fq;
        f32x4 gv[2][2];
#pragma unroll
        for (int bj = 0; bj < 2; ++bj)
#pragma unroll
            for (int n = 0; n < 2; ++n) gv[bj][n] = *(const f32x4*)(gate + col0 + bj * HALF + n * 16);
#pragma unroll
        for (int ai = 0; ai < 2; ++ai)
#pragma unroll
            for (int m = 0; m < 4; ++m) { float* rowp = X + (size_t)(row0 + ai * HALF + m * 16) * 2048 + col0;
#pragma unroll
                for (int bj = 0; bj < 2; ++bj)
#pragma unroll
                    for (int n = 0; n < 2; ++n) { f32x4* p = (f32x4*)(rowp + bj * HALF + n * 16); const f32x4 o = *p + gv[bj][n] * acc[ai][bj][m][n]; *p = o; }
                asm volatile("" ::: "memory"); }
    }
};
struct EpiMoe1 {
    static constexpr bool PERM = true, AFTER_DRAIN = false;
    bf16_t* ACT;
    __device__ __forceinline__ void operator()(const f32x4 (&acc)[2][2][4][2], const Unit& u, int wr, int wc, int fr, int fq) const {
        const int row0 = u.pm * BM + wr * 64 + fr, col0 = (u.pn & 7) * HALF + wc * 32 + 8 * fq;
#pragma unroll
        for (int ai = 0; ai < 2; ++ai)
#pragma unroll
            for (int m = 0; m < 4; ++m) { float a[8];
#pragma unroll
                for (int n = 0; n < 2; ++n)
#pragma unroll
                    for (int j = 0; j < 4; ++j) { const float g = acc[ai][0][m][n][j], uu = acc[ai][1][m][n][j]; a[n * 4 + j] = g * __builtin_amdgcn_rcpf(1.0f + __expf(-g)) * uu; }
                u32x4 w; w.x = cvt_pk_bf16(a[0], a[1]); w.y = cvt_pk_bf16(a[2], a[3]); w.z = cvt_pk_bf16(a[4], a[5]); w.w = cvt_pk_bf16(a[6], a[7]);
                *(u32x4*)(ACT + (size_t)(row0 + ai * HALF + m * 16) * 1024 + col0) = w; }
    }
};
struct MoeOrder {
    int G, c, ntiles; const PG8_LAS int* toff;
    __device__ __forceinline__ bool next(int i, Unit& u) const {
        const int L = i * G + c; if (L >= ntiles * 8) return false;
        const int pm = L >> 3; int e = 0;
#pragma unroll
        for (int k = 1; k < 16; ++k) e += (pm >= toff[k]) ? 1 : 0;
        u.pm = pm; u.pn = e * 8 + (L & 7); return true;
    }
    __device__ __forceinline__ void a_ready(const Unit&) const {}
    __device__ __forceinline__ void done(const Unit&) const {}
};
}
#define GAS __attribute__((address_space(1)))
#define LAS __attribute__((address_space(3)))
typedef unsigned short bf16;
typedef unsigned v4u __attribute__((ext_vector_type(4)));
typedef float f32x4 __attribute__((ext_vector_type(4)));
typedef short bf16x8 __attribute__((ext_vector_type(8)));
typedef GAS unsigned gu32;
typedef GAS unsigned long long gu64;
#define RLX_AGENT __ATOMIC_RELAXED, __HIP_MEMORY_SCOPE_AGENT
#define LDS_WAIT() asm volatile("s_waitcnt lgkmcnt(0)" ::: "memory")
#define VM_WAIT() asm volatile("s_waitcnt vmcnt(0)" ::: "memory")
__device__ __forceinline__ unsigned long long rt() { return __builtin_amdgcn_s_memrealtime(); }
__device__ __forceinline__ unsigned f2bf(float f) { unsigned u = __builtin_bit_cast(unsigned, f); return (u + 0x7fffu + ((u >> 16) & 1u)) >> 16; }
__device__ __forceinline__ unsigned pk2(float lo, float hi) { return f2bf(lo) | (f2bf(hi) << 16); }
#define XB_TMO      128
#define XB_XCNT(j)  (256  + 64 * (j))
#define XB_XSUB(j)  (1280 + 64 * (j))
#define XB_XGEN(j)  (2304 + 64 * (j))
#define XB_TOP      3328
#define XB_TOPGEN   3392
#define XCD_BAR_WORDS 3456
#define XB_SPIN_CAP (1u << 18)

__device__ __forceinline__ unsigned xb_ld(unsigned* p)              { return __hip_atomic_load(p, __ATOMIC_RELAXED, __HIP_MEMORY_SCOPE_AGENT); }
__device__ __forceinline__ unsigned xb_add(unsigned* p, unsigned v) { return __hip_atomic_fetch_add(p, v, __ATOMIC_RELAXED, __HIP_MEMORY_SCOPE_AGENT); }
__device__ __forceinline__ unsigned xb_xcc_id() { return (unsigned)__builtin_amdgcn_s_getreg((3 << 11) | 20) & 0xFu; }
#define XB_SPIN(cond, bar) do { unsigned _sp = 0; while (cond) { __builtin_amdgcn_s_sleep(1); \
    if ((++_sp & 255u) == 0u) { if (xb_ld(&(bar)[XB_TMO])) break; if (_sp > XB_SPIN_CAP) { atomicAdd(&(bar)[XB_TMO], 1u); break; } } } } while (0)

struct XcdBarrier {
    unsigned* bar; unsigned x;
    volatile LAS unsigned* st;
};

__device__ __forceinline__ XcdBarrier xcd_barrier_post(unsigned* bar, volatile LAS unsigned* st) {
    XcdBarrier b; b.bar = bar; b.x = xb_xcc_id(); b.st = st;
    if (threadIdx.x == 0) (void)xb_add(&bar[XB_XCNT(b.x)], 1u);
    return b;
}
__device__ __forceinline__ void xcd_barrier_complete(unsigned* bar, unsigned x, unsigned& nloc, unsigned& nx) {
    const unsigned G = gridDim.x * gridDim.y * gridDim.z;
    unsigned sum, cnt, mine, sp = 0u;
    for (;;) {
        sum = 0u; cnt = 0u; mine = 0u;
#pragma unroll
        for (unsigned j = 0; j < 16; ++j) { const unsigned c = xb_ld(&bar[XB_XCNT(j)]); sum += c; cnt += (c > 0u) ? 1u : 0u; mine = (j == x) ? c : mine; }
        if (sum == G) break;
        __builtin_amdgcn_s_sleep(1);
        if ((++sp & 255u) == 0u) { if (xb_ld(&bar[XB_TMO])) break; if (sp > XB_SPIN_CAP) { atomicAdd(&bar[XB_TMO], 1u); break; } }
    }
    nloc = mine > 0u ? mine : 1u; nx = cnt > 0u ? cnt : 1u;
}

__device__ __forceinline__ void xcd_barrier(const XcdBarrier& b) {
    asm volatile("s_waitcnt vmcnt(0)" ::: "memory");
    __syncthreads();
    if (threadIdx.x == 0) {
        unsigned* bar = b.bar;
        __builtin_amdgcn_s_waitcnt(0);
        unsigned nloc = b.st[0], nx = b.st[1];
        if (nloc == 0u) { xcd_barrier_complete(bar, b.x, nloc, nx); b.st[0] = nloc; b.st[1] = nx; }
        const unsigned old = xb_add(&bar[XB_XSUB(b.x)], 1u);
        const unsigned gen = old / nloc;
        if (old + 1u == (gen + 1u) * nloc) {
            __builtin_amdgcn_fence(__ATOMIC_RELEASE, "agent");
            asm volatile("s_waitcnt vmcnt(0)" ::: "memory");
            const unsigned og = xb_add(&bar[XB_TOP], 1u);
            const unsigned tg = og / nx;
            if (og + 1u == (tg + 1u) * nx) xb_add(&bar[XB_TOPGEN], 1u);
            else XB_SPIN(xb_ld(&bar[XB_TOPGEN]) == tg, bar);
            __builtin_amdgcn_fence(__ATOMIC_ACQUIRE, "agent");
            xb_add(&bar[XB_XGEN(b.x)], 1u);
            asm volatile("s_waitcnt vmcnt(0)" ::: "memory");
        } else {
            XB_SPIN(xb_ld(&bar[XB_XGEN(b.x)]) == gen, bar);
            __builtin_amdgcn_fence(__ATOMIC_ACQUIRE, "agent");
            asm volatile("s_waitcnt vmcnt(0)" ::: "memory");
        }
    }
    __syncthreads();
}
constexpr int NWAVES = 8, NTHR = 512;
constexpr int DM = 2048, NBATCH = 2, SEQ = 8192, CTXL = 256;
constexpr int NCTX = NBATCH * CTXL;
constexpr int NLAT = NBATCH * SEQ;
constexpr int NROW = NCTX + NLAT;
constexpr int EVC = 6176, EVN = 6400, ZC0 = 6144;
constexpr int ODC = 4608;
constexpr int NEXP = 16, DFF = 1024;
constexpr int MP_MAX = 37888;
constexpr float EPSN = 1e-6f;
constexpr int FFTN = 16384;

constexpr size_t MiB = 1u << 20;
constexpr size_t WS_CTL = 0, CTL_ZERO_BYTES = 1 * MiB;
constexpr size_t WS_MODP = 1 * MiB;
constexpr size_t WS_MOD = 11 * MiB;
constexpr size_t WS_HDNL = 12 * MiB;
constexpr size_t WS_HDNC = 14 * MiB;
constexpr size_t WS_ROUTE = 15 * MiB;
constexpr size_t WS_LR = 16 * MiB;
constexpr size_t WS_WIN0 = 19 * MiB;
constexpr size_t WS_WOUT0 = 44 * MiB;
constexpr size_t WS_WIN1 = 52 * MiB;
constexpr size_t WS_WOUT1 = 70 * MiB;
constexpr size_t WS_WM13 = 78 * MiB;
constexpr size_t WS_WM2 = 334 * MiB;
constexpr size_t WS_X = 462 * MiB;
constexpr size_t WS_H = 594 * MiB;
constexpr size_t WS_Z = 660 * MiB;
constexpr size_t WS_W = 858 * MiB;
constexpr size_t WS_OF = WS_W, WS_OB = WS_W + 33 * MiB, WS_MIX = WS_W + 66 * MiB;
constexpr size_t WS_ACT = 1006 * MiB;
constexpr size_t WS_END = 1086 * MiB;
constexpr size_t HYS_BYTES = 196608 + 256;
static_assert(WS_MODP + (size_t)2 * 32 * 3 * 12288 * 4 <= WS_MOD && WS_LR + (size_t)NROW * 32 * 4 <= WS_WIN0 && WS_WIN0 + (size_t)EVN * DM * 2 <= WS_WOUT0 && WS_WIN1 + (size_t)ODC * DM * 2 <= WS_WOUT1, "ws map 1");
static_assert(WS_X + (size_t)NROW * DM * 4 <= WS_H && WS_H + (size_t)NROW * DM * 2 <= WS_Z && WS_Z + (size_t)NROW * ZC0 * 2 <= WS_W && WS_Z + (size_t)MP_MAX * DM * 2 <= WS_W, "ws map 2");
static_assert(WS_W + (size_t)MP_MAX * DM * 2 <= WS_ACT && WS_MIX + (size_t)NROW * DM * 2 <= WS_ACT && WS_ACT + (size_t)MP_MAX * DFF * 2 <= WS_END && WS_ACT + 256 * HYS_BYTES <= WS_END, "ws map 3");
constexpr int CW_CNT = 64;
constexpr int CW_HYQ = 256;
constexpr int CW_ATQ = 320;
constexpr int CW_BAR = 4096;

constexpr int RING_BYTES = 139264;
constexpr int LDSCTL_OFF = RING_BYTES;
constexpr int MISC_OFF = LDSCTL_OFF + 320;
constexpr int LDS_BYTES = 147456;
constexpr int TOFF_OFF = LDSCTL_OFF + 512;
typedef float f32x2v __attribute__((ext_vector_type(2)));
typedef unsigned v2u __attribute__((ext_vector_type(2)));
typedef short bf16x4 __attribute__((ext_vector_type(4)));

struct Args { const float* in[32]; float* out; unsigned char* ws; int ph_lo, ph_hi; };

struct Frame {
    LAS unsigned char* lds;
    int G, bx, NGW;
    const float* const __attribute__((address_space(4)))* in;
    float* out; unsigned char* ws;
};

__device__ __forceinline__ float bf2f(unsigned h) { return __uint_as_float(h << 16); }
__device__ __forceinline__ float bflo(unsigned w) { return __uint_as_float(w << 16); }
__device__ __forceinline__ float bfhi(unsigned w) { return __uint_as_float(w & 0xffff0000u); }
__device__ __forceinline__ float wave_sum(float v) {
#pragma unroll
    for (int o = 1; o < 64; o <<= 1) v += __shfl_xor(v, o);
    return v;
}
__device__ __forceinline__ float wave_max(float v) {
#pragma unroll
    for (int o = 1; o < 64; o <<= 1) v = fmaxf(v, __shfl_xor(v, o));
    return v;
}
__device__ __forceinline__ float silu_f(float x) { return x / (1.0f + __expf(-x)); }
__device__ __forceinline__ f32x4 mfma_bf16(bf16x8 a, bf16x8 b, f32x4 c) { return __builtin_amdgcn_mfma_f32_16x16x32_bf16(a, b, c, 0, 0, 0); }
__device__ __forceinline__ int row_cls(int row) { return row < NCTX ? 2 : ((row - NCTX) >> 13); }
#define PHASE_LOCALS int tid = threadIdx.x; asm volatile("" : "+v"(tid)); const int lane = tid & 63, wave = __builtin_amdgcn_readfirstlane(tid >> 6), gw = F.bx * NWAVES + wave; (void)lane; (void)wave; (void)gw;
__device__ __forceinline__ void tr_item(const float* W, int N, int ncols, bf16* WT, int K, int k0, int n0, int drow0, int drow1, LAS float* scr, int lane) {
#pragma unroll 4
    for (int i = 0; i < 16; ++i) {
        const int r = 4 * i + (lane >> 4), cc = 4 * (lane & 15);
        float4 v = make_float4(0.f, 0.f, 0.f, 0.f);
        if (cc < ncols) v = *(const float4*)(W + (size_t)(k0 + r) * N + n0 + cc);
        LAS float* s = scr + r * 65 + cc; s[0] = v.x; s[1] = v.y; s[2] = v.z; s[3] = v.w;
    }
    LDS_WAIT();
    const int c = lane & 7;
#pragma unroll
    for (int j = 0; j < 8; ++j) {
        const int n = (lane >> 3) + 8 * j;
        if (n < ncols) {
            const LAS float* s = scr + (8 * c) * 65 + n;
            v4u o; o.x = pk2(s[0], s[65]); o.y = pk2(s[2 * 65], s[3 * 65]); o.z = pk2(s[4 * 65], s[5 * 65]); o.w = pk2(s[6 * 65], s[7 * 65]);
            const int drow = n < 32 ? drow0 + n : drow1 + (n - 32);
            *(v4u*)(WT + (size_t)drow * K + k0 + 8 * c) = o;
        }
    }
    LDS_WAIT();
}
__device__ __forceinline__ int map_evin(int c0) { return c0 < 3072 ? c0 : (c0 < 3104 ? 6144 + (c0 - 3072) : c0 - 32); }

__device__ __forceinline__ void phase_pre(Frame& F) {
    PHASE_LOCALS
    {
        LAS float* sv = (LAS float*)F.lds;
        const float* cvec = F.in[1]; const float* cctx = F.in[3]; const float* adaw = F.in[4];
        float* modp = (float*)(F.ws + WS_MODP);
        for (int u = F.bx; u < 384; u += F.G) {
            const int layer = u / 192, r = u % 192, kc = r / 6, cb = r % 6, k0 = kc * 64;
            __syncthreads();
            if (tid < 192) { const int v = tid >> 6, k = tid & 63; const float c = v < 2 ? cvec[v * DM + k0 + k] : cctx[k0 + k]; sv[tid] = silu_f(c); }
            __syncthreads();
            const int col0 = cb * 2048 + tid * 4;
            const float* wp = adaw + ((size_t)layer * DM + k0) * 12288 + col0;
            f32x4 a0 = {0.f, 0.f, 0.f, 0.f}, a1 = a0, a2 = a0;
#pragma unroll 8
            for (int k = 0; k < 64; ++k) { const f32x4 w = *(const f32x4*)(wp + (size_t)k * 12288); a0 += w * sv[k]; a1 += w * sv[64 + k]; a2 += w * sv[128 + k]; }
            float* op = modp + ((size_t)(layer * 32 + kc) * 3) * 12288 + col0;
            *(f32x4*)op = a0; *(f32x4*)(op + 12288) = a1; *(f32x4*)(op + 2 * 12288) = a2;
        }
        __syncthreads();
    }
    {
        const float* w1 = F.in[15]; const float* b1 = F.in[16]; const float* w2 = F.in[17]; const float* b2 = F.in[18];
        float* hdn = (float*)(F.ws + WS_HDNL);
        for (int rr = gw; rr < 8192 + 256; rr += F.NGW) {
            const int L = rr < 8192 ? 8192 : 256, l = rr < 8192 ? rr : rr - 8192;
            const float t = (float)l / (float)(L - 1);
            const float w = (float)(2.0 * 3.14159265358979323846 / (double)L) * (float)l;
            float h1 = b1[lane] + t * w1[lane];
#pragma unroll 4
            for (int i = 0; i < 16; ++i) {
                const float band = 1e-4f + (float)i * ((15.0f - 1e-4f) / 15.0f);
                float sn, cs; sincosf(band * w, &sn, &cs);
                h1 += cs * w1[(1 + i) * 64 + lane] - sn * w1[(17 + i) * 64 + lane];
            }
            h1 = sinf(h1);
            float h2 = b2[lane];
#pragma unroll 8
            for (int i = 0; i < 64; ++i) h2 += __shfl(h1, i) * w2[i * 64 + lane];
            hdn[(size_t)rr * 64 + lane] = sinf(h2);
        }
    }
    {
        LAS float* scr = (LAS float*)(F.lds) + wave * (64 * 65);
        bf16* win0 = (bf16*)(F.ws + WS_WIN0); bf16* wout0 = (bf16*)(F.ws + WS_WOUT0); bf16* win1 = (bf16*)(F.ws + WS_WIN1); bf16* wout1 = (bf16*)(F.ws + WS_WOUT1);
        bf16* wm13 = (bf16*)(F.ws + WS_WM13); bf16* wm2 = (bf16*)(F.ws + WS_WM2);
        constexpr int I0 = 32 * 97, I1 = 32 * 32, I2 = 32 * 72, I3 = 32 * 32, I4 = 32 * 512, I5 = I4, I6 = 32 * 512;
        constexpr int NITEMS = I0 + I1 + I2 + I3 + I4 + I5 + I6;
        for (int it = gw; it < NITEMS; it += F.NGW) {
            int r = it;
            if (r < I0) { const int kb = r / 97, nb = r % 97, n0 = nb * 64; tr_item(F.in[8], EVC, nb == 96 ? 32 : 64, win0, DM, kb * 64, n0, map_evin(n0), map_evin(n0 + 32), scr, lane); continue; } r -= I0;
            if (r < I1) { const int kb = r / 32, nb = r % 32, n0 = nb * 64; tr_item(F.in[9], DM, 64, wout0, DM, kb * 64, n0, n0, n0 + 32, scr, lane); continue; } r -= I1;
            if (r < I2) { const int kb = r / 72, nb = r % 72, n0 = nb * 64; tr_item(F.in[21], ODC, 64, win1, DM, kb * 64, n0, n0, n0 + 32, scr, lane); continue; } r -= I2;
            if (r < I3) { const int kb = r / 32, nb = r % 32, n0 = nb * 64; tr_item(F.in[22], DM, 64, wout1, DM, kb * 64, n0, n0, n0 + 32, scr, lane); continue; } r -= I3;
            if (r < I4 + I5) {
                const int which = r >= I4 ? 1 : 0; if (which) r -= I4;
                const int le = r / 512, q = r % 512, kb = q / 16, nb = q % 16, n0 = nb * 64, layer = le >> 4, e = le & 15;
                const float* W = (which ? F.in[30] : F.in[29]) + (size_t)le * DM * DFF;
                const int d0 = e * 2048 + (n0 >> 7) * 256 + which * 128 + (n0 & 127);
                tr_item(W, DFF, 64, wm13 + (size_t)layer * 16 * 2048 * DM, DM, kb * 64, n0, d0, d0 + 32, scr, lane); continue;
            }
            r -= I4 + I5;
            {
                const int le = r / 512, q = r % 512, kb = q / 32, nb = q % 32, n0 = nb * 64, layer = le >> 4, e = le & 15;
                const float* W = F.in[31] + (size_t)le * DFF * DM;
                tr_item(W, DM, 64, wm2 + (size_t)layer * 16 * 2048 * DFF, DFF, kb * 64, n0, e * 2048 + n0, e * 2048 + n0 + 32, scr, lane);
            }
        }
    }
}
__device__ __forceinline__ void phase_modfin(Frame& F) {
    PHASE_LOCALS
    const float* adab = F.in[5]; const float* modp = (const float*)(F.ws + WS_MODP); float* mod = (float*)(F.ws + WS_MOD);
    for (int idx = F.bx * NTHR + tid; idx < 2 * 3 * 12288; idx += F.G * NTHR) {
        const int layer = idx / 36864, rem = idx % 36864, v = rem / 12288, col = rem % 12288;
        float s = adab[layer * 12288 + col];
        for (int kc = 0; kc < 32; ++kc) s += modp[((size_t)(layer * 32 + kc) * 3 + v) * 12288 + col];
        mod[idx] = s;
    }
}
template <int MODE>
__device__ __forceinline__ void phase_norm(Frame& F, int layer) {
    PHASE_LOCALS
    float* X = (float*)(F.ws + WS_X); bf16* H = (bf16*)(F.ws + WS_H);
    const float* mod = (const float*)(F.ws + WS_MOD); const bf16* yperm = (const bf16*)(F.ws + WS_W);
    const unsigned* route = (const unsigned*)(F.ws + WS_ROUTE);
    const float* gain = F.in[6] + layer * DM;
    const int r_begin = MODE == 2 ? NCTX : 0;
    for (int row = r_begin + gw; row < NROW; row += F.NGW) {
        const int cls = row_cls(row);
        f32x4 v[8];
        if (MODE == 0) {
            const float* src = row < NCTX ? F.in[2] + (size_t)row * DM : F.in[0] + (size_t)(row - NCTX) * DM;
#pragma unroll
            for (int j = 0; j < 8; ++j) v[j] = *(const f32x4*)(src + 256 * j + 4 * lane);
        } else {
            const float* src = X + (size_t)row * DM;
            const v4u rt = *(const v4u*)(route + (size_t)row * 8 + 4);
            const float w0 = __uint_as_float(rt.x), w1 = __uint_as_float(rt.y);
            const bf16* y0 = yperm + (size_t)rt.z * DM; const bf16* y1 = yperm + (size_t)rt.w * DM;
            const float* g2 = mod + (size_t)((layer - (MODE == 1 ? 1 : 0)) * 3 + cls) * 12288 + 5 * DM;
#pragma unroll
            for (int j = 0; j < 8; ++j) {
                const int e = 256 * j + 4 * lane;
                const f32x4 x = *(const f32x4*)(src + e), g = *(const f32x4*)(g2 + e);
                const v2u a = *(const v2u*)(y0 + e), b = *(const v2u*)(y1 + e);
                f32x4 y; y[0] = w0 * bflo(a.x) + w1 * bflo(b.x); y[1] = w0 * bfhi(a.x) + w1 * bfhi(b.x); y[2] = w0 * bflo(a.y) + w1 * bflo(b.y); y[3] = w0 * bfhi(a.y) + w1 * bfhi(b.y);
                v[j] = x + g * y;
            }
        }
        if (MODE == 2) {
            float* o = F.out + (size_t)(row - NCTX) * DM;
#pragma unroll
            for (int j = 0; j < 8; ++j) *(f32x4*)(o + 256 * j + 4 * lane) = v[j];
        } else {
            float* xo = X + (size_t)row * DM; float ss = 0.f;
#pragma unroll
            for (int j = 0; j < 8; ++j) { *(f32x4*)(xo + 256 * j + 4 * lane) = v[j]; ss += v[j][0] * v[j][0] + v[j][1] * v[j][1] + v[j][2] * v[j][2] + v[j][3] * v[j][3]; }
            const float rstd = rsqrtf(wave_sum(ss) * (1.0f / DM) + EPSN);
            const float* mrow = mod + (size_t)(layer * 3 + cls) * 12288;
            bf16* ho = H + (size_t)row * DM;
#pragma unroll
            for (int j = 0; j < 8; ++j) {
                const int e = 256 * j + 4 * lane;
                const f32x4 gn = *(const f32x4*)(gain + e), sh = *(const f32x4*)(mrow + e), sc = *(const f32x4*)(mrow + DM + e);
                const f32x4 h = v[j] * rstd * gn * (sc + 1.0f) + sh;
                v2u o; o.x = pk2(h[0], h[1]); o.y = pk2(h[2], h[3]); *(v2u*)(ho + e) = o;
            }
        }
    }
}
__device__ __forceinline__ void phase_route(Frame& F, int layer) {
    PHASE_LOCALS
    const float* X = (const float*)(F.ws + WS_X); bf16* H = (bf16*)(F.ws + WS_H);
    const float* mod = (const float*)(F.ws + WS_MOD);
    unsigned* route = (unsigned*)(F.ws + WS_ROUTE);
    unsigned* cnt = (unsigned*)(F.ws + WS_CTL) + CW_CNT + 64 * layer;
    const float* gain = F.in[7] + layer * DM; const float* rw = F.in[27]; const float* rb = F.in[28];
    LAS float* rwT = (LAS float*)F.lds;
    __syncthreads();
    for (int idx = tid; idx < DM * NEXP; idx += NTHR) rwT[(idx & 15) * DM + (idx >> 4)] = rw[idx];
    __syncthreads();
    float rbv[16];
#pragma unroll
    for (int e = 0; e < 16; ++e) rbv[e] = rb[e];
    const int r_begin = layer == 0 ? 0 : NCTX;
    for (int row = r_begin + gw; row < NROW; row += F.NGW) {
        const int cls = row_cls(row);
        const float* src = X + (size_t)row * DM;
        f32x4 v[8]; float ss = 0.f;
#pragma unroll
        for (int j = 0; j < 8; ++j) { v[j] = *(const f32x4*)(src + 256 * j + 4 * lane); ss += v[j][0] * v[j][0] + v[j][1] * v[j][1] + v[j][2] * v[j][2] + v[j][3] * v[j][3]; }
        const float rstd = rsqrtf(wave_sum(ss) * (1.0f / DM) + EPSN);
        const float* mrow = mod + (size_t)(layer * 3 + cls) * 12288 + 3 * DM;
        bf16* ho = H + (size_t)row * DM;
#pragma unroll
        for (int j = 0; j < 8; ++j) {
            const int e = 256 * j + 4 * lane;
            const f32x4 gn = *(const f32x4*)(gain + e), sh = *(const f32x4*)(mrow + e), sc = *(const f32x4*)(mrow + DM + e);
            v[j] = v[j] * rstd * gn * (sc + 1.0f) + sh;
            v2u o; o.x = pk2(v[j][0], v[j][1]); o.y = pk2(v[j][2], v[j][3]); *(v2u*)(ho + e) = o;
        }
        float lg[16];
#pragma unroll
        for (int e = 0; e < 16; ++e) {
            float p = 0.f;
#pragma unroll
            for (int j = 0; j < 8; ++j) { const f32x4 w = *(const LAS f32x4*)(rwT + e * DM + 256 * j + 4 * lane); p += v[j][0] * w[0] + v[j][1] * w[1] + v[j][2] * w[2] + v[j][3] * w[3]; }
            lg[e] = wave_sum(p);
            asm volatile("" ::: "memory");
        }
        float mx = lg[0];
#pragma unroll
        for (int e = 1; e < 16; ++e) mx = fmaxf(mx, lg[e]);
        float sc[16], den = 0.f;
#pragma unroll
        for (int e = 0; e < 16; ++e) { sc[e] = expf(lg[e] - mx); den += sc[e]; }
        const float inv = 1.0f / den;
        float sel[16];
#pragma unroll
        for (int e = 0; e < 16; ++e) { sc[e] *= inv; sel[e] = sc[e] + rbv[e]; }
        int gbest = 0; float gsb = -3.0e38f;
#pragma unroll
        for (int g = 0; g < 4; ++g) {
            const float a = sel[4 * g], b = sel[4 * g + 1], c = sel[4 * g + 2], d = sel[4 * g + 3];
            const float hi1 = fmaxf(a, b), lo1 = fminf(a, b), hi2 = fmaxf(c, d), lo2 = fminf(c, d);
            const float top = fmaxf(hi1, hi2), second = fmaxf(fminf(hi1, hi2), fmaxf(lo1, lo2));
            const float gs = top + second;
            if (gs > gsb) { gsb = gs; gbest = g; }
        }
        int e0 = 0, e1 = 0; float s0 = -3.0e38f, s1 = -3.0e38f;
#pragma unroll
        for (int e = 0; e < 16; ++e) if ((e >> 2) == gbest) { if (sel[e] > s0) { s1 = s0; e1 = e0; s0 = sel[e]; e0 = e; } else if (sel[e] > s1) { s1 = sel[e]; e1 = e; } }
        float w0 = 0.f, w1 = 0.f;
#pragma unroll
        for (int e = 0; e < 16; ++e) { w0 = (e == e0) ? sc[e] : w0; w1 = (e == e1) ? sc[e] : w1; }
        const float ws = 1.0f / (w0 + w1); w0 *= ws; w1 *= ws;
        if (lane == 0) {
            const unsigned r0 = __hip_atomic_fetch_add(cnt + e0, 1u, __ATOMIC_RELAXED, __HIP_MEMORY_SCOPE_AGENT);
            const unsigned r1 = __hip_atomic_fetch_add(cnt + e1, 1u, __ATOMIC_RELAXED, __HIP_MEMORY_SCOPE_AGENT);
            v4u a; a.x = (unsigned)e0; a.y = (unsigned)e1; a.z = r0; a.w = r1;
            v4u b; b.x = __float_as_uint(w0); b.y = __float_as_uint(w1); b.z = 0u; b.w = 0u;
            *(v4u*)(route + (size_t)row * 8) = a; *(v4u*)(route + (size_t)row * 8 + 4) = b;
        }
    }
    __syncthreads();
}
__device__ __forceinline__ void moe_offsets(Frame& F, int layer) {
    PHASE_LOCALS
    LAS int* toff = (LAS int*)(F.lds + TOFF_OFF);
    __syncthreads();
    if (tid == 0) {
        const unsigned* cnt = (const unsigned*)(F.ws + WS_CTL) + CW_CNT + 64 * layer; int acc = 0;
        for (int e = 0; e < 16; ++e) { toff[e] = acc; acc += (int)((__hip_atomic_load(cnt + e, __ATOMIC_RELAXED, __HIP_MEMORY_SCOPE_AGENT) + 255u) >> 8); }
        toff[16] = acc;
    }
    __syncthreads();
}
__device__ __forceinline__ void phase_gather(Frame& F, int layer) {
    PHASE_LOCALS
    moe_offsets(F, layer);
    const LAS int* toff = (const LAS int*)(F.lds + TOFF_OFF);
    const bf16* H = (const bf16*)(F.ws + WS_H); bf16* hperm = (bf16*)(F.ws + WS_Z);
    unsigned* route = (unsigned*)(F.ws + WS_ROUTE);
    const int r_begin = layer == 0 ? 0 : NCTX;
    for (int row = r_begin + gw; row < NROW; row += F.NGW) {
        const v4u a = *(const v4u*)(route + (size_t)row * 8);
        const unsigned p0 = (unsigned)toff[a.x] * 256u + a.z, p1 = (unsigned)toff[a.y] * 256u + a.w;
        const v4u* src = (const v4u*)(H + (size_t)row * DM); v4u* d0 = (v4u*)(hperm + (size_t)p0 * DM); v4u* d1 = (v4u*)(hperm + (size_t)p1 * DM);
#pragma unroll
        for (int j = 0; j < 4; ++j) { const v4u x = src[64 * j + lane]; d0[64 * j + lane] = x; d1[64 * j + lane] = x; }
        if (lane == 0) { v2u pp; pp.x = p0; pp.y = p1; *(v2u*)(route + (size_t)row * 8 + 6) = pp; }
    }
}
__device__ __forceinline__ void phase_ht(Frame& F) {
    PHASE_LOCALS
    const bf16* Z = (const bf16*)(F.ws + WS_Z); bf16* UT = (bf16*)F.out;
    const float* cw = F.in[13]; const float* cb = F.in[14];
    constexpr int NCB = 3072 / 64, NRB = NROW / 64;
    for (int it = gw; it < NCB * NRB; it += F.NGW) {
        const int cblk = it % NCB, rblk = it / NCB, ch = cblk * 64 + lane, r0 = rblk * 64;
        const float w0 = cw[ch], w1 = cw[3072 + ch], w2 = cw[2 * 3072 + ch], bb = cb[ch];
        const bool first = (r0 < NCTX) ? ((r0 & 255) == 0) : (((r0 - NCTX) & 8191) == 0);
        const bool last = (r0 < NCTX) ? (((r0 + 64) & 255) == 0) : (((r0 + 64 - NCTX) & 8191) == 0);
        const bf16* zp = Z + (size_t)r0 * ZC0 + 3072 + ch;
        float prev = first ? 0.f : bf2f(zp[-(ptrdiff_t)ZC0]);
        float cur = bf2f(zp[0]);
        bf16* up = UT + (size_t)ch * NROW + r0;
#pragma unroll 1
        for (int g8 = 0; g8 < 8; ++g8) {
            float o[8];
#pragma unroll
            for (int q = 0; q < 8; ++q) {
                const int r = g8 * 8 + q;
                const float nxt = (r == 63) ? (last ? 0.f : bf2f(zp[(size_t)64 * ZC0])) : bf2f(zp[(size_t)(r + 1) * ZC0]);
                o[q] = w0 * prev + w1 * cur + w2 * nxt + bb; prev = cur; cur = nxt;
            }
            v4u w; w.x = pk2(o[0], o[1]); w.y = pk2(o[2], o[3]); w.z = pk2(o[4], o[5]); w.w = pk2(o[6], o[7]);
            *(v4u*)(up + g8 * 8) = w;
        }
    }
}
__device__ __forceinline__ void merge_heads(Frame& F, const float* gain, int ldz, int r_begin) {
    PHASE_LOCALS
    const bf16* OF = (const bf16*)(F.ws + WS_OF); const bf16* OB = (const bf16*)(F.ws + WS_OB); const bf16* Z = (const bf16*)(F.ws + WS_Z);
    bf16* MIX = (bf16*)(F.ws + WS_MIX);
    const f32x4 gn = *(const f32x4*)(gain + 4 * lane);
    for (int row = r_begin + gw; row < NROW; row += F.NGW) {
#pragma unroll
        for (int h = 0; h < 4; ++h) {
            const size_t off = (size_t)row * 1024 + h * 256 + 4 * lane;
            const v2u a = *(const v2u*)(OF + off), b = *(const v2u*)(OB + off), g = *(const v2u*)(Z + (size_t)row * ldz + 2048 + h * 256 + 4 * lane);
            f32x4 o; o[0] = bflo(a.x) + bflo(b.x); o[1] = bfhi(a.x) + bfhi(b.x); o[2] = bflo(a.y) + bflo(b.y); o[3] = bfhi(a.y) + bfhi(b.y);
            const float ss = wave_sum(o[0] * o[0] + o[1] * o[1] + o[2] * o[2] + o[3] * o[3]);
            const float rstd = rsqrtf(ss * (1.0f / 256.0f) + EPSN);
            f32x4 gg; gg[0] = silu_f(bflo(g.x)); gg[1] = silu_f(bfhi(g.x)); gg[2] = silu_f(bflo(g.y)); gg[3] = silu_f(bfhi(g.y));
            const f32x4 r = o * rstd * gn * gg;
            v2u w; w.x = pk2(r[0], r[1]); w.y = pk2(r[2], r[3]);
            *(v2u*)(MIX + (size_t)row * DM + h * 256 + 4 * lane) = w;
        }
    }
}
__device__ __forceinline__ void merge_hyena(Frame& F) {
    PHASE_LOCALS
    const bf16* HYO = (const bf16*)(F.ws + WS_H); bf16* MIX = (bf16*)(F.ws + WS_MIX);
    LAS unsigned short* tl = (LAS unsigned short*)F.lds + wave * (64 * 72);
    constexpr int NCB = 1024 / 64, NRB = NROW / 64;
    for (int it = gw; it < NCB * NRB; it += F.NGW) {
        const int cblk = it % NCB, rblk = it / NCB, c0 = cblk * 64, r0 = rblk * 64;
#pragma unroll
        for (int i = 0; i < 8; ++i) {
            const int c = i * 8 + (lane >> 3), ch = lane & 7;
            const v4u x = *(const v4u*)(HYO + (size_t)(c0 + c) * NROW + r0 + ch * 8);
            *(LAS v4u*)(tl + c * 72 + ch * 8) = x;
        }
        LDS_WAIT();
#pragma unroll
        for (int i = 0; i < 8; ++i) {
            const int r = i * 8 + (lane >> 3), cq = (lane & 7) * 8;
            unsigned short e[8];
#pragma unroll
            for (int q = 0; q < 8; ++q) e[q] = tl[(cq + q) * 72 + r];
            v4u w; w.x = e[0] | ((unsigned)e[1] << 16); w.y = e[2] | ((unsigned)e[3] << 16); w.z = e[4] | ((unsigned)e[5] << 16); w.w = e[6] | ((unsigned)e[7] << 16);
            *(v4u*)(MIX + (size_t)(r0 + r) * DM + 1024 + c0 + cq) = w;
        }
        LDS_WAIT();
    }
}
__device__ __forceinline__ void phase_prep(Frame& F) {
    PHASE_LOCALS
    bf16* Z = (bf16*)(F.ws + WS_Z);
    const float* qn = F.in[24]; const float* kn = F.in[25];
    const float rsq = 0.08838834764831845f;
    const float inv_ret = powf(10000.0f, -(float)lane / 63.0f);
    const float inv_ax = powf(10000.0f, -(float)(lane & 31) / 32.0f);
    for (int row = gw; row < NROW; row += F.NGW) {
        const bool latent = row >= NCTX; const int pos = latent ? ((row - NCTX) & 8191) : 0;
        bf16* zr = Z + (size_t)row * ODC;
        float sr = 0.f, cr = 1.f, s1 = 0.f, c1 = 1.f, s2 = 0.f, c2 = 1.f;
        if (latent) { sincosf((float)pos * inv_ret, &sr, &cr); sincosf((float)(pos >> 6) * inv_ax, &s1, &c1); sincosf((float)(pos & 63) * inv_ax, &s2, &c2); }
#pragma unroll
        for (int sg = 0; sg < 8; ++sg) {
            bf16* p = zr + sg * 128;
            const float x1 = bf2f(p[lane]), x2 = bf2f(p[64 + lane]);
            float o1 = x1 * cr - x2 * sr, o2 = x2 * cr + x1 * sr;
            if (sg >= 4) { o1 *= rsq; o2 *= rsq; }
            p[lane] = (bf16)f2bf(o1); p[64 + lane] = (bf16)f2bf(o2);
        }
#pragma unroll
        for (int sg = 0; sg < 10; ++sg) {
            bf16* p = zr + 3072 + sg * 128; const float* gnp = sg < 8 ? qn : kn;
            float a = bf2f(p[lane]), b = bf2f(p[64 + lane]);
            const float rstd = rsqrtf(wave_sum(a * a + b * b) * (1.0f / 128.0f) + EPSN);
            a = a * rstd * gnp[lane]; b = b * rstd * gnp[64 + lane];
            const float ap = __shfl_xor(a, 32), bp = __shfl_xor(b, 32);
            float oa, ob;
            if (lane < 32) { oa = a * c1 - ap * s1; ob = b * c2 - bp * s2; }
            else { oa = a * c1 + ap * s1; ob = b * c2 + bp * s2; }
            if (sg < 8) { oa *= rsq; ob *= rsq; }
            p[lane] = (bf16)f2bf(oa); p[64 + lane] = (bf16)f2bf(ob);
        }
    }
}
__device__ __forceinline__ int scan_rowbase(int n, int b, int dir) {
    if (n < 4) { const int cc = dir ? 3 - n : n; return b * CTXL + cc * 64; }
    const int m = n - 4, cc = dir ? 127 - m : m; return NCTX + b * SEQ + cc * 64;
}
template <bool GLA>
__device__ __forceinline__ void scan_unit(Frame& F, int unit) {
    const int s = unit & 3, dir = (unit >> 2) & 1, h = (unit >> 3) & 3, b = unit >> 5;
    PHASE_LOCALS
    const int w = wave, l = lane, g = l >> 4, c = l & 15;
    LAS unsigned char* lds = F.lds;
    constexpr int S128 = 272, S64 = 144;
    constexpr int O_RQ = 0, O_RK = 17408, O_QE = 34816, O_KE = 52224, O_KDT = 69632, O_VT = 88064, O_ST = 97280, O_LR = 132096;
    static_assert(O_LR + 64 * 17 * 4 <= RING_BYTES, "scan LDS map");
    const bf16* Z = (const bf16*)(F.ws + WS_Z);
    constexpr int ldz = GLA ? ZC0 : ODC;
    const bf16* Zq = Z + h * 128; const bf16* Zk = Z + 512 + h * 128; const bf16* Zv = Z + 1024 + h * 256 + s * 64;
    const float* LRp = (const float*)(F.ws + WS_LR) + dir * 16;
    bf16* O = (bf16*)(F.ws + (dir ? WS_OB : WS_OF)) + h * 256 + s * 64;
    const float qscale = GLA ? 0.08838834764831845f : 1.0f;
    float wgv[4] = {0.f, 0.f, 0.f, 0.f}, bgv[4] = {0.f, 0.f, 0.f, 0.f}; float lgv = 0.f;
    if (GLA) {
        const float* wg = F.in[10] + dir * 16 * 512 + h * 128 + 16 * w; const float* bg = F.in[11] + dir * 512 + h * 128 + 16 * w;
#pragma unroll
        for (int ks = 0; ks < 4; ++ks) wgv[ks] = wg[(4 * ks + g) * 512 + c];
#pragma unroll
        for (int i = 0; i < 4; ++i) bgv[i] = bg[4 * g + i];
    } else {
        const int hh = dir ? 3 - h : h; lgv = logf(1.0f - exp2f(-5.0f - (float)hh));
    }
    for (int i = tid; i < 17408 / 4; i += NTHR) ((LAS unsigned*)(lds + O_ST))[i] = 0u;
    f32x4 S[4];
#pragma unroll
    for (int et = 0; et < 4; ++et) S[et] = (f32x4){0.f, 0.f, 0.f, 0.f};
    v4u rq[2], rk[2], rv; f32x4 rl = {0.f, 0.f, 0.f, 0.f};
#define SCAN_LOAD(n_) do { const int rb_ = scan_rowbase((n_), b, dir); \
        _Pragma("unroll") for (int i_ = 0; i_ < 2; ++i_) { const int idx_ = tid + 512 * i_, r_ = idx_ >> 4, ch_ = idx_ & 15; \
            rq[i_] = *(const v4u*)(Zq + (size_t)(rb_ + r_) * ldz + ch_ * 8); rk[i_] = *(const v4u*)(Zk + (size_t)(rb_ + r_) * ldz + ch_ * 8); } \
        rv = *(const v4u*)(Zv + (size_t)(rb_ + (tid >> 3)) * ldz + (tid & 7) * 8); \
        if (GLA && tid < 256) rl = *(const f32x4*)(LRp + (size_t)(rb_ + (tid >> 2)) * 32 + (tid & 3) * 4); } while (0)
    SCAN_LOAD(0);
    int cur = 0;
    for (int n = 0; n < 132; ++n) {
        const int rb = scan_rowbase(n, b, dir);
#pragma unroll
        for (int i = 0; i < 2; ++i) { const int idx = tid + 512 * i, r = idx >> 4, ch = idx & 15;
            *(LAS v4u*)(lds + O_RQ + r * S128 + ch * 16) = rq[i]; *(LAS v4u*)(lds + O_RK + r * S128 + ch * 16) = rk[i]; }
        { const int t = tid >> 3, e0 = (tid & 7) * 8; const unsigned vv[4] = {rv.x, rv.y, rv.z, rv.w};
#pragma unroll
            for (int q = 0; q < 4; ++q) {
                *(LAS unsigned short*)(lds + O_VT + (e0 + 2 * q) * S64 + t * 2) = (unsigned short)(vv[q] & 0xffffu);
                *(LAS unsigned short*)(lds + O_VT + (e0 + 2 * q + 1) * S64 + t * 2) = (unsigned short)(vv[q] >> 16); } }
        if (GLA && tid < 256) { LAS float* lr = (LAS float*)(lds + O_LR) + (tid >> 2) * 17 + (tid & 3) * 4; lr[0] = rl[0]; lr[1] = rl[1]; lr[2] = rl[2]; lr[3] = rl[3]; }
        if (n + 1 < 132) SCAN_LOAD(n + 1);
        __syncthreads();
        f32x4 cum[4]; float tot[4];
        if (GLA) {
            const LAS float* lrs = (const LAS float*)(lds + O_LR);
            f32x4 la[4];
#pragma unroll
            for (int tt = 0; tt < 4; ++tt) {
                f32x4 a = {0.f, 0.f, 0.f, 0.f};
#pragma unroll
                for (int ks = 0; ks < 4; ++ks) a = __builtin_amdgcn_mfma_f32_16x16x4f32(wgv[ks], lrs[(16 * tt + c) * 17 + 4 * ks + g], a, 0, 0, 0);
#pragma unroll
                for (int i = 0; i < 4; ++i) { const float x = a[i] + bgv[i]; la[tt][i] = (fminf(x, 0.f) - __logf(1.0f + __expf(-fabsf(x)))) * 0.0625f; }
            }
            float carry[4] = {0.f, 0.f, 0.f, 0.f};
#pragma unroll
            for (int tt = 0; tt < 4; ++tt)
#pragma unroll
                for (int i = 0; i < 4; ++i) {
                    float v = la[tt][i], u;
                    u = __shfl_up(v, 1, 16); if (c >= 1) v += u;
                    u = __shfl_up(v, 2, 16); if (c >= 2) v += u;
                    u = __shfl_up(v, 4, 16); if (c >= 4) v += u;
                    u = __shfl_up(v, 8, 16); if (c >= 8) v += u;
                    const float ttot = __shfl(v, 15, 16);
                    cum[tt][i] = v + carry[i]; carry[i] += ttot;
                }
#pragma unroll
            for (int i = 0; i < 4; ++i) tot[i] = carry[i];
            if (dir) {
#pragma unroll
                for (int tt = 0; tt < 4; ++tt)
#pragma unroll
                    for (int i = 0; i < 4; ++i) cum[tt][i] = tot[i] - cum[tt][i] + la[tt][i];
            }
        } else {
#pragma unroll
            for (int tt = 0; tt < 4; ++tt) { const int t = 16 * tt + c; const float cv = dir ? (float)(64 - t) * lgv : (float)(t + 1) * lgv;
#pragma unroll
                for (int i = 0; i < 4; ++i) cum[tt][i] = cv; }
#pragma unroll
            for (int i = 0; i < 4; ++i) tot[i] = 64.0f * lgv;
        }
#pragma unroll
        for (int tt = 0; tt < 4; ++tt) {
            const int t = 16 * tt + c;
            const v2u q4 = *(const LAS v2u*)(lds + O_RQ + t * S128 + (16 * w + 4 * g) * 2), k4 = *(const LAS v2u*)(lds + O_RK + t * S128 + (16 * w + 4 * g) * 2);
            const float qv[4] = {bflo(q4.x), bfhi(q4.x), bflo(q4.y), bfhi(q4.y)}, kv[4] = {bflo(k4.x), bfhi(k4.x), bflo(k4.y), bfhi(k4.y)};
            float qe[4], ke[4];
#pragma unroll
            for (int i = 0; i < 4; ++i) {
                const float e1 = __expf(cum[tt][i]), e2 = __expf(-cum[tt][i]), e3 = __expf(tot[i] - cum[tt][i]);
                qe[i] = qv[i] * qscale * e1; ke[i] = kv[i] * e2;
                *(LAS unsigned short*)(lds + O_KDT + (16 * w + 4 * g + i) * S64 + t * 2) = (unsigned short)f2bf(kv[i] * e3);
            }
            v2u o; o.x = pk2(qe[0], qe[1]); o.y = pk2(qe[2], qe[3]); *(LAS v2u*)(lds + O_QE + t * S128 + (16 * w + 4 * g) * 2) = o;
            o.x = pk2(ke[0], ke[1]); o.y = pk2(ke[2], ke[3]); *(LAS v2u*)(lds + O_KE + t * S128 + (16 * w + 4 * g) * 2) = o;
        }
        float dec[4];
#pragma unroll
        for (int i = 0; i < 4; ++i) dec[i] = __expf(tot[i]);
        __syncthreads();
        {
            const int it = w >> 1, ep = w & 1;
            bf16x8 qf[4];
#pragma unroll
            for (int ks = 0; ks < 4; ++ks) qf[ks] = *(const LAS bf16x8*)(lds + O_QE + (16 * it + c) * S128 + (32 * ks + 8 * g) * 2);
            f32x4 sa[4];
#pragma unroll
            for (int jt = 0; jt < 4; ++jt) {
                sa[jt] = (f32x4){0.f, 0.f, 0.f, 0.f};
#pragma unroll
                for (int ks = 0; ks < 4; ++ks) { const bf16x8 a = *(const LAS bf16x8*)(lds + O_KE + (16 * jt + c) * S128 + (32 * ks + 8 * g) * 2); sa[jt] = mfma_bf16(a, qf[ks], sa[jt]); }
                const int itok = 16 * it + c;
#pragma unroll
                for (int r = 0; r < 4; ++r) { const int j = 16 * jt + 4 * g + r; const bool keep = dir ? (j >= itok) : (j <= itok); sa[jt][r] = keep ? sa[jt][r] : 0.f; }
            }
            bf16x8 P[2];
#pragma unroll
            for (int p = 0; p < 2; ++p) { v4u t4; t4.x = pk2(sa[2 * p][0], sa[2 * p][1]); t4.y = pk2(sa[2 * p][2], sa[2 * p][3]); t4.z = pk2(sa[2 * p + 1][0], sa[2 * p + 1][1]); t4.w = pk2(sa[2 * p + 1][2], sa[2 * p + 1][3]);
                P[p] = __builtin_bit_cast(bf16x8, t4); }
            const LAS unsigned char* stc = lds + O_ST + cur * 17408;
#pragma unroll
            for (int en = 0; en < 2; ++en) {
                const int et = 2 * ep + en; f32x4 acc = {0.f, 0.f, 0.f, 0.f};
#pragma unroll
                for (int p = 0; p < 2; ++p) {
                    const v2u lo = *(const LAS v2u*)(lds + O_VT + (16 * et + c) * S64 + (32 * p + 4 * g) * 2), hi = *(const LAS v2u*)(lds + O_VT + (16 * et + c) * S64 + (32 * p + 16 + 4 * g) * 2);
                    v4u a4; a4.x = lo.x; a4.y = lo.y; a4.z = hi.x; a4.w = hi.y;
                    acc = mfma_bf16(__builtin_bit_cast(bf16x8, a4), P[p], acc);
                }
#pragma unroll
                for (int ks = 0; ks < 4; ++ks) { const bf16x8 a = *(const LAS bf16x8*)(stc + (16 * et + c) * S128 + (32 * ks + 8 * g) * 2); acc = mfma_bf16(a, qf[ks], acc); }
                if (GLA || n >= 4) { v2u o; o.x = pk2(acc[0], acc[1]); o.y = pk2(acc[2], acc[3]); *(v2u*)(O + (size_t)(rb + 16 * it + c) * 1024 + 16 * et + 4 * g) = o; }
            }
        }
        {
            LAS unsigned char* stn = lds + O_ST + (cur ^ 1) * 17408;
            bf16x8 ka[2];
#pragma unroll
            for (int p = 0; p < 2; ++p) ka[p] = *(const LAS bf16x8*)(lds + O_KDT + (16 * w + c) * S64 + (32 * p + 8 * g) * 2);
#pragma unroll
            for (int et = 0; et < 4; ++et) {
#pragma unroll
                for (int i = 0; i < 4; ++i) S[et][i] *= dec[i];
#pragma unroll
                for (int p = 0; p < 2; ++p) { const bf16x8 vb = *(const LAS bf16x8*)(lds + O_VT + (16 * et + c) * S64 + (32 * p + 8 * g) * 2); S[et] = mfma_bf16(ka[p], vb, S[et]); }
                v2u o; o.x = pk2(S[et][0], S[et][1]); o.y = pk2(S[et][2], S[et][3]);
                *(LAS v2u*)(stn + (16 * et + c) * S128 + (16 * w + 4 * g) * 2) = o;
            }
        }
        cur ^= 1;
        __syncthreads();
    }
#undef SCAN_LOAD
}
__device__ __forceinline__ f32x2v cmul(f32x2v a, f32x2v b) { return (f32x2v){a.x * b.x - a.y * b.y, a.x * b.y + a.y * b.x}; }
__device__ __forceinline__ f32x2v twid(float turns) { return (f32x2v){__builtin_amdgcn_cosf(turns), __builtin_amdgcn_sinf(turns)}; }
__device__ __forceinline__ int rev4_14(int p) { const unsigned y = __brev((unsigned)p) >> 18; return (int)(((y & 0x1555u) << 1) | ((y >> 1) & 0x1555u)); }

template <int S>
__device__ __forceinline__ void fft_fwd_stage(LAS f32x2v* x, int tid) {
    constexpr int M = FFTN >> (2 * S), Q = M / 4;
#pragma unroll 2
    for (int i = 0; i < 8; ++i) {
        const int bf = tid + 512 * i, blk = bf / Q, k = bf % Q, base = blk * M + k;
        const f32x2v a0 = x[base], a1 = x[base + Q], a2 = x[base + 2 * Q], a3 = x[base + 3 * Q];
        const f32x2v b0 = a0 + a2, b1 = a0 - a2, b2 = a1 + a3, t = a1 - a3, b3 = (f32x2v){t.y, -t.x};
        f32x2v y0 = b0 + b2, y1 = b1 + b3, y2 = b0 - b2, y3 = b1 - b3;
        if (Q > 1) { const float ang = -(float)k * (1.0f / (float)M); y1 = cmul(y1, twid(ang)); y2 = cmul(y2, twid(2.0f * ang)); y3 = cmul(y3, twid(3.0f * ang)); }
        x[base] = y0; x[base + Q] = y1; x[base + 2 * Q] = y2; x[base + 3 * Q] = y3;
    }
    __syncthreads();
}
template <int S>
__device__ __forceinline__ void fft_inv_stage(LAS f32x2v* x, int tid) {
    constexpr int M = FFTN >> (2 * S), Q = M / 4;
#pragma unroll 2
    for (int i = 0; i < 8; ++i) {
        const int bf = tid + 512 * i, blk = bf / Q, k = bf % Q, base = blk * M + k;
        f32x2v a0 = x[base], a1 = x[base + Q], a2 = x[base + 2 * Q], a3 = x[base + 3 * Q];
        if (Q > 1) { const float ang = (float)k * (1.0f / (float)M); a1 = cmul(a1, twid(ang)); a2 = cmul(a2, twid(2.0f * ang)); a3 = cmul(a3, twid(3.0f * ang)); }
        const f32x2v b0 = a0 + a2, b1 = a0 - a2, b2 = a1 + a3, t = a1 - a3, b3 = (f32x2v){-t.y, t.x};
        x[base] = b0 + b2; x[base + Q] = b1 + b3; x[base + 2 * Q] = b0 - b2; x[base + 3 * Q] = b1 - b3;
    }
    __syncthreads();
}
__device__ __forceinline__ void fft_fwd(LAS f32x2v* x, int tid) { fft_fwd_stage<0>(x, tid); fft_fwd_stage<1>(x, tid); fft_fwd_stage<2>(x, tid); fft_fwd_stage<3>(x, tid); fft_fwd_stage<4>(x, tid); fft_fwd_stage<5>(x, tid); fft_fwd_stage<6>(x, tid); }
__device__ __forceinline__ void fft_inv(LAS f32x2v* x, int tid) { fft_inv_stage<6>(x, tid); fft_inv_stage<5>(x, tid); fft_inv_stage<4>(x, tid); fft_inv_stage<3>(x, tid); fft_inv_stage<2>(x, tid); fft_inv_stage<1>(x, tid); fft_inv_stage<0>(x, tid); }
__device__ __forceinline__ void spec_mul(LAS f32x2v* x, const f32x2v* ks, float kny, int tid) {
#pragma unroll 2
    for (int i = 0; i < 16; ++i) {
        const int idx = tid + 512 * i, p = (idx >> 1) * 4 + (idx & 1), f = rev4_14(p), pp = rev4_14((FFTN - f) & (FFTN - 1));
        const f32x2v k = ks[idx];
        const f32x2v xp = x[p], xq = x[pp];
        x[p] = cmul(xp, k);
        if (pp != p) x[pp] = cmul(xq, (f32x2v){k.x, -k.y});
        if (idx == 0) { const f32x2v x2 = x[2]; x[2] = x2 * kny; }
    }
    __syncthreads();
}
__device__ __forceinline__ float block_sum2(LAS float* red, float v, int tid, int wave, int lane, int slot) {
    v = wave_sum(v); if (lane == 0) red[slot * 8 + wave] = v; __syncthreads();
    float s = 0.f;
#pragma unroll
    for (int i = 0; i < 8; ++i) s += red[slot * 8 + i];
    return s;
}
__device__ __forceinline__ void hyena_unit(Frame& F, int ch) {
    PHASE_LOCALS
    LAS f32x2v* cb = (LAS f32x2v*)F.lds;
    LAS float* cbf = (LAS float*)F.lds;
    LAS float* w3c = (LAS float*)(F.lds + 131072);
    LAS float* red = (LAS float*)(F.lds + 131072 + 1024);
    const bf16* UT = (const bf16*)F.out; bf16* HYO = (bf16*)(F.ws + WS_H);
    const float* hdnL = (const float*)(F.ws + WS_HDNL); const float* hdnC = (const float*)(F.ws + WS_HDNC);
    unsigned char* hs = F.ws + WS_ACT + (size_t)F.bx * HYS_BYTES;
    f32x2v* KA = (f32x2v*)hs; f32x2v* KB = (f32x2v*)(hs + 65536); f32x2v* ZS = (f32x2v*)(hs + 131072); float* KX = (float*)(hs + 196608);
    const float bias0 = F.in[20][ch], bias1 = F.in[20][1024 + ch];
    const float delta = fabsf(-3.0701134573253945f + (-15.350567286626972f + 3.0701134573253945f) * ((float)ch / 1023.0f));
    const bf16* uz = UT + (size_t)ch * NROW; const bf16* ug1 = UT + (size_t)(1024 + ch) * NROW; const bf16* ug2 = UT + (size_t)(2048 + ch) * NROW;
    bf16* ho = HYO + (size_t)ch * NROW;
    __syncthreads();
    if (tid < 256) { const int q = tid >> 6, j = tid & 63; w3c[tid] = F.in[19][(size_t)j * 4096 + q * 1024 + ch]; }
    __syncthreads();
    {
        LAS float* kf = cbf;
        LAS float* zc = cbf + 1024;
        LAS float* g1c = cbf + 1536; LAS float* g2c = cbf + 2048; LAS float* y1c = cbf + 2560;
        float s0 = 0.f, s1 = 0.f;
        if (tid < 256) {
            const int l = tid; const float* hr = hdnC + l * 64; float a[4] = {0.f, 0.f, 0.f, 0.f};
#pragma unroll 4
            for (int jj = 0; jj < 16; ++jj) { const f32x4 hv = *(const f32x4*)(hr + 4 * jj);
#pragma unroll
                for (int q = 0; q < 4; ++q) { const f32x4 wv = *(const LAS f32x4*)(w3c + q * 64 + 4 * jj); a[q] += hv[0] * wv[0] + hv[1] * wv[1] + hv[2] * wv[2] + hv[3] * wv[3]; } }
            const float mult = __expf(-((float)l / 255.0f) * delta) + 0.05f;
#pragma unroll
            for (int q = 0; q < 4; ++q) { a[q] *= mult; kf[q * 256 + l] = a[q]; }
            s0 = fabsf(a[0]) + (l >= 1 ? fabsf(a[1]) : 0.f); s1 = fabsf(a[2]) + (l >= 1 ? fabsf(a[3]) : 0.f);
        }
        zc[tid] = bf2f(uz[tid]); g1c[tid] = bf2f(ug1[tid]); g2c[tid] = bf2f(ug2[tid]);
        const float n0 = block_sum2(red, s0, tid, wave, lane, 0), n1 = block_sum2(red, s1, tid, wave, lane, 1);
        const int bb = tid >> 8, t = tid & 255;
        float y = 0.f;
        for (int sidx = 0; sidx < 256; ++sidx) { const int m = t - sidx; const float kv = m >= 0 ? kf[m] : kf[256 - m]; y += kv * zc[bb * 256 + sidx]; }
        const float y1 = g1c[tid] * (y / n0 + zc[tid] * bias0);
        y1c[tid] = y1;
        __syncthreads();
        y = 0.f;
        for (int sidx = 0; sidx < 256; ++sidx) { const int m = t - sidx; const float kv = m >= 0 ? kf[512 + m] : kf[768 - m]; y += kv * y1c[bb * 256 + sidx]; }
        const float o = g2c[tid] * (y / n1 + y1 * bias1);
        ho[tid] = (bf16)f2bf(o);
        __syncthreads();
    }
    {
        float s0 = 0.f, s1 = 0.f;
#pragma unroll 1
        for (int i = 0; i < 16; ++i) {
            const int l = tid + 512 * i; const float* hr = hdnL + (size_t)l * 64; float a[4] = {0.f, 0.f, 0.f, 0.f};
#pragma unroll 2
            for (int jj = 0; jj < 16; ++jj) { const f32x4 hv = *(const f32x4*)(hr + 4 * jj);
#pragma unroll
                for (int q = 0; q < 4; ++q) { const f32x4 wv = *(const LAS f32x4*)(w3c + q * 64 + 4 * jj); a[q] += hv[0] * wv[0] + hv[1] * wv[1] + hv[2] * wv[2] + hv[3] * wv[3]; } }
            const float mult = __expf(-((float)l / 8191.0f) * delta) + 0.05f;
#pragma unroll
            for (int q = 0; q < 4; ++q) a[q] *= mult;
            cb[l] = (f32x2v){a[0], a[2]};
            if (l >= 1) { cb[FFTN - l] = (f32x2v){a[1], a[3]}; s0 += fabsf(a[1]); s1 += fabsf(a[3]); } else cb[8192] = (f32x2v){0.f, 0.f};
            s0 += fabsf(a[0]); s1 += fabsf(a[2]);
        }
        const float n0 = block_sum2(red, s0, tid, wave, lane, 2), n1 = block_sum2(red, s1, tid, wave, lane, 3);
        fft_fwd(cb, tid);
        const float sc0 = 1.0f / (n0 * (float)FFTN), sc1 = 1.0f / (n1 * (float)FFTN);
#pragma unroll 2
        for (int i = 0; i < 16; ++i) {
            const int idx = tid + 512 * i, p = (idx >> 1) * 4 + (idx & 1), f = rev4_14(p), pp = rev4_14((FFTN - f) & (FFTN - 1));
            const f32x2v zf = cb[p], zq = cb[pp]; const f32x2v zc = (f32x2v){zq.x, -zq.y};
            const f32x2v sm = zf + zc, df = zf - zc;
            KA[idx] = sm * (0.5f * sc0); KB[idx] = (f32x2v){df.y, -df.x} * (0.5f * sc1);
            if (idx == 0) { const f32x2v z2 = cb[2]; KX[0] = z2.x * sc0; KX[1] = z2.y * sc1; }
        }
        __syncthreads();
    }
    const float kny0 = KX[0], kny1 = KX[1];
#pragma unroll 1
    for (int i = 0; i < 2; ++i) {
        const int t8 = (tid + 512 * i) * 8;
        const v4u a = *(const v4u*)(uz + NCTX + t8), b = *(const v4u*)(uz + NCTX + SEQ + t8);
        const unsigned av[4] = {a.x, a.y, a.z, a.w}, bv[4] = {b.x, b.y, b.z, b.w};
#pragma unroll
        for (int q = 0; q < 4; ++q) { cb[t8 + 2 * q] = (f32x2v){bflo(av[q]), bflo(bv[q])}; cb[t8 + 2 * q + 1] = (f32x2v){bfhi(av[q]), bfhi(bv[q])};
            cb[8192 + t8 + 2 * q] = (f32x2v){0.f, 0.f}; cb[8192 + t8 + 2 * q + 1] = (f32x2v){0.f, 0.f}; }
    }
    __syncthreads();
    fft_fwd(cb, tid); spec_mul(cb, KA, kny0, tid); fft_inv(cb, tid);
#pragma unroll 1
    for (int i = 0; i < 2; ++i) {
        const int t8 = (tid + 512 * i) * 8;
        const v4u a = *(const v4u*)(uz + NCTX + t8), b = *(const v4u*)(uz + NCTX + SEQ + t8), ga = *(const v4u*)(ug1 + NCTX + t8), gb = *(const v4u*)(ug1 + NCTX + SEQ + t8);
        const unsigned av[4] = {a.x, a.y, a.z, a.w}, bv[4] = {b.x, b.y, b.z, b.w}, gav[4] = {ga.x, ga.y, ga.z, ga.w}, gbv[4] = {gb.x, gb.y, gb.z, gb.w};
#pragma unroll
        for (int q = 0; q < 8; ++q) {
            const float z0 = (q & 1) ? bfhi(av[q >> 1]) : bflo(av[q >> 1]), z1 = (q & 1) ? bfhi(bv[q >> 1]) : bflo(bv[q >> 1]);
            const float g0 = (q & 1) ? bfhi(gav[q >> 1]) : bflo(gav[q >> 1]), g1 = (q & 1) ? bfhi(gbv[q >> 1]) : bflo(gbv[q >> 1]);
            const f32x2v cv = cb[t8 + q];
            const f32x2v y = (f32x2v){g0 * (cv.x + z0 * bias0), g1 * (cv.y + z1 * bias0)};
            cb[t8 + q] = y; ZS[t8 + q] = y; cb[8192 + t8 + q] = (f32x2v){0.f, 0.f};
        }
    }
    __syncthreads();
    fft_fwd(cb, tid); spec_mul(cb, KB, kny1, tid); fft_inv(cb, tid);
#pragma unroll 1
    for (int i = 0; i < 2; ++i) {
        const int t8 = (tid + 512 * i) * 8;
        const v4u ga = *(const v4u*)(ug2 + NCTX + t8), gb = *(const v4u*)(ug2 + NCTX + SEQ + t8);
        const unsigned gav[4] = {ga.x, ga.y, ga.z, ga.w}, gbv[4] = {gb.x, gb.y, gb.z, gb.w};
        float o0[8], o1[8];
#pragma unroll
        for (int q = 0; q < 8; ++q) {
            const float g0 = (q & 1) ? bfhi(gav[q >> 1]) : bflo(gav[q >> 1]), g1 = (q & 1) ? bfhi(gbv[q >> 1]) : bflo(gbv[q >> 1]);
            const f32x2v cv = cb[t8 + q], y1 = ZS[t8 + q];
            o0[q] = g0 * (cv.x + y1.x * bias1); o1[q] = g1 * (cv.y + y1.y * bias1);
        }
        v4u w0, w1; w0.x = pk2(o0[0], o0[1]); w0.y = pk2(o0[2], o0[3]); w0.z = pk2(o0[4], o0[5]); w0.w = pk2(o0[6], o0[7]);
        w1.x = pk2(o1[0], o1[1]); w1.y = pk2(o1[2], o1[3]); w1.z = pk2(o1[4], o1[5]); w1.w = pk2(o1[6], o1[7]);
        *(v4u*)(ho + NCTX + t8) = w0; *(v4u*)(ho + NCTX + SEQ + t8) = w1;
    }
    __syncthreads();
}
__device__ __forceinline__ void attn_unit(Frame& F, int unit) {
    const int qb = unit & 127, kvh = (unit >> 7) & 1, b = unit >> 8;
    PHASE_LOCALS
    const int w = wave, l = lane, g = l >> 4, c = l & 15;
    const int hq = w >> 1, th = w & 1, head = kvh * 4 + hq, q0 = qb * 64;
    LAS unsigned char* lds = F.lds;
    constexpr int O_KT = 0, O_VT = 17408;
    const bf16* Z = (const bf16*)(F.ws + WS_Z); bf16* MIX = (bf16*)(F.ws + WS_MIX);
    bf16x8 qf[2][4];
#pragma unroll
    for (int it = 0; it < 2; ++it)
#pragma unroll
        for (int ks = 0; ks < 4; ++ks) qf[it][ks] = *(const bf16x8*)(Z + (size_t)(NCTX + b * SEQ + q0 + 32 * th + 16 * it + c) * ODC + 3072 + head * 128 + 32 * ks + 8 * g);
    const float sink = F.in[26][head];
    float m_run[2] = {sink, sink}, l_run[2] = {1.f, 1.f};
    f32x4 Oa[8][2];
#pragma unroll
    for (int dt = 0; dt < 8; ++dt) { Oa[dt][0] = (f32x4){0.f, 0.f, 0.f, 0.f}; Oa[dt][1] = (f32x4){0.f, 0.f, 0.f, 0.f}; }
#pragma unroll 1
    for (int kt = 0; kt < 9; ++kt) {
        __syncthreads();
#pragma unroll
        for (int i = 0; i < 2; ++i) {
            const int idx = tid + 512 * i, key = idx >> 4, chn = idx & 15;
            int row; bool valid = true;
            if (kt < 4) row = b * CTXL + 64 * kt + key;
            else { const int pos = q0 - 128 + 64 * (kt - 4) + key; valid = pos >= 0 && pos < SEQ; row = NCTX + b * SEQ + pos; }
            v4u kv = {0u, 0u, 0u, 0u}, vv = {0u, 0u, 0u, 0u};
            if (valid) { const bf16* zr = Z + (size_t)row * ODC; kv = *(const v4u*)(zr + 4096 + kvh * 128 + chn * 8); vv = *(const v4u*)(zr + 4352 + kvh * 128 + chn * 8); }
            *(LAS v4u*)(lds + O_KT + key * 272 + chn * 16) = kv;
            const unsigned vw[4] = {vv.x, vv.y, vv.z, vv.w};
#pragma unroll
            for (int q = 0; q < 4; ++q) {
                *(LAS unsigned short*)(lds + O_VT + (chn * 8 + 2 * q) * 144 + key * 2) = (unsigned short)(vw[q] & 0xffffu);
                *(LAS unsigned short*)(lds + O_VT + (chn * 8 + 2 * q + 1) * 144 + key * 2) = (unsigned short)(vw[q] >> 16); }
        }
        __syncthreads();
        f32x4 sa[4][2];
#pragma unroll
        for (int jt = 0; jt < 4; ++jt) {
            sa[jt][0] = (f32x4){0.f, 0.f, 0.f, 0.f}; sa[jt][1] = (f32x4){0.f, 0.f, 0.f, 0.f};
#pragma unroll
            for (int ks = 0; ks < 4; ++ks) { const bf16x8 a = *(const LAS bf16x8*)(lds + O_KT + (16 * jt + c) * 272 + (32 * ks + 8 * g) * 2);
                sa[jt][0] = mfma_bf16(a, qf[0][ks], sa[jt][0]); sa[jt][1] = mfma_bf16(a, qf[1][ks], sa[jt][1]); }
        }
        if (kt >= 4) {
#pragma unroll
            for (int jt = 0; jt < 4; ++jt)
#pragma unroll
                for (int it = 0; it < 2; ++it)
#pragma unroll
                    for (int r = 0; r < 4; ++r) {
                        const int kpos = q0 - 128 + 64 * (kt - 4) + 16 * jt + 4 * g + r, qpos = q0 + 32 * th + 16 * it + c, d = qpos - kpos;
                        const bool ok = kpos >= 0 && kpos < SEQ && d <= 128 && d >= -128;
                        sa[jt][it][r] = ok ? sa[jt][it][r] : -1.0e30f;
                    }
        }
        bf16x8 P[2][2];
#pragma unroll
        for (int it = 0; it < 2; ++it) {
            float mx = -3.0e38f;
#pragma unroll
            for (int jt = 0; jt < 4; ++jt)
#pragma unroll
                for (int r = 0; r < 4; ++r) mx = fmaxf(mx, sa[jt][it][r]);
            mx = fmaxf(mx, __shfl_xor(mx, 16)); mx = fmaxf(mx, __shfl_xor(mx, 32));
            const float mn = fmaxf(m_run[it], mx), alpha = __expf(m_run[it] - mn);
            float rs = 0.f;
#pragma unroll
            for (int jt = 0; jt < 4; ++jt)
#pragma unroll
                for (int r = 0; r < 4; ++r) { const float p = __expf(sa[jt][it][r] - mn); sa[jt][it][r] = p; rs += p; }
            rs += __shfl_xor(rs, 16); rs += __shfl_xor(rs, 32);
            l_run[it] = l_run[it] * alpha + rs; m_run[it] = mn;
#pragma unroll
            for (int dt = 0; dt < 8; ++dt) Oa[dt][it] *= alpha;
#pragma unroll
            for (int p2 = 0; p2 < 2; ++p2) { v4u t4; t4.x = pk2(sa[2 * p2][it][0], sa[2 * p2][it][1]); t4.y = pk2(sa[2 * p2][it][2], sa[2 * p2][it][3]);
                t4.z = pk2(sa[2 * p2 + 1][it][0], sa[2 * p2 + 1][it][1]); t4.w = pk2(sa[2 * p2 + 1][it][2], sa[2 * p2 + 1][it][3]); P[p2][it] = __builtin_bit_cast(bf16x8, t4); }
        }
#pragma unroll
        for (int dt = 0; dt < 8; ++dt)
#pragma unroll
            for (int p2 = 0; p2 < 2; ++p2) {
                const v2u lo = *(const LAS v2u*)(lds + O_VT + (16 * dt + c) * 144 + (32 * p2 + 4 * g) * 2), hi = *(const LAS v2u*)(lds + O_VT + (16 * dt + c) * 144 + (32 * p2 + 16 + 4 * g) * 2);
                v4u a4; a4.x = lo.x; a4.y = lo.y; a4.z = hi.x; a4.w = hi.y; const bf16x8 a = __builtin_bit_cast(bf16x8, a4);
                Oa[dt][0] = mfma_bf16(a, P[p2][0], Oa[dt][0]); Oa[dt][1] = mfma_bf16(a, P[p2][1], Oa[dt][1]);
            }
    }
#pragma unroll
    for (int it = 0; it < 2; ++it) {
        const float inv = 1.0f / l_run[it];
        bf16* orow = MIX + (size_t)(NCTX + b * SEQ + q0 + 32 * th + 16 * it + c) * DM + 1024 + head * 128 + 4 * g;
#pragma unroll
        for (int dt = 0; dt < 8; ++dt) { const f32x4 o = Oa[dt][it] * inv; v2u wv; wv.x = pk2(o[0], o[1]); wv.y = pk2(o[2], o[3]); *(v2u*)(orow + 16 * dt) = wv; }
    }
}
constexpr int N_PHASES = 23;
constexpr int QSLOT_OFF = LDSCTL_OFF + 256;

__global__ void __launch_bounds__(NTHR, 2) mk_fwd(Args args) {
    extern __shared__ __attribute__((aligned(16))) unsigned char lds_raw[];
    Frame F;
    F.lds = (LAS unsigned char*)lds_raw;
    F.G = gridDim.x; F.bx = blockIdx.x; F.NGW = F.G * NWAVES;
    F.in = (const float* const __attribute__((address_space(4)))*)__builtin_amdgcn_kernarg_segment_ptr();
    F.out = args.out; F.ws = args.ws;
    for (int u = threadIdx.x; u < (LDS_BYTES - LDSCTL_OFF) / 4; u += NTHR) ((LAS unsigned*)(F.lds + LDSCTL_OFF))[u] = 0u;
    __syncthreads();
    const int lo = args.ph_lo, hi = args.ph_hi;
    XcdBarrier bar; bar.bar = (unsigned*)(F.ws + WS_CTL) + CW_BAR; bar.x = 0; bar.st = nullptr;
    if (hi - lo > 1) bar = xcd_barrier_post((unsigned*)(F.ws + WS_CTL) + CW_BAR, (volatile LAS unsigned*)(F.lds + MISC_OFF) + 8);
#ifndef PHASE_ENABLE
#define PHASE_ENABLE 0xFFFFFFFFu
#endif
#ifndef MIX_EN
#define MIX_EN 15
#endif
#define EN(s) (((PHASE_ENABLE) >> (s)) & 1u)
#define IN(k) (lo <= (k) && (k) < hi)
#define SEAM(k) do { if (IN(k) && IN((k) + 1)) xcd_barrier(bar); } while (0)
    unsigned char* ws = F.ws;
    float* X = (float*)(ws + WS_X); bf16* H = (bf16*)(ws + WS_H); bf16* Zb = (bf16*)(ws + WS_Z); bf16* MIX = (bf16*)(ws + WS_MIX); bf16* ACT = (bf16*)(ws + WS_ACT);
    const float* mod = (const float*)(ws + WS_MOD);
    const LAS int* toff = (const LAS int*)(F.lds + TOFF_OFF);

    if (EN(0) && IN(0)) phase_pre(F);
    SEAM(0);
    if (EN(1) && IN(1)) phase_modfin(F);
    SEAM(1);
    {
        constexpr int layer = 0;
        const int pb = 2 + 10 * layer;
        if (EN(2) && IN(pb)) { if (layer == 0) phase_norm<0>(F, 0); else phase_norm<1>(F, 1); }
        SEAM(pb);
        if (EN(3) && IN(pb + 1)) {
            const int N = layer ? ODC : EVN;
            pg8::Gemm g{H, (const bf16*)(ws + (layer ? WS_WIN1 : WS_WIN0)), NROW, N, DM}; pg8::StaticOrder S; S.init(NROW, N, F.G, F.bx);
            pg8::EpiStore E{Zb, layer ? ODC : ZC0, 0x7fffffff, layer ? 18 : 24, (float*)(ws + WS_LR)};
            pg8::gemm_phase<pg8::EpiStore, pg8::StaticOrder, true, true>(F.lds, g, S, E);
        }
        SEAM(pb + 1);
        if (EN(4) && IN(pb + 2)) { if (layer == 0) phase_ht(F); else phase_prep(F); }
        SEAM(pb + 2);
        if (EN(5) && IN(pb + 3)) {
            unsigned* qhead = (unsigned*)(ws + WS_CTL) + (layer == 0 ? CW_HYQ : CW_ATQ);
            const int nunits = layer == 0 ? 1024 : 512;
            for (int u = F.bx; u < 64; u += F.G) { __syncthreads(); if (layer == 0) { if (MIX_EN & 1) scan_unit<true>(F, u); } else { if (MIX_EN & 2) scan_unit<false>(F, u); } }
            for (;;) {
                __syncthreads();
                if (threadIdx.x == 0) *(LAS int*)(F.lds + QSLOT_OFF) = (int)__hip_atomic_fetch_add(qhead, 1u, __ATOMIC_RELAXED, __HIP_MEMORY_SCOPE_AGENT);
                __syncthreads();
                const int u = *(LAS int*)(F.lds + QSLOT_OFF);
                if (u >= nunits) break;
                if (layer == 0) { if (MIX_EN & 4) hyena_unit(F, u); } else { if (MIX_EN & 8) attn_unit(F, u); }
            }
            __syncthreads();
        }
        SEAM(pb + 3);
        if (EN(6) && IN(pb + 4)) {
            if (layer == 0) { merge_heads(F, F.in[12], ZC0, 0); __syncthreads(); merge_hyena(F); }
            else merge_heads(F, F.in[23], ODC, NCTX);
        }
        SEAM(pb + 4);
        if (EN(7) && IN(pb + 5)) {
            const int row_off = layer ? NCTX : 0, M = NROW - row_off;
            pg8::Gemm g{MIX + (size_t)row_off * DM, (const bf16*)(ws + (layer ? WS_WOUT1 : WS_WOUT0)), M, DM, DM}; pg8::StaticOrder S; S.init(M, DM, F.G, F.bx);
            const float* gb = mod + (size_t)layer * 3 * 12288 + 2 * DM;
            pg8::EpiOut E{X, row_off, gb};
            pg8::gemm_phase<pg8::EpiOut, pg8::StaticOrder, true, true>(F.lds, g, S, E);
        }
        SEAM(pb + 5);
        if (EN(8) && IN(pb + 6)) phase_route(F, layer);
        SEAM(pb + 6);
        if (EN(9) && IN(pb + 7)) phase_gather(F, layer);
        SEAM(pb + 7);
        if (EN(10) && IN(pb + 8)) {
            moe_offsets(F, layer);
            pg8::Gemm g{Zb, (const bf16*)(ws + WS_WM13) + (size_t)layer * 16 * 2048 * DM, 0, 0, DM};
            pg8::MoeOrder S{F.G, F.bx, toff[16], toff}; pg8::EpiMoe1 E{ACT};
            pg8::gemm_phase<pg8::EpiMoe1, pg8::MoeOrder, true, true>(F.lds, g, S, E);
        }
        SEAM(pb + 8);
        if (EN(11) && IN(pb + 9)) {
            moe_offsets(F, layer);
            pg8::Gemm g{ACT, (const bf16*)(ws + WS_WM2) + (size_t)layer * 16 * 2048 * DFF, 0, 0, DFF};
            pg8::MoeOrder S{F.G, F.bx, toff[16], toff}; pg8::EpiStore E{(bf16*)(ws + WS_W), DM, 7, 8, nullptr};
            pg8::gemm_phase<pg8::EpiStore, pg8::MoeOrder, true, true>(F.lds, g, S, E);
        }
        SEAM(pb + 9);
        }
    {
        constexpr int layer = 1;
        const int pb = 2 + 10 * layer;
        if (EN(2) && IN(pb)) { if (layer == 0) phase_norm<0>(F, 0); else phase_norm<1>(F, 1); }
        SEAM(pb);
        if (EN(3) && IN(pb + 1)) {
            const int N = layer ? ODC : EVN;
            pg8::Gemm g{H, (const bf16*)(ws + (layer ? WS_WIN1 : WS_WIN0)), NROW, N, DM}; pg8::StaticOrder S; S.init(NROW, N, F.G, F.bx);
            pg8::EpiStore E{Zb, layer ? ODC : ZC0, 0x7fffffff, layer ? 18 : 24, (float*)(ws + WS_LR)};
            pg8::gemm_phase<pg8::EpiStore, pg8::StaticOrder, true, true>(F.lds, g, S, E);
        }
        SEAM(pb + 1);
        if (EN(4) && IN(pb + 2)) { if (layer == 0) phase_ht(F); else phase_prep(F); }
        SEAM(pb + 2);
        if (EN(5) && IN(pb + 3)) {
            unsigned* qhead = (unsigned*)(ws + WS_CTL) + (layer == 0 ? CW_HYQ : CW_ATQ);
            const int nunits = layer == 0 ? 1024 : 512;
            for (int u = F.bx; u < 64; u += F.G) { __syncthreads(); if (layer == 0) { if (MIX_EN & 1) scan_unit<true>(F, u); } else { if (MIX_EN & 2) scan_unit<false>(F, u); } }
            for (;;) {
                __syncthreads();
                if (threadIdx.x == 0) *(LAS int*)(F.lds + QSLOT_OFF) = (int)__hip_atomic_fetch_add(qhead, 1u, __ATOMIC_RELAXED, __HIP_MEMORY_SCOPE_AGENT);
                __syncthreads();
                const int u = *(LAS int*)(F.lds + QSLOT_OFF);
                if (u >= nunits) break;
                if (layer == 0) { if (MIX_EN & 4) hyena_unit(F, u); } else { if (MIX_EN & 8) attn_unit(F, u); }
            }
            __syncthreads();
        }
        SEAM(pb + 3);
        if (EN(6) && IN(pb + 4)) {
            if (layer == 0) { merge_heads(F, F.in[12], ZC0, 0); __syncthreads(); merge_hyena(F); }
            else merge_heads(F, F.in[23], ODC, NCTX);
        }
        SEAM(pb + 4);
        if (EN(7) && IN(pb + 5)) {
            const int row_off = layer ? NCTX : 0, M = NROW - row_off;
            pg8::Gemm g{MIX + (size_t)row_off * DM, (const bf16*)(ws + (layer ? WS_WOUT1 : WS_WOUT0)), M, DM, DM}; pg8::StaticOrder S; S.init(M, DM, F.G, F.bx);
            const float* gb = mod + (size_t)layer * 3 * 12288 + 2 * DM;
            pg8::EpiOut E{X, row_off, gb};
            pg8::gemm_phase<pg8::EpiOut, pg8::StaticOrder, true, true>(F.lds, g, S, E);
        }
        SEAM(pb + 5);
        if (EN(8) && IN(pb + 6)) phase_route(F, layer);
        SEAM(pb + 6);
        if (EN(9) && IN(pb + 7)) phase_gather(F, layer);
        SEAM(pb + 7);
        if (EN(10) && IN(pb + 8)) {
            moe_offsets(F, layer);
            pg8::Gemm g{Zb, (const bf16*)(ws + WS_WM13) + (size_t)layer * 16 * 2048 * DM, 0, 0, DM};
            pg8::MoeOrder S{F.G, F.bx, toff[16], toff}; pg8::EpiMoe1 E{ACT};
            pg8::gemm_phase<pg8::EpiMoe1, pg8::MoeOrder, true, true>(F.lds, g, S, E);
        }
        SEAM(pb + 8);
        if (EN(11) && IN(pb + 9)) {
            moe_offsets(F, layer);
            pg8::Gemm g{ACT, (const bf16*)(ws + WS_WM2) + (size_t)layer * 16 * 2048 * DFF, 0, 0, DFF};
            pg8::MoeOrder S{F.G, F.bx, toff[16], toff}; pg8::EpiStore E{(bf16*)(ws + WS_W), DM, 7, 8, nullptr};
            pg8::gemm_phase<pg8::EpiStore, pg8::MoeOrder, true, true>(F.lds, g, S, E);
        }
        SEAM(pb + 9);
        }
    if (EN(12) && IN(22)) phase_norm<2>(F, 1);
#undef IN
#undef SEAM
}

extern "C" void kernel_launch(void* const* d_in, const int* in_sizes, int n_in, void* d_out, int out_size, void* d_ws, size_t ws_size, hipStream_t stream) {
    static int grid = 0;
    if (grid == 0) {
        if (n_in != 32 || out_size != NLAT * DM || ws_size < WS_END) { fprintf(stderr, "kernel_launch: unexpected shapes (n_in %d, out %d, ws %zu < %zu)\n", n_in, out_size, ws_size, (size_t)WS_END); grid = -1; return; }
        int dev = 0, cus = 0;
        if (hipGetDevice(&dev) != hipSuccess || hipDeviceGetAttribute(&cus, hipDeviceAttributeMultiprocessorCount, dev) != hipSuccess) { grid = -1; return; }
        if (hipFuncSetAttribute((const void*)mk_fwd, hipFuncAttributeMaxDynamicSharedMemorySize, LDS_BYTES) != hipSuccess) { fprintf(stderr, "kernel_launch: hipFuncSetAttribute failed\n"); grid = -1; return; }
        int per_cu = 0;
        if (hipOccupancyMaxActiveBlocksPerMultiprocessor(&per_cu, (const void*)mk_fwd, NTHR, LDS_BYTES) != hipSuccess || per_cu < 1) { fprintf(stderr, "kernel_launch: occupancy query says %d\n", per_cu); }
        (void)hipGetLastError();
        grid = cus;
    }
    if (grid < 0) return;
    if (hipMemsetAsync((char*)d_ws + WS_CTL, 0, CTL_ZERO_BYTES, stream) != hipSuccess) return;
    Args a{};
    for (int i = 0; i < 32; ++i) a.in[i] = (const float*)d_in[i];
    a.out = (float*)d_out; a.ws = (unsigned char*)d_ws;
#if MK_ONE_LAUNCH
    a.ph_lo = 0; a.ph_hi = N_PHASES;
    hipLaunchKernelGGL(mk_fwd, dim3(grid), dim3(NTHR), LDS_BYTES, stream, a);
#else
    for (int p = 0; p < N_PHASES; ++p) { a.ph_lo = p; a.ph_hi = p + 1; hipLaunchKernelGGL(mk_fwd, dim3(grid), dim3(NTHR), LDS_BYTES, stream, a); }
#endif
}
```

```cpp
#include <hip/hip_runtime.h>
#include <cstdio>
#include <cstdint>
#include <cmath>

#ifndef MK_ONE_LAUNCH
#define MK_ONE_LAUNCH 1
#endif
#ifndef SCAN_DPP
#define SCAN_DPP 1
#endif
namespace pg8 {
#define PG8_LAS __attribute__((address_space(3)))
typedef unsigned short bf16_t;
typedef short bf16x8 __attribute__((ext_vector_type(8)));
typedef float f32x4 __attribute__((ext_vector_type(4)));
typedef unsigned u32x4 __attribute__((ext_vector_type(4)));
constexpr int BM = 256, BK = 64, HALF = 128, HTB = HALF * BK * 2  , STAGE_BYTES = 8 * HTB, NXCD = 8, WGM = 8;

__host__ __device__ __forceinline__ int lds_byte(int r, int c) { const int st = (r >> 4) * 2 + (c >> 5), rr = r & 15, cc = c & 31, ob = rr * 64 + cc * 2; return st * 1024 + (ob ^ (((ob >> 9) & 1) << 5)); }
__host__ __device__ __forceinline__ void stage_rc(int b, int& R, int& C) { const int st = b / 1024, sb = b % 1024, swz = sb ^ (((sb >> 9) & 1) << 5); R = (st >> 1) * 16 + swz / 64; C = (st & 1) * 32 + (swz % 64) / 2; }
__host__ __device__ __forceinline__ int perm32(int rho) { const int n = rho >> 4, i = rho & 15; return 8 * (i >> 2) + 4 * n + (i & 3); }

struct Unit { int pm, pn; };
struct Gemm { const bf16_t* A; const bf16_t* Bt; int M, N, K; };

struct StaticOrder {
    int nM, nN, nwg, G, c;
    __host__ __device__ void init(int M, int N, int G_, int c_) { nM = M / BM; nN = N / BM; nwg = nM * nN; G = G_; c = c_; }
    __host__ __device__ bool next(int i, Unit& u) const {
        const long L = (long)i * G + c; if (L >= nwg) return false;
        int wgid = (int)L; { const int q = nwg / NXCD, r = nwg % NXCD, xcd = wgid % NXCD, off = wgid / NXCD; wgid = (xcd < r ? xcd * (q + 1) : r * (q + 1) + (xcd - r) * q) + off; }
        const int nig = WGM * nN, gid = wgid / nig, fm = gid * WGM, gsz = (nM - fm) < WGM ? (nM - fm) : WGM;
        u.pm = fm + ((wgid % nig) % gsz); u.pn = (wgid % nig) / gsz; return true;
    }
    __device__ __forceinline__ void a_ready(const Unit&) const {}
    __device__ __forceinline__ void done(const Unit&) const {}
};

__device__ __forceinline__ unsigned cvt_pk_bf16(float lo, float hi) { unsigned r; asm volatile("v_cvt_pk_bf16_f32 %0, %1, %2" : "=v"(r) : "v"(lo), "v"(hi)); return r; }
typedef float f32x2 __attribute__((ext_vector_type(2)));

template <class Epi, class Sched, bool ALIGN_EPI = false, bool SP2 = false>
__device__ __forceinline__ void gemm_phase(PG8_LAS unsigned char* lds, const Gemm g, const Sched& S, const Epi& E) {
    const int tid = threadIdx.x, wid = __builtin_amdgcn_readfirstlane(tid >> 6), lane = tid & 63, wr = wid >> 2, wc = wid & 3, fr = lane & 15, fq = lane >> 4;
    const int K = g.K, nt = K / BK;
    unsigned voffA[2], voffB[2];
#pragma unroll
    for (int i = 0; i < 2; ++i) { int R, C; stage_rc(tid * 16 + i * 8192, R, C); const int Rb = Epi::PERM ? ((R & ~31) + perm32(R & 31)) : R;
        voffA[i] = (unsigned)(R * K + C) * 2u; voffB[i] = (unsigned)(Rb * K + C) * 2u; }
    const size_t kstep = (size_t)(BK * 2);
    const size_t hstep = (size_t)HALF * K * 2;
    const size_t tstep = 2 * hstep;
    const unsigned ldsw = (unsigned)wid * 1024u;
    const int aoff = lds_byte(wr * 64 + fr, fq * 8), boff = lds_byte(wc * 32 + fr, fq * 8);
#define PG8_SA(b, h) (((b) * 2 + (h)) * HTB)
#define PG8_SB(b, h) ((4 + (b) * 2 + (h)) * HTB)
#define PG8_STAGE(bufoff, gbase, voff) do { _Pragma("unroll") for (int _i = 0; _i < 2; ++_i) \
        __builtin_amdgcn_global_load_lds((const unsigned*)((const char*)(gbase) + (voff)[_i]), (PG8_LAS unsigned*)(lds + (bufoff) + ldsw + _i * 8192), 16, 0, 0); } while (0)
#define PG8_LDA(dst, b, h) do { _Pragma("unroll") for (int m = 0; m < 4; ++m) _Pragma("unroll") for (int k = 0; k < 2; ++k) dst[m][k] = *(const PG8_LAS bf16x8*)(lds + PG8_SA(b, h) + aoff + m * 2048 + k * 1024); } while (0)
#define PG8_LDB(dst, b, h) do { _Pragma("unroll") for (int n = 0; n < 2; ++n) _Pragma("unroll") for (int k = 0; k < 2; ++k) dst[n][k] = *(const PG8_LAS bf16x8*)(lds + PG8_SB(b, h) + boff + n * 2048 + k * 1024); } while (0)
#define PG8_MMA(ai, bj, At, Bt) do { __builtin_amdgcn_s_setprio(1); _Pragma("unroll") for (int m = 0; m < 4; ++m) _Pragma("unroll") for (int n = 0; n < 2; ++n) _Pragma("unroll") for (int k = 0; k < 2; ++k) \
        acc[ai][bj][m][n] = __builtin_amdgcn_mfma_f32_16x16x32_bf16(Bt[n][k], At[m][k], acc[ai][bj][m][n], 0, 0, 0); __builtin_amdgcn_s_setprio(0); } while (0)
#define PG8_WAIT_V(n) asm volatile("s_waitcnt vmcnt(" #n ")" ::: "memory")
#define PG8_WAIT_L(n) asm volatile("s_waitcnt lgkmcnt(" #n ")" ::: "memory")
#define PG8_BAR __builtin_amdgcn_s_barrier()
#define PG8_SCHED __builtin_amdgcn_sched_barrier(0)
    Unit cur, nxt; int ui = 0;
    if (!S.next(0, cur)) return;
    f32x4 acc[2][2][4][2];
#pragma unroll
    for (int a = 0; a < 2; ++a)
#pragma unroll
        for (int b = 0; b < 2; ++b)
#pragma unroll
            for (int m = 0; m < 4; ++m)
#pragma unroll
                for (int n = 0; n < 2; ++n) acc[a][b][m][n] = (f32x4){0.f, 0.f, 0.f, 0.f};
    bf16x8 At[4][2], B0[2][2], B1[2][2];
    const char* cA = (const char*)g.A + (size_t)cur.pm * tstep; const char* cB = (const char*)g.Bt + (size_t)cur.pn * tstep;
    S.a_ready(cur);
    if constexpr (SP2) {
        PG8_STAGE(PG8_SB(0, 0), cB, voffB); PG8_STAGE(PG8_SB(0, 1), cB + hstep, voffB); PG8_STAGE(PG8_SA(0, 0), cA, voffA); PG8_STAGE(PG8_SA(0, 1), cA + hstep, voffA);
        if (wr == 1) PG8_BAR;
        PG8_WAIT_V(2); PG8_BAR;
        PG8_STAGE(PG8_SB(1, 0), cB + kstep, voffB); PG8_STAGE(PG8_SA(1, 0), cA + kstep, voffA); PG8_STAGE(PG8_SB(1, 1), cB + hstep + kstep, voffB);
        PG8_WAIT_V(6); PG8_BAR;
    } else {
        PG8_STAGE(PG8_SB(0, 0), cB, voffB); PG8_STAGE(PG8_SA(0, 0), cA, voffA); PG8_STAGE(PG8_SB(0, 1), cB + hstep, voffB); PG8_STAGE(PG8_SA(0, 1), cA + hstep, voffA);
        if (wr == 1) PG8_BAR;
        PG8_WAIT_V(4); PG8_BAR;
        PG8_STAGE(PG8_SB(1, 0), cB + kstep, voffB); PG8_STAGE(PG8_SA(1, 0), cA + kstep, voffA); PG8_STAGE(PG8_SB(1, 1), cB + hstep + kstep, voffB);
        PG8_WAIT_V(6); PG8_BAR;
    }
    for (;;) {
        const bool has_next = S.next(ui + 1, nxt);
        const char* nA = has_next ? (const char*)g.A + (size_t)nxt.pm * tstep : cA; const char* nB = has_next ? (const char*)g.Bt + (size_t)nxt.pn * tstep : cB;
        for (int t = 0; t < nt; t += 2) {
            const bool last = (t == nt - 2);
            const char* a1 = cA + (size_t)(t + 1) * kstep;
            const char* a2 = last ? nA : cA + (size_t)(t + 2) * kstep; const char* b2 = last ? nB : cB + (size_t)(t + 2) * kstep;
            const char* a3 = a2 + kstep; const char* b3 = b2 + kstep;
            if (last && has_next) S.a_ready(nxt);
            if constexpr (SP2) {
            PG8_LDB(B0, 0, 0); PG8_LDB(B1, 0, 1); PG8_SCHED; PG8_LDA(At, 0, 0); PG8_STAGE(PG8_SA(1, 1), a1 + hstep, voffA);
            PG8_WAIT_V(8); PG8_WAIT_L(0); PG8_BAR; PG8_MMA(0, 0, At, B0); PG8_MMA(0, 1, At, B1); PG8_BAR; PG8_SCHED;
            PG8_LDA(At, 0, 1); PG8_STAGE(PG8_SB(0, 0), b2, voffB); PG8_STAGE(PG8_SB(0, 1), b2 + hstep, voffB); PG8_STAGE(PG8_SA(0, 0), a2, voffA);
            PG8_WAIT_V(8); PG8_WAIT_L(0); PG8_BAR; PG8_MMA(1, 0, At, B0); PG8_MMA(1, 1, At, B1); PG8_BAR; PG8_SCHED;
            PG8_LDB(B0, 1, 0); PG8_LDB(B1, 1, 1); PG8_SCHED; PG8_LDA(At, 1, 0); PG8_STAGE(PG8_SA(0, 1), a2 + hstep, voffA);
            PG8_WAIT_V(8); PG8_WAIT_L(0); PG8_BAR; PG8_MMA(0, 0, At, B0); PG8_MMA(0, 1, At, B1); PG8_BAR; PG8_SCHED;
            PG8_LDA(At, 1, 1); PG8_STAGE(PG8_SB(1, 0), b3, voffB); PG8_STAGE(PG8_SB(1, 1), b3 + hstep, voffB); PG8_STAGE(PG8_SA(1, 0), a3, voffA);
            PG8_WAIT_V(8); PG8_WAIT_L(0); PG8_BAR; PG8_MMA(1, 0, At, B0); PG8_MMA(1, 1, At, B1); PG8_BAR; PG8_SCHED;
            } else {
            PG8_LDB(B0, 0, 0); PG8_SCHED; PG8_LDA(At, 0, 0); PG8_STAGE(PG8_SA(1, 1), a1 + hstep, voffA);
            PG8_WAIT_L(8); PG8_BAR; PG8_WAIT_L(0); PG8_MMA(0, 0, At, B0); PG8_BAR; PG8_SCHED;
            PG8_LDB(B1, 0, 1); PG8_STAGE(PG8_SB(0, 0), b2, voffB);
            PG8_BAR; PG8_WAIT_L(0); PG8_MMA(0, 1, At, B1); PG8_BAR;
            PG8_LDA(At, 0, 1); PG8_STAGE(PG8_SA(0, 0), a2, voffA);
            PG8_BAR; PG8_WAIT_L(0); PG8_MMA(1, 0, At, B0); PG8_BAR; PG8_SCHED;
            PG8_STAGE(PG8_SB(0, 1), b2 + hstep, voffB);
            PG8_WAIT_V(6); PG8_BAR; PG8_MMA(1, 1, At, B1); PG8_BAR;
            PG8_LDB(B0, 1, 0); PG8_SCHED; PG8_LDA(At, 1, 0); PG8_STAGE(PG8_SA(0, 1), a2 + hstep, voffA);
            PG8_WAIT_L(8); PG8_BAR; PG8_WAIT_L(0); PG8_MMA(0, 0, At, B0); PG8_BAR; PG8_SCHED;
            PG8_LDB(B1, 1, 1); PG8_STAGE(PG8_SB(1, 0), b3, voffB);
            PG8_BAR; PG8_WAIT_L(0); PG8_MMA(0, 1, At, B1); PG8_BAR;
            PG8_LDA(At, 1, 1); PG8_STAGE(PG8_SA(1, 0), a3, voffA);
            PG8_BAR; PG8_WAIT_L(0); PG8_MMA(1, 0, At, B0); PG8_BAR; PG8_SCHED;
            PG8_STAGE(PG8_SB(1, 1), b3 + hstep, voffB);
            PG8_WAIT_V(6); PG8_BAR; PG8_MMA(1, 1, At, B1); PG8_BAR;
            }
        }
        if constexpr (ALIGN_EPI) { if (wr == 0) PG8_BAR; }
        if constexpr (!Epi::AFTER_DRAIN) { E(acc, cur, wr, wc, fr, fq); S.done(cur); }
        if (!has_next) break;
#pragma unroll
        for (int a = 0; a < 2; ++a)
#pragma unroll
            for (int b = 0; b < 2; ++b)
#pragma unroll
                for (int m = 0; m < 4; ++m)
#pragma unroll
                    for (int n = 0; n < 2; ++n) acc[a][b][m][n] = (f32x4){0.f, 0.f, 0.f, 0.f};
        cur = nxt; cA = nA; cB = nB; ++ui;
        if constexpr (ALIGN_EPI) { if (wr == 1) PG8_BAR; }
    }
    PG8_WAIT_V(0);
    if constexpr (!ALIGN_EPI) { if (wr == 0) PG8_BAR; }
    PG8_BAR;
    if constexpr (Epi::AFTER_DRAIN) { E.fused(acc, cur, wr, wc, fr, fq, lds, wid, lane); S.done(cur); }
#undef PG8_SA
#undef PG8_SB
#undef PG8_STAGE
#undef PG8_LDA
#undef PG8_LDB
#undef PG8_MMA
#undef PG8_WAIT_V
#undef PG8_WAIT_L
#undef PG8_BAR
#undef PG8_SCHED
}
}
namespace pg8 {
struct EpiStore {
    static constexpr bool PERM = true, AFTER_DRAIN = false;
    bf16_t* O; int ldo; int pn_mask; int nz; float* LR;
    __device__ __forceinline__ void operator()(const f32x4 (&acc)[2][2][4][2], const Unit& u, int wr, int wc, int fr, int fq) const {
        const int row0 = u.pm * BM + wr * 64 + fr; const int ct = u.pn & pn_mask;
        if (ct < nz) {
            const int col0 = ct * BM + wc * 32 + 8 * fq;
#pragma unroll
            for (int ai = 0; ai < 2; ++ai)
#pragma unroll
                for (int m = 0; m < 4; ++m) { bf16_t* rowp = O + (size_t)(row0 + ai * HALF + m * 16) * ldo + col0;
#pragma unroll
                    for (int bj = 0; bj < 2; ++bj) { const f32x4 v0 = acc[ai][bj][m][0], v1 = acc[ai][bj][m][1];
                        u32x4 w; w.x = cvt_pk_bf16(v0[0], v0[1]); w.y = cvt_pk_bf16(v0[2], v0[3]); w.z = cvt_pk_bf16(v1[0], v1[1]); w.w = cvt_pk_bf16(v1[2], v1[3]);
                        *(u32x4*)(rowp + bj * HALF) = w; } }
        } else if (wc == 0) {
#pragma unroll
            for (int ai = 0; ai < 2; ++ai)
#pragma unroll
                for (int m = 0; m < 4; ++m) { float* rp = LR + (size_t)(row0 + ai * HALF + m * 16) * 32 + 8 * fq;
                    *(f32x4*)rp = acc[ai][0][m][0]; *(f32x4*)(rp + 4) = acc[ai][0][m][1]; }
        }
    }
};
struct EpiOut {
    static constexpr bool PERM = false, AFTER_DRAIN = false;
    float* X; int row_off; const float* gbase;
    const float* in_ctx; const float* in_lat;
    __device__ __forceinline__ void operator()(const f32x4 (&acc)[2][2][4][2], const Unit& u, int wr, int wc, int fr, int fq) const {
        const int rt = row_off + u.pm * BM; const int cls = rt < 512 ? 2 : (rt < 512 + 8192 ? 0 : 1); const float* gate = gbase + cls * 12288;
        const int row0 = rt + wr * 64 + fr, col0 = u.pn * BM + wc * 32 + 4 * fq;
        f32x4 gv[2][2];
#pragma unroll
        for (int bj = 0; bj < 2; ++bj)
#pragma unroll
            for (int n = 0; n < 2; ++n) gv[bj][n] = *(const f32x4*)(gate + col0 + bj * HALF + n * 16);
#pragma unroll
        for (int ai = 0; ai < 2; ++ai)
#pragma unroll
            for (int m = 0; m < 4; ++m) { const int rr = row0 + ai * HALF + m * 16; float* rowp = X + (size_t)rr * 2048 + col0;
                const float* srcp = in_lat ? (rt < 512 ? in_ctx + (size_t)rr * 2048 : in_lat + (size_t)(rr - 512) * 2048) + col0 : rowp;
#pragma unroll
                for (int bj = 0; bj < 2; ++bj)
#pragma unroll
                    for (int n = 0; n < 2; ++n) { const f32x4 o = *(const f32x4*)(srcp + bj * HALF + n * 16) + gv[bj][n] * acc[ai][bj][m][n]; *(f32x4*)(rowp + bj * HALF + n * 16) = o; }
                if (m == 3) asm volatile("" ::: "memory"); }
    }
};
struct EpiMoe1 {
    static constexpr bool PERM = true, AFTER_DRAIN = false;
    bf16_t* ACT;
    __device__ __forceinline__ void operator()(const f32x4 (&acc)[2][2][4][2], const Unit& u, int wr, int wc, int fr, int fq) const {
        const int row0 = u.pm * BM + wr * 64 + fr, col0 = (u.pn & 7) * HALF + wc * 32 + 8 * fq;
#pragma unroll
        for (int ai = 0; ai < 2; ++ai)
#pragma unroll
            for (int m = 0; m < 4; ++m) { float a[8];
#pragma unroll
                for (int n = 0; n < 2; ++n)
#pragma unroll
                    for (int j = 0; j < 4; ++j) { const float g = acc[ai][0][m][n][j], uu = acc[ai][1][m][n][j]; a[n * 4 + j] = g * __builtin_amdgcn_rcpf(1.0f + __expf(-g)) * uu; }
                u32x4 w; w.x = cvt_pk_bf16(a[0], a[1]); w.y = cvt_pk_bf16(a[2], a[3]); w.z = cvt_pk_bf16(a[4], a[5]); w.w = cvt_pk_bf16(a[6], a[7]);
                *(u32x4*)(ACT + (size_t)(row0 + ai * HALF + m * 16) * 1024 + col0) = w; }
    }
};
struct MoeOrder {
    int G, c, ntiles; const PG8_LAS int* toff;
    __device__ __forceinline__ bool next(int i, Unit& u) const {
        int pm, j;
        if (G == 256) { const int x = c & 7, q = c >> 3; pm = (i * 8 + (q >> 2)) * 4 + (x >> 1); j = (x & 1) * 4 + (q & 3); if (pm >= ntiles) return false; }
        else { const int L = i * G + c; if (L >= ntiles * 8) return false; pm = L >> 3; j = L & 7; }
        int e = 0;
#pragma unroll
        for (int k = 1; k < 16; ++k) e += (pm >= toff[k]) ? 1 : 0;
        u.pm = pm; u.pn = __builtin_amdgcn_readfirstlane(e * 8 + j); return true;
    }
    __device__ __forceinline__ void a_ready(const Unit&) const {}
    __device__ __forceinline__ void done(const Unit&) const {}
};
}
#define GAS __attribute__((address_space(1)))
#define LAS __attribute__((address_space(3)))
typedef unsigned short bf16;
typedef unsigned v4u __attribute__((ext_vector_type(4)));
typedef float f32x4 __attribute__((ext_vector_type(4)));
typedef short bf16x8 __attribute__((ext_vector_type(8)));
typedef GAS unsigned gu32;
typedef GAS unsigned long long gu64;
#define RLX_AGENT __ATOMIC_RELAXED, __HIP_MEMORY_SCOPE_AGENT
#define LDS_WAIT() asm volatile("s_waitcnt lgkmcnt(0)" ::: "memory")
#define VM_WAIT() asm volatile("s_waitcnt vmcnt(0)" ::: "memory")
__device__ __forceinline__ unsigned long long rt() { return __builtin_amdgcn_s_memrealtime(); }
__device__ __forceinline__ unsigned f2bf(float f) { unsigned u = __builtin_bit_cast(unsigned, f); return (u + 0x7fffu + ((u >> 16) & 1u)) >> 16; }
__device__ __forceinline__ unsigned pk2(float lo, float hi) { return f2bf(lo) | (f2bf(hi) << 16); }
#define XB_TMO      128
#define XB_XCNT(j)  (256  + 64 * (j))
#define XB_XSUB(j)  (1280 + 64 * (j))
#define XB_XGEN(j)  (2304 + 64 * (j))
#define XB_TOP      3328
#define XB_TOPGEN   3392
#define XCD_BAR_WORDS 3456
#define XB_SPIN_CAP (1u << 18)

__device__ __forceinline__ unsigned xb_ld(unsigned* p)              { return __hip_atomic_load(p, __ATOMIC_RELAXED, __HIP_MEMORY_SCOPE_AGENT); }
__device__ __forceinline__ unsigned xb_add(unsigned* p, unsigned v) { return __hip_atomic_fetch_add(p, v, __ATOMIC_RELAXED, __HIP_MEMORY_SCOPE_AGENT); }
__device__ __forceinline__ unsigned xb_xcc_id() { return (unsigned)__builtin_amdgcn_s_getreg((3 << 11) | 20) & 0xFu; }
#define XB_SPIN(cond, bar) do { unsigned _sp = 0; while (cond) { __builtin_amdgcn_s_sleep(1); \
    if ((++_sp & 255u) == 0u) { if (xb_ld(&(bar)[XB_TMO])) break; if (_sp > XB_SPIN_CAP) { atomicAdd(&(bar)[XB_TMO], 1u); break; } } } } while (0)

struct XcdBarrier {
    unsigned* bar; unsigned x;
    volatile LAS unsigned* st;
};

__device__ __forceinline__ XcdBarrier xcd_barrier_post(unsigned* bar, volatile LAS unsigned* st) {
    XcdBarrier b; b.bar = bar; b.x = xb_xcc_id(); b.st = st;
    if (threadIdx.x == 0) (void)xb_add(&bar[XB_XCNT(b.x)], 1u);
    return b;
}
__device__ __forceinline__ void xcd_barrier_complete(unsigned* bar, unsigned x, unsigned& nloc, unsigned& nx) {
    const unsigned G = gridDim.x * gridDim.y * gridDim.z;
    unsigned sum, cnt, mine, sp = 0u;
    for (;;) {
        sum = 0u; cnt = 0u; mine = 0u;
#pragma unroll
        for (unsigned j = 0; j < 16; ++j) { const unsigned c = xb_ld(&bar[XB_XCNT(j)]); sum += c; cnt += (c > 0u) ? 1u : 0u; mine = (j == x) ? c : mine; }
        if (sum == G) break;
        __builtin_amdgcn_s_sleep(1);
        if ((++sp & 255u) == 0u) { if (xb_ld(&bar[XB_TMO])) break; if (sp > XB_SPIN_CAP) { atomicAdd(&bar[XB_TMO], 1u); break; } }
    }
    nloc = mine > 0u ? mine : 1u; nx = cnt > 0u ? cnt : 1u;
}

__device__ __forceinline__ void xcd_barrier(const XcdBarrier& b) {
    asm volatile("s_waitcnt vmcnt(0)" ::: "memory");
    __syncthreads();
    if (threadIdx.x == 0) {
        unsigned* bar = b.bar;
        __builtin_amdgcn_s_waitcnt(0);
        unsigned nloc = b.st[0], nx = b.st[1];
        if (nloc == 0u) { xcd_barrier_complete(bar, b.x, nloc, nx); b.st[0] = nloc; b.st[1] = nx; }
        const unsigned old = xb_add(&bar[XB_XSUB(b.x)], 1u);
        const unsigned gen = old / nloc;
        if (old + 1u == (gen + 1u) * nloc) {
            __builtin_amdgcn_fence(__ATOMIC_RELEASE, "agent");
            asm volatile("s_waitcnt vmcnt(0)" ::: "memory");
            const unsigned og = xb_add(&bar[XB_TOP], 1u);
            const unsigned tg = og / nx;
            if (og + 1u == (tg + 1u) * nx) xb_add(&bar[XB_TOPGEN], 1u);
            else XB_SPIN(xb_ld(&bar[XB_TOPGEN]) == tg, bar);
            __builtin_amdgcn_fence(__ATOMIC_ACQUIRE, "agent");
            xb_add(&bar[XB_XGEN(b.x)], 1u);
            asm volatile("s_waitcnt vmcnt(0)" ::: "memory");
        } else {
            XB_SPIN(xb_ld(&bar[XB_XGEN(b.x)]) == gen, bar);
            __builtin_amdgcn_fence(__ATOMIC_ACQUIRE, "agent");
            asm volatile("s_waitcnt vmcnt(0)" ::: "memory");
        }
    }
    __syncthreads();
}
constexpr int NWAVES = 8, NTHR = 512;
constexpr int DM = 2048, NBATCH = 2, SEQ = 8192, CTXL = 256;
constexpr int NCTX = NBATCH * CTXL;
constexpr int NLAT = NBATCH * SEQ;
constexpr int NROW = NCTX + NLAT;
constexpr int EVC = 6176, EVN = 6400, ZC0 = 6144;
constexpr int ODC = 4608;
constexpr int NEXP = 16, DFF = 1024;
constexpr int MP_MAX = 37888;
constexpr float EPSN = 1e-6f;
constexpr int FFTN = 16384;

constexpr size_t MiB = 1u << 20;
constexpr size_t WS_CTL = 0, CTL_ZERO_BYTES = 1 * MiB;
constexpr size_t WS_MODP = 1 * MiB;
constexpr size_t WS_MOD = 11 * MiB;
constexpr size_t WS_HDNL = 12 * MiB;
constexpr size_t WS_HDNC = 14 * MiB;
constexpr size_t WS_ROUTE = 15 * MiB;
constexpr size_t WS_LR = 16 * MiB;
constexpr size_t WS_WIN0 = 19 * MiB;
constexpr size_t WS_WOUT0 = 44 * MiB;
constexpr size_t WS_WIN1 = 52 * MiB;
constexpr size_t WS_WOUT1 = 70 * MiB;
constexpr size_t WS_WM13 = 78 * MiB;
constexpr size_t WS_WM2 = 334 * MiB;
constexpr size_t WS_X = 462 * MiB;
constexpr size_t WS_H = 594 * MiB;
constexpr size_t WS_Z = 660 * MiB;
constexpr size_t WS_W = 858 * MiB;
constexpr size_t WS_OF = WS_W, WS_OB = WS_W + 33 * MiB, WS_MIX = WS_W + 66 * MiB;
constexpr size_t WS_ACT = 1006 * MiB;
constexpr size_t WS_W3S = 1088 * MiB;
constexpr size_t WS_HDS = 1090 * MiB;
constexpr size_t WS_QKD = 1094 * MiB;
constexpr size_t WS_END = 1178 * MiB;
constexpr size_t WS_FILT0 = WS_MIX, WS_FILT1 = WS_MIX + 32 * MiB, WS_FILT2 = WS_H + 34 * MiB, WS_FILT3 = WS_ACT + 50 * MiB;
constexpr size_t HYS_BYTES = 196608 + 256;
static_assert(WS_QKD + (size_t)2112 * 41472 <= WS_END, "ws map 4");
static_assert(WS_MODP + (size_t)2 * 32 * 3 * 12288 * 4 <= WS_MOD && WS_LR + (size_t)NROW * 32 * 4 <= WS_WIN0 && WS_WIN0 + (size_t)EVN * DM * 2 <= WS_WOUT0 && WS_WIN1 + (size_t)ODC * DM * 2 <= WS_WOUT1, "ws map 1");
static_assert(WS_X + (size_t)NROW * DM * 4 <= WS_H && WS_H + (size_t)NROW * DM * 2 <= WS_Z && WS_Z + (size_t)NROW * ZC0 * 2 <= WS_W && WS_Z + (size_t)MP_MAX * DM * 2 <= WS_W, "ws map 2");
static_assert(WS_W + (size_t)MP_MAX * DM * 2 <= WS_ACT && WS_MIX + (size_t)NROW * DM * 2 <= WS_ACT && WS_ACT + (size_t)MP_MAX * DFF * 2 <= WS_END && WS_ACT + 256 * HYS_BYTES <= WS_FILT3 && WS_FILT3 + 32 * MiB <= WS_W3S && WS_FILT2 + 32 * MiB <= WS_Z && WS_H + (size_t)1024 * NROW * 2 <= WS_FILT2, "ws map 3");
constexpr int CW_CNT = 8192;
constexpr int CW_HYQ = 256;
constexpr int CW_ATQ = 320;
constexpr int CW_BAR = 4096;

constexpr int RING_BYTES = 139264;
constexpr int LDSCTL_OFF = RING_BYTES;
constexpr int MISC_OFF = LDSCTL_OFF + 320;
constexpr int LDS_BYTES = 147456;
namespace pg8 {
struct EpiFilt {
    static constexpr bool PERM = false, AFTER_DRAIN = false;
    unsigned char* base;
    __device__ __forceinline__ void operator()(const f32x4 (&acc)[2][2][4][2], const Unit& u, int wr, int wc, int fr, int fq) const {
        const int q = u.pm >> 2; size_t off = WS_FILT0; if (q == 1) off = WS_FILT1; if (q == 2) off = WS_FILT2; if (q == 3) off = WS_FILT3;
        float* C = (float*)(base + off);
        const int row0 = (u.pm & 3) * BM + wr * 64 + fr, col0 = u.pn * BM + wc * 32 + 4 * fq;
#pragma unroll
        for (int ai = 0; ai < 2; ++ai)
#pragma unroll
            for (int m = 0; m < 4; ++m) { float* rowp = C + (size_t)(row0 + ai * HALF + m * 16) * 8192 + col0;
#pragma unroll
                for (int bj = 0; bj < 2; ++bj)
#pragma unroll
                    for (int n = 0; n < 2; ++n) *(f32x4*)(rowp + bj * HALF + n * 16) = acc[ai][bj][m][n]; }
    }
};
}
constexpr int TOFF_OFF = LDSCTL_OFF + 512;
typedef float f32x2v __attribute__((ext_vector_type(2)));
typedef unsigned v2u __attribute__((ext_vector_type(2)));
typedef short bf16x4 __attribute__((ext_vector_type(4)));

struct Args { const float* in[32]; float* out; unsigned char* ws; int ph_lo, ph_hi; };

struct Frame {
    LAS unsigned char* lds;
    int G, bx, NGW;
    const float* const __attribute__((address_space(4)))* in;
    float* out; unsigned char* ws;
};

__device__ __forceinline__ float bf2f(unsigned h) { return __uint_as_float(h << 16); }
__device__ __forceinline__ float bflo(unsigned w) { return __uint_as_float(w << 16); }
__device__ __forceinline__ float bfhi(unsigned w) { return __uint_as_float(w & 0xffff0000u); }
__device__ __forceinline__ float wave_sum(float v) {
#pragma unroll
    for (int o = 1; o < 64; o <<= 1) v += __shfl_xor(v, o);
    return v;
}
__device__ __forceinline__ float wave_max(float v) {
#pragma unroll
    for (int o = 1; o < 64; o <<= 1) v = fmaxf(v, __shfl_xor(v, o));
    return v;
}
__device__ __forceinline__ float silu_f(float x) { return x / (1.0f + __expf(-x)); }
__device__ __forceinline__ f32x4 mfma_bf16(bf16x8 a, bf16x8 b, f32x4 c) { return __builtin_amdgcn_mfma_f32_16x16x32_bf16(a, b, c, 0, 0, 0); }
__device__ __forceinline__ int row_cls(int row) { return row < NCTX ? 2 : ((row - NCTX) >> 13); }
#define PHASE_LOCALS int tid = threadIdx.x; asm volatile("" : "+v"(tid)); const int lane = tid & 63, wave = __builtin_amdgcn_readfirstlane(tid >> 6), gw = F.bx * NWAVES + wave; (void)lane; (void)wave; (void)gw;
template <int N> __device__ __forceinline__ float row_shr(float v) { return __builtin_bit_cast(float, __builtin_amdgcn_update_dpp(0, __builtin_bit_cast(int, v), 0x110 + N, 0xF, 0xF, true)); }
template <int N> __device__ __forceinline__ float row_ror(float v) { return __builtin_bit_cast(float, __builtin_amdgcn_update_dpp(0, __builtin_bit_cast(int, v), 0x120 + N, 0xF, 0xF, false)); }
typedef __bf16 bf16x2n __attribute__((ext_vector_type(2)));
__device__ __forceinline__ unsigned cvt_pk(float lo, float hi) { const f32x2v v = {lo, hi}; return __builtin_bit_cast(unsigned, __builtin_convertvector(v, bf16x2n)); }
#define LDS_BARRIER() do { asm volatile("s_waitcnt lgkmcnt(0)" ::: "memory"); __builtin_amdgcn_s_barrier(); asm volatile("" ::: "memory"); } while (0)
__device__ __forceinline__ void tr_item(const float* W, int N, int ncols, bf16* WT, int K, int k0, int n0, int drow0, int drow1, LAS float* scr, int lane) {
    const int cc = 4 * (lane & 15);
    f32x4 v[16];
#pragma unroll
    for (int i = 0; i < 16; ++i) {
        const int r = 4 * i + (lane >> 4);
        v[i] = (f32x4){0.f, 0.f, 0.f, 0.f};
        if (cc < ncols) v[i] = *(const f32x4*)(W + (size_t)(k0 + r) * N + n0 + cc);
    }
#pragma unroll
    for (int i = 0; i < 16; ++i) { const int r = 4 * i + (lane >> 4); LAS float* s = scr + r * 65 + cc; s[0] = v[i][0]; s[1] = v[i][1]; s[2] = v[i][2]; s[3] = v[i][3]; }
    LDS_WAIT();
    const int c = lane & 7;
#pragma unroll
    for (int j = 0; j < 8; ++j) {
        const int n = (lane >> 3) + 8 * j;
        if (n < ncols) {
            const LAS float* s = scr + (8 * c) * 65 + n;
            v4u o; o.x = cvt_pk(s[0], s[65]); o.y = cvt_pk(s[2 * 65], s[3 * 65]); o.z = cvt_pk(s[4 * 65], s[5 * 65]); o.w = cvt_pk(s[6 * 65], s[7 * 65]);
            const int drow = n < 32 ? drow0 + n : drow1 + (n - 32);
            *(v4u*)(WT + (size_t)drow * K + k0 + 8 * c) = o;
        }
    }
    LDS_WAIT();
}
__device__ __forceinline__ int map_evin(int c0) { return c0 < 3072 ? c0 : (c0 < 3104 ? 6144 + (c0 - 3072) : c0 - 32); }

__device__ __forceinline__ void tr_moe_item(Frame& F, int layer, int r, LAS float* scr, int lane) {
    bf16* wm13 = (bf16*)(F.ws + WS_WM13) + (size_t)layer * 16 * 2048 * DM; bf16* wm2 = (bf16*)(F.ws + WS_WM2) + (size_t)layer * 16 * 2048 * DFF;
    if (r < 16384) {
        const int which = r >= 8192 ? 1 : 0; if (which) r -= 8192;
        const int e = r / 512, q = r % 512, kb = q / 16, nb = q % 16, n0 = nb * 64, le = layer * 16 + e;
        const float* W = (which ? F.in[30] : F.in[29]) + (size_t)le * DM * DFF;
        const int d0 = e * 2048 + (n0 >> 7) * 256 + which * 128 + (n0 & 127);
        tr_item(W, DFF, 64, wm13, DM, kb * 64, n0, d0, d0 + 32, scr, lane);
    } else {
        r -= 16384;
        const int e = r / 512, q = r % 512, kb = q / 32, nb = q % 32, n0 = nb * 64, le = layer * 16 + e;
        const float* W = F.in[31] + (size_t)le * DFF * DM;
        tr_item(W, DM, 64, wm2, DFF, kb * 64, n0, e * 2048 + n0, e * 2048 + n0 + 32, scr, lane);
    }
}
struct TrDesc { const float* src; bf16* dst; int N, K; };
__device__ __forceinline__ TrDesc moe_desc(Frame& F, int layer, int r) {
    TrDesc d;
    if (r < 16384) {
        const int which = r >= 8192 ? 1 : 0; if (which) r -= 8192;
        const int e = r / 512, q = r % 512, kb = q % 32, nb = q / 32, n0 = nb * 64, le = layer * 16 + e;
        const float* W = (which ? F.in[30] : F.in[29]) + (size_t)le * DM * DFF;
        const int d0 = e * 2048 + (n0 >> 7) * 256 + which * 128 + (n0 & 127);
        d.src = W + (size_t)(kb * 64) * DFF + n0; d.N = DFF; d.K = DM;
        d.dst = (bf16*)(F.ws + WS_WM13) + (size_t)layer * 16 * 2048 * DM + (size_t)d0 * DM + kb * 64;
    } else {
        r -= 16384;
        const int e = r / 512, q = r % 512, kb = q % 16, nb = q / 16, n0 = nb * 64, le = layer * 16 + e;
        const float* W = F.in[31] + (size_t)le * DFF * DM;
        d.src = W + (size_t)(kb * 64) * DM + n0; d.N = DM; d.K = DFF;
        d.dst = (bf16*)(F.ws + WS_WM2) + (size_t)layer * 16 * 2048 * DFF + (size_t)(e * 2048 + n0) * DFF + kb * 64;
    }
    return d;
}
__device__ __forceinline__ void tr_load(const TrDesc& d, int lane, f32x4 (&v)[16]) {
#pragma unroll
    for (int i = 0; i < 16; ++i) v[i] = *(const f32x4*)(d.src + (size_t)(4 * i + (lane >> 4)) * d.N + 4 * (lane & 15));
}
__device__ __forceinline__ void tr_commit(const TrDesc& d, const f32x4 (&v)[16], LAS float* scr, int lane) {
    const int cc = 4 * (lane & 15);
#pragma unroll
    for (int i = 0; i < 16; ++i) { const int r = 4 * i + (lane >> 4); LAS float* s = scr + r * 65 + cc; s[0] = v[i][0]; s[1] = v[i][1]; s[2] = v[i][2]; s[3] = v[i][3]; }
    LDS_WAIT();
    const int c = lane & 7;
#pragma unroll
    for (int j = 0; j < 8; ++j) {
        const int n = (lane >> 3) + 8 * j;
        const LAS float* s = scr + (8 * c) * 65 + n;
        v4u o; o.x = cvt_pk(s[0], s[65]); o.y = cvt_pk(s[2 * 65], s[3 * 65]); o.z = cvt_pk(s[4 * 65], s[5 * 65]); o.w = cvt_pk(s[6 * 65], s[7 * 65]);
        *(v4u*)(d.dst + (size_t)n * d.K + 8 * c) = o;
    }
    LDS_WAIT();
}
template <int NI>
__device__ __forceinline__ void conv_unit(Frame& F, int layer, int cu) {
    PHASE_LOCALS
    LAS float* scr = (LAS float*)(F.lds) + wave * (64 * 65);
    __syncthreads();
    const int r0 = cu * (8 * NI) + wave * NI;
    f32x4 va[16], vb[16];
    TrDesc da = moe_desc(F, layer, r0), db = da;
    tr_load(da, lane, va);
#pragma unroll
    for (int i = 0; i < NI; i += 2) {
        db = moe_desc(F, layer, r0 + i + 1); tr_load(db, lane, vb);
        tr_commit(da, va, scr, lane);
        if (i + 2 < NI) { da = moe_desc(F, layer, r0 + i + 2); tr_load(da, lane, va); }
        tr_commit(db, vb, scr, lane);
    }
    __syncthreads();
}

__device__ __forceinline__ void phase_pre(Frame& F) {
    PHASE_LOCALS
    {
        LAS float* sv = (LAS float*)F.lds;
        const float* cvec = F.in[1]; const float* cctx = F.in[3]; const float* adaw = F.in[4];
        float* modp = (float*)(F.ws + WS_ACT);
        for (int u = F.bx; u < 768; u += F.G) {
            const int layer = u / 384, r = u % 384, kc = r / 6, cb = r % 6, k0 = kc * 32;
            __syncthreads();
            if (tid < 96) { const int v = tid >> 5, k = tid & 31; const float c = v < 2 ? cvec[v * DM + k0 + k] : cctx[k0 + k]; sv[tid] = silu_f(c); }
            __syncthreads();
            const int col0 = cb * 2048 + tid * 4;
            const float* wp = adaw + ((size_t)layer * DM + k0) * 12288 + col0;
            f32x4 a0 = {0.f, 0.f, 0.f, 0.f}, a1 = a0, a2 = a0;
#pragma unroll 8
            for (int k = 0; k < 32; ++k) { const f32x4 w = *(const f32x4*)(wp + (size_t)k * 12288); a0 += w * sv[k]; a1 += w * sv[32 + k]; a2 += w * sv[64 + k]; }
            float* op = modp + ((size_t)(layer * 64 + kc) * 3) * 12288 + col0;
            *(f32x4*)op = a0; *(f32x4*)(op + 12288) = a1; *(f32x4*)(op + 2 * 12288) = a2;
        }
        __syncthreads();
    }
    {
        const float* w1 = F.in[15]; const float* b1 = F.in[16]; const float* w2 = F.in[17]; const float* b2 = F.in[18];
        float* hdn = (float*)(F.ws + WS_HDNL);
        for (int rr = gw; rr < 8192 + 256; rr += F.NGW) {
            const int L = rr < 8192 ? 8192 : 256, l = rr < 8192 ? rr : rr - 8192;
            const float t = (float)l / (float)(L - 1);
            const float w = (float)(2.0 * 3.14159265358979323846 / (double)L) * (float)l;
            float h1 = b1[lane] + t * w1[lane];
            const float band = 1e-4f + (float)(lane & 15) * ((15.0f - 1e-4f) / 15.0f);
            float sn, cs; sincosf(band * w, &sn, &cs);
#pragma unroll
            for (int i = 0; i < 16; ++i) h1 += __shfl(cs, i) * w1[(1 + i) * 64 + lane] - __shfl(sn, i) * w1[(17 + i) * 64 + lane];
            h1 = sinf(h1);
            float h2 = b2[lane];
#pragma unroll 8
            for (int i = 0; i < 64; ++i) h2 += __shfl(h1, i) * w2[i * 64 + lane];
            const float hv = sinf(h2);
            hdn[(size_t)rr * 64 + lane] = hv;
            if (rr < 8192) {
                bf16* hs = (bf16*)(F.ws + WS_HDS) + (size_t)rr * 256;
                const unsigned hi = f2bf(hv), lo = f2bf(hv - bf2f(hi));
                hs[lane] = (bf16)hi; hs[64 + lane] = (bf16)lo; hs[128 + lane] = (bf16)hi; hs[192 + lane] = (bf16)0;
            }
        }
        const float* w3 = F.in[19]; bf16* w3s = (bf16*)(F.ws + WS_W3S);
        for (int r = gw; r < 4096; r += F.NGW) {
            const float wv = w3[(size_t)lane * 4096 + r];
            const unsigned hi = f2bf(wv), lo = f2bf(wv - bf2f(hi));
            bf16* o = w3s + (size_t)r * 256;
            o[lane] = (bf16)hi; o[64 + lane] = (bf16)hi; o[128 + lane] = (bf16)lo; o[192 + lane] = (bf16)0;
        }
    }
    {
        LAS float* scr = (LAS float*)(F.lds) + wave * (64 * 65);
        bf16* win0 = (bf16*)(F.ws + WS_WIN0); bf16* wout0 = (bf16*)(F.ws + WS_WOUT0); bf16* win1 = (bf16*)(F.ws + WS_WIN1); bf16* wout1 = (bf16*)(F.ws + WS_WOUT1);
        constexpr int I0 = 32 * 97, I1 = 32 * 32, I2 = 32 * 72, I3 = 32 * 32;
        constexpr int NITEMS = I0 + I1 + I2 + I3;
        for (int it = gw; it < NITEMS; it += F.NGW) {
            int r = it;
            if (r < I0) { const int kb = r / 97, nb = r % 97, n0 = nb * 64; tr_item(F.in[8], EVC, nb == 96 ? 32 : 64, win0, DM, kb * 64, n0, map_evin(n0), map_evin(n0 + 32), scr, lane); continue; } r -= I0;
            if (r < I1) { const int kb = r / 32, nb = r % 32, n0 = nb * 64; tr_item(F.in[9], DM, 64, wout0, DM, kb * 64, n0, n0, n0 + 32, scr, lane); continue; } r -= I1;
            if (r < I2) { const int kb = r / 72, nb = r % 72, n0 = nb * 64; tr_item(F.in[21], ODC, 64, win1, DM, kb * 64, n0, n0, n0 + 32, scr, lane); continue; } r -= I2;
            { const int kb = r / 32, nb = r % 32, n0 = nb * 64; tr_item(F.in[22], DM, 64, wout1, DM, kb * 64, n0, n0, n0 + 32, scr, lane); }
        }
        if (F.G != 256) for (int it = gw; it < 24576; it += F.NGW) tr_moe_item(F, 0, it, scr, lane);
    }
}
__device__ __forceinline__ void phase_modfin(Frame& F) {
    PHASE_LOCALS
    const float* adab = F.in[5]; const float* modp = (const float*)(F.ws + WS_ACT); float* mod = (float*)(F.ws + WS_MOD);
    for (int idx = F.bx * NTHR + tid; idx < 2 * 3 * 12288; idx += F.G * NTHR) {
        const int layer = idx / 36864, rem = idx % 36864, v = rem / 12288, col = rem % 12288;
        float s = adab[layer * 12288 + col];
        for (int kc = 0; kc < 64; ++kc) s += modp[((size_t)(layer * 64 + kc) * 3 + v) * 12288 + col];
        mod[idx] = s;
    }
}
template <int MODE>
__device__ __forceinline__ void phase_norm(Frame& F, int layer) {
    PHASE_LOCALS
    float* X = (float*)(F.ws + WS_X); bf16* H = (bf16*)(F.ws + WS_H);
    const float* mod = (const float*)(F.ws + WS_MOD); const bf16* yperm = (const bf16*)(F.ws + WS_W);
    const unsigned* route = (const unsigned*)(F.ws + WS_ROUTE);
    const float* gain = F.in[6] + layer * DM;
    const int r_begin = MODE == 2 ? NCTX : 0;
    v4u rt_next = {0u, 0u, 0u, 0u};
    if (MODE != 0 && r_begin + gw < NROW) rt_next = *(const v4u*)(route + (size_t)(r_begin + gw) * 8 + 4);
    for (int row = r_begin + gw; row < NROW; row += F.NGW) {
        const int cls = row_cls(row);
        const v4u rt = rt_next;
        if (MODE != 0 && row + F.NGW < NROW) rt_next = *(const v4u*)(route + (size_t)(row + F.NGW) * 8 + 4);
        f32x4 v[8];
        if (MODE == 0) {
            const float* src = row < NCTX ? F.in[2] + (size_t)row * DM : F.in[0] + (size_t)(row - NCTX) * DM;
#pragma unroll
            for (int j = 0; j < 8; ++j) v[j] = *(const f32x4*)(src + 256 * j + 4 * lane);
        } else {
            const float* src = X + (size_t)row * DM;
            const float w0 = __uint_as_float(rt.x), w1 = __uint_as_float(rt.y);
            const bf16* y0 = yperm + (size_t)rt.z * DM; const bf16* y1 = yperm + (size_t)rt.w * DM;
            const float* g2 = mod + (size_t)((layer - (MODE == 1 ? 1 : 0)) * 3 + cls) * 12288 + 5 * DM;
#pragma unroll
            for (int j = 0; j < 8; ++j) {
                const int e = 256 * j + 4 * lane;
                const f32x4 x = *(const f32x4*)(src + e), g = *(const f32x4*)(g2 + e);
                const v2u a = *(const v2u*)(y0 + e), b = *(const v2u*)(y1 + e);
                f32x4 y; y[0] = w0 * bflo(a.x) + w1 * bflo(b.x); y[1] = w0 * bfhi(a.x) + w1 * bfhi(b.x); y[2] = w0 * bflo(a.y) + w1 * bflo(b.y); y[3] = w0 * bfhi(a.y) + w1 * bfhi(b.y);
                v[j] = x + g * y;
            }
        }
        if (MODE == 2) {
            float* o = F.out + (size_t)(row - NCTX) * DM;
#pragma unroll
            for (int j = 0; j < 8; ++j) *(f32x4*)(o + 256 * j + 4 * lane) = v[j];
        } else {
            float* xo = X + (size_t)row * DM; float ss = 0.f;
#pragma unroll
            for (int j = 0; j < 8; ++j) { if (MODE != 0) *(f32x4*)(xo + 256 * j + 4 * lane) = v[j]; ss += v[j][0] * v[j][0] + v[j][1] * v[j][1] + v[j][2] * v[j][2] + v[j][3] * v[j][3]; }
            const float rstd = rsqrtf(wave_sum(ss) * (1.0f / DM) + EPSN);
            const float* mrow = mod + (size_t)(layer * 3 + cls) * 12288;
            bf16* ho = H + (size_t)row * DM;
#pragma unroll
            for (int j = 0; j < 8; ++j) {
                const int e = 256 * j + 4 * lane;
                const f32x4 gn = *(const f32x4*)(gain + e), sh = *(const f32x4*)(mrow + e), sc = *(const f32x4*)(mrow + DM + e);
                const f32x4 h = v[j] * rstd * gn * (sc + 1.0f) + sh;
                v2u o; o.x = pk2(h[0], h[1]); o.y = pk2(h[2], h[3]); *(v2u*)(ho + e) = o;
            }
        }
    }
}
constexpr size_t WS_RWT = WS_HDNC + 128 * 1024, WS_RB = WS_HDNC + 64 * 1024;
__device__ __forceinline__ void route_fold(Frame& F) {
    PHASE_LOCALS
    const float* mod = (const float*)(F.ws + WS_MOD); const float* rw = F.in[27];
    float* rwt = (float*)(F.ws + WS_RWT); float* rbv = (float*)(F.ws + WS_RB);
    for (int idx = F.bx * NTHR + tid; idx < 2 * 3 * 16 * DM; idx += F.G * NTHR) {
        const int d = idx & (DM - 1), e = (idx >> 11) & 15, lc = idx >> 15;
        const int layer = lc / 3;
        rwt[idx] = F.in[7][layer * DM + d] * (1.0f + mod[(size_t)lc * 12288 + 4 * DM + d]) * rw[d * 16 + e];
    }
    if (gw < 96) {
        const int e = gw & 15, lc = gw >> 4; float s = 0.f;
        for (int d = lane; d < DM; d += 64) s += mod[(size_t)lc * 12288 + 3 * DM + d] * rw[d * 16 + e];
        s = wave_sum(s); if (lane == 0) rbv[gw] = s;
    }
}
template <int J> __device__ __forceinline__ float quad_bcast(float v) { return __builtin_bit_cast(float, __builtin_amdgcn_update_dpp(0, __builtin_bit_cast(int, v), J * 0x55, 0xF, 0xF, false)); }
__device__ __forceinline__ float row_sum16(float v) { v += row_ror<8>(v); v += row_ror<4>(v); v += row_ror<2>(v); v += row_ror<1>(v); return v; }
__device__ __forceinline__ float row_max16(float v) { v = fmaxf(v, row_ror<8>(v)); v = fmaxf(v, row_ror<4>(v)); v = fmaxf(v, row_ror<2>(v)); v = fmaxf(v, row_ror<1>(v)); return v; }
__device__ __forceinline__ void phase_route(Frame& F, int layer, int rep = 0) {
    PHASE_LOCALS
    const float* X = (const float*)(F.ws + WS_X); bf16* H = (bf16*)(F.ws + WS_H);
    const float* mod = (const float*)(F.ws + WS_MOD);
    unsigned* route = (unsigned*)(F.ws + WS_ROUTE) + (rep ? 8 * NROW : 0);
    unsigned* cnt = (unsigned*)(F.ws + WS_CTL) + CW_CNT + 64 * 16 * (2 * layer + rep);
    const float* gain = F.in[7] + layer * DM; const float* rb = F.in[28];
    constexpr int XS = DM + 4;
    LAS float* XT = (LAS float*)F.lds;
    LAS float* RSTD = (LAS float*)(F.lds + LDSCTL_OFF + 1024);
    LAS unsigned* lcnt = (LAS unsigned*)(F.lds + LDSCTL_OFF + 768);
    static_assert(16 * XS * 4 <= RING_BYTES, "route LDS map");
    __syncthreads();
    if (tid < 32) lcnt[tid] = 0u;
    const int r_begin = layer == 0 ? 0 : NCTX, ntile = (NROW - r_begin) / 16;
    const int m = lane & 15, kq = lane >> 4;
    for (int tl = F.bx; tl < ntile; tl += F.G) {
        const int row0 = r_begin + 16 * tl, cls = row_cls(row0);
        const float* mrow = mod + (size_t)(layer * 3 + cls) * 12288 + 3 * DM;
        __syncthreads();
#pragma unroll
        for (int rr = 0; rr < 2; ++rr) {
            const int mr = 2 * wave + rr, row = row0 + mr;
            const float* src = X + (size_t)row * DM;
            f32x4 v[8]; float ss = 0.f;
#pragma unroll
            for (int j = 0; j < 8; ++j) { v[j] = *(const f32x4*)(src + 256 * j + 4 * lane); ss += v[j][0] * v[j][0] + v[j][1] * v[j][1] + v[j][2] * v[j][2] + v[j][3] * v[j][3]; }
#pragma unroll
            for (int j = 0; j < 8; ++j) *(LAS f32x4*)(XT + mr * XS + 256 * j + 4 * lane) = v[j];
            const float rstd = rsqrtf(wave_sum(ss) * (1.0f / DM) + EPSN);
            if (lane == 0) RSTD[mr] = rstd;
            bf16* ho = H + (size_t)row * DM;
#pragma unroll
            for (int j = 0; j < 8; ++j) {
                const int e = 256 * j + 4 * lane;
                const f32x4 gn = *(const f32x4*)(gain + e), sh = *(const f32x4*)(mrow + e), sc = *(const f32x4*)(mrow + DM + e);
                const f32x4 h = v[j] * rstd * gn * (sc + 1.0f) + sh;
                v2u o; o.x = cvt_pk(h[0], h[1]); o.y = cvt_pk(h[2], h[3]); *(v2u*)(ho + e) = o;
            }
        }
        __syncthreads();
        const float* rwt = (const float*)(F.ws + WS_RWT) + (size_t)(layer * 3 + cls) * 16 * DM + (size_t)m * DM + 256 * wave + 4 * kq;
        const LAS float* xa = XT + m * XS + 256 * wave + 4 * kq;
        f32x4 acc0 = {0.f, 0.f, 0.f, 0.f}, acc1 = acc0;
#pragma unroll 4
        for (int j = 0; j < 16; ++j) {
            const f32x4 a4 = *(const LAS f32x4*)(xa + 16 * j), b4 = *(const f32x4*)(rwt + 16 * j);
            acc0 = __builtin_amdgcn_mfma_f32_16x16x4f32(a4[0], b4[0], acc0, 0, 0, 0); acc1 = __builtin_amdgcn_mfma_f32_16x16x4f32(a4[1], b4[1], acc1, 0, 0, 0);
            acc0 = __builtin_amdgcn_mfma_f32_16x16x4f32(a4[2], b4[2], acc0, 0, 0, 0); acc1 = __builtin_amdgcn_mfma_f32_16x16x4f32(a4[3], b4[3], acc1, 0, 0, 0);
        }
        acc0 += acc1;
        __syncthreads();
        LAS float* PART = XT;
#pragma unroll
        for (int i = 0; i < 4; ++i) PART[wave * 256 + (4 * kq + i) * 16 + m] = acc0[i];
        __syncthreads();
        if (tid < 256) {
            const int mr = tid >> 4, e = tid & 15, row = row0 + mr;
            float s = 0.f;
#pragma unroll
            for (int w8 = 0; w8 < 8; ++w8) s += PART[w8 * 256 + mr * 16 + e];
            const float logit = RSTD[mr] * s + ((const float*)(F.ws + WS_RB))[(layer * 3 + cls) * 16 + e];
            const float mx = row_max16(logit), ex = expf(logit - mx), score = ex / row_sum16(ex), sel = score + rb[e];
            const float q0 = quad_bcast<0>(sel), q1 = quad_bcast<1>(sel), q2 = quad_bcast<2>(sel), q3 = quad_bcast<3>(sel);
            const float hi1 = fmaxf(q0, q1), lo1 = fminf(q0, q1), hi2 = fmaxf(q2, q3), lo2 = fminf(q2, q3);
            const float gs = fmaxf(hi1, hi2) + fmaxf(fminf(hi1, hi2), fmaxf(lo1, lo2));
            const int G = e >> 2, jq = e & 3;
            const float Gf = (float)G;
            const float g1 = row_ror<4>(gs), g2 = row_ror<8>(gs), g3 = row_ror<12>(gs);
            const float G1 = row_ror<4>(Gf), G2 = row_ror<8>(Gf), G3 = row_ror<12>(Gf);
            const bool in_best = (gs > g1 || (gs == g1 && Gf < G1)) && (gs > g2 || (gs == g2 && Gf < G2)) && (gs > g3 || (gs == g3 && Gf < G3));
            const int rank = ((q0 > sel || (q0 == sel && 0 < jq)) ? 1 : 0) + ((q1 > sel || (q1 == sel && 1 < jq)) ? 1 : 0) + ((q2 > sel || (q2 == sel && 2 < jq)) ? 1 : 0) + ((q3 > sel || (q3 == sel && 3 < jq)) ? 1 : 0);
            const bool is0 = in_best && rank == 0, is1 = in_best && rank == 1;
            const float e0f = row_sum16(is0 ? (float)e : 0.f), e1f = row_sum16(is1 ? (float)e : 0.f);
            float w0 = row_sum16(is0 ? score : 0.f), w1 = row_sum16(is1 ? score : 0.f);
            const float wsn = 1.0f / (w0 + w1); w0 *= wsn; w1 *= wsn;
            if (e == 0) {
                const int e0 = (int)e0f, e1 = (int)e1f;
                const unsigned r0 = __hip_atomic_fetch_add(lcnt + e0, 1u, __ATOMIC_RELAXED, __HIP_MEMORY_SCOPE_WORKGROUP);
                const unsigned r1 = __hip_atomic_fetch_add(lcnt + e1, 1u, __ATOMIC_RELAXED, __HIP_MEMORY_SCOPE_WORKGROUP);
                v4u a; a.x = (unsigned)e0; a.y = (unsigned)e1; a.z = r0; a.w = r1;
                v4u b; b.x = __float_as_uint(w0); b.y = __float_as_uint(w1); b.z = 0u; b.w = 0u;
                *(v4u*)(route + (size_t)row * 8) = a; *(v4u*)(route + (size_t)row * 8 + 4) = b;
            }
        }
    }
    __syncthreads();
    if (tid < 16) { const unsigned n = lcnt[tid]; lcnt[16 + tid] = n ? __hip_atomic_fetch_add(cnt + 64 * tid, n, __ATOMIC_RELAXED, __HIP_MEMORY_SCOPE_AGENT) : 0u; }
    __syncthreads();
    for (int tl = F.bx; tl < ntile; tl += F.G)
        if (tid < 16) {
            const int row = r_begin + 16 * tl + tid;
            v4u a = *(const v4u*)(route + (size_t)row * 8);
            a.z += lcnt[16 + a.x]; a.w += lcnt[16 + a.y];
            *(v4u*)(route + (size_t)row * 8) = a;
        }
    __syncthreads();
}
__device__ __forceinline__ void moe_offsets(Frame& F, int layer) {
    PHASE_LOCALS
    LAS int* toff = (LAS int*)(F.lds + TOFF_OFF);
    __syncthreads();
    if (tid == 0) {
        const unsigned* cnt = (const unsigned*)(F.ws + WS_CTL) + CW_CNT + 64 * 16 * (2 * layer); int acc = 0;
        for (int e = 0; e < 16; ++e) { toff[e] = acc; acc += (int)((__hip_atomic_load(cnt + 64 * e, __ATOMIC_RELAXED, __HIP_MEMORY_SCOPE_AGENT) + 255u) >> 8); }
        toff[16] = acc;
    }
    __syncthreads();
}
__device__ __forceinline__ void phase_gather(Frame& F, int layer) {
    PHASE_LOCALS
    moe_offsets(F, layer);
    const LAS int* toff = (const LAS int*)(F.lds + TOFF_OFF);
    const bf16* H = (const bf16*)(F.ws + WS_H); bf16* hperm = (bf16*)(F.ws + WS_Z);
    unsigned* route = (unsigned*)(F.ws + WS_ROUTE);
    const int r_begin = layer == 0 ? 0 : NCTX;
    v4u a_next = {0u, 0u, 0u, 0u};
    if (r_begin + gw < NROW) a_next = *(const v4u*)(route + (size_t)(r_begin + gw) * 8);
    for (int row = r_begin + gw; row < NROW; row += F.NGW) {
        const v4u a = a_next;
        if (row + F.NGW < NROW) a_next = *(const v4u*)(route + (size_t)(row + F.NGW) * 8);
        const unsigned p0 = (unsigned)toff[a.x] * 256u + a.z, p1 = (unsigned)toff[a.y] * 256u + a.w;
        const v4u* src = (const v4u*)(H + (size_t)row * DM); v4u* d0 = (v4u*)(hperm + (size_t)p0 * DM); v4u* d1 = (v4u*)(hperm + (size_t)p1 * DM);
#pragma unroll
        for (int j = 0; j < 4; ++j) { const v4u x = src[64 * j + lane]; d0[64 * j + lane] = x; d1[64 * j + lane] = x; }
        if (lane == 0) { v2u pp; pp.x = p0; pp.y = p1; *(v2u*)(route + (size_t)row * 8 + 6) = pp; }
    }
}
__device__ __forceinline__ void phase_ht(Frame& F) {
    PHASE_LOCALS
    const bf16* Z = (const bf16*)(F.ws + WS_Z); bf16* UT = (bf16*)F.out;
    const float* cw = F.in[13]; const float* cb = F.in[14];
    constexpr int NCB = 3072 / 64, NRB = NROW / 64;
    for (int it = gw; it < NCB * NRB; it += F.NGW) {
        const int cblk = it % NCB, rblk = it / NCB, ch = cblk * 64 + lane, r0 = rblk * 64;
        const float w0 = cw[ch], w1 = cw[3072 + ch], w2 = cw[2 * 3072 + ch], bb = cb[ch];
        const bool first = (r0 < NCTX) ? ((r0 & 255) == 0) : (((r0 - NCTX) & 8191) == 0);
        const bool last = (r0 < NCTX) ? (((r0 + 64) & 255) == 0) : (((r0 + 64 - NCTX) & 8191) == 0);
        const bf16* zp = Z + (size_t)r0 * ZC0 + 3072 + ch;
        bf16* up = UT + (size_t)ch * NROW + r0;
        unsigned short x[66];
        x[0] = first ? (unsigned short)0 : zp[-(ptrdiff_t)ZC0];
#pragma unroll
        for (int r = 0; r < 64; ++r) x[1 + r] = zp[(size_t)r * ZC0];
        x[65] = last ? (unsigned short)0 : zp[(size_t)64 * ZC0];
#pragma unroll
        for (int g8 = 0; g8 < 8; ++g8) {
            float o[8];
#pragma unroll
            for (int q = 0; q < 8; ++q) { const int r = g8 * 8 + q; o[q] = w0 * bf2f(x[r]) + w1 * bf2f(x[r + 1]) + w2 * bf2f(x[r + 2]) + bb; }
            v4u w; w.x = cvt_pk(o[0], o[1]); w.y = cvt_pk(o[2], o[3]); w.z = cvt_pk(o[4], o[5]); w.w = cvt_pk(o[6], o[7]);
            *(v4u*)(up + g8 * 8) = w;
        }
    }
}
__device__ __forceinline__ void merge_heads(Frame& F, const float* gain, int ldz, int r_begin) {
    PHASE_LOCALS
    const bf16* OF = (const bf16*)(F.ws + WS_OF); const bf16* OB = (const bf16*)(F.ws + WS_OB); const bf16* Z = (const bf16*)(F.ws + WS_Z);
    bf16* MIX = (bf16*)(F.ws + WS_MIX);
    const f32x4 gn = *(const f32x4*)(gain + 4 * lane);
    for (int row = r_begin + gw; row < NROW; row += F.NGW) {
#pragma unroll
        for (int h = 0; h < 4; ++h) {
            const size_t off = (size_t)row * 1024 + h * 256 + 4 * lane;
            const v2u a = *(const v2u*)(OF + off), b = *(const v2u*)(OB + off), g = *(const v2u*)(Z + (size_t)row * ldz + 2048 + h * 256 + 4 * lane);
            f32x4 o; o[0] = bflo(a.x) + bflo(b.x); o[1] = bfhi(a.x) + bfhi(b.x); o[2] = bflo(a.y) + bflo(b.y); o[3] = bfhi(a.y) + bfhi(b.y);
            const float ss = wave_sum(o[0] * o[0] + o[1] * o[1] + o[2] * o[2] + o[3] * o[3]);
            const float rstd = rsqrtf(ss * (1.0f / 256.0f) + EPSN);
            f32x4 gg; gg[0] = silu_f(bflo(g.x)); gg[1] = silu_f(bfhi(g.x)); gg[2] = silu_f(bflo(g.y)); gg[3] = silu_f(bfhi(g.y));
            const f32x4 r = o * rstd * gn * gg;
            v2u w; w.x = pk2(r[0], r[1]); w.y = pk2(r[2], r[3]);
            *(v2u*)(MIX + (size_t)row * DM + h * 256 + 4 * lane) = w;
        }
    }
}
__device__ __forceinline__ void merge_hyena(Frame& F) {
    PHASE_LOCALS
    const bf16* HYO = (const bf16*)(F.ws + WS_H); bf16* MIX = (bf16*)(F.ws + WS_MIX);
    LAS unsigned short* tl = (LAS unsigned short*)F.lds + wave * (64 * 72);
    constexpr int NCB = 1024 / 64, NRB = NROW / 64;
    for (int it = gw; it < NCB * NRB; it += F.NGW) {
        const int cblk = it % NCB, rblk = it / NCB, c0 = cblk * 64, r0 = rblk * 64;
#pragma unroll
        for (int i = 0; i < 8; ++i) {
            const int c = i * 8 + (lane >> 3), ch = lane & 7;
            const v4u x = *(const v4u*)(HYO + (size_t)(c0 + c) * NROW + r0 + ch * 8);
            *(LAS v4u*)(tl + c * 72 + ch * 8) = x;
        }
        LDS_WAIT();
#pragma unroll
        for (int i = 0; i < 8; ++i) {
            const int r = i * 8 + (lane >> 3), cq = (lane & 7) * 8;
            unsigned short e[8];
#pragma unroll
            for (int q = 0; q < 8; ++q) e[q] = tl[(cq + q) * 72 + r];
            v4u w; w.x = e[0] | ((unsigned)e[1] << 16); w.y = e[2] | ((unsigned)e[3] << 16); w.z = e[4] | ((unsigned)e[5] << 16); w.w = e[6] | ((unsigned)e[7] << 16);
            *(v4u*)(MIX + (size_t)(r0 + r) * DM + 1024 + c0 + cq) = w;
        }
        LDS_WAIT();
    }
}
__device__ __forceinline__ void phase_prep(Frame& F, int rep = 0) {
    PHASE_LOCALS
    bf16* Z = (bf16*)(F.ws + WS_Z); bf16* ZD = rep ? (bf16*)(F.ws + WS_W) : Z;
    const float* qn = F.in[24]; const float* kn = F.in[25];
    const float rsq = 0.08838834764831845f;
    const float inv_ret = powf(10000.0f, -(float)lane / 63.0f);
    const float inv_ax = powf(10000.0f, -(float)(lane & 31) / 32.0f);
    for (int row = gw; row < NROW; row += F.NGW) {
        const bool latent = row >= NCTX; const int pos = latent ? ((row - NCTX) & 8191) : 0;
        bf16* zr = Z + (size_t)row * ODC; bf16* zd = ZD + (size_t)row * ODC;
        float sr = 0.f, cr = 1.f, s1 = 0.f, c1 = 1.f, s2 = 0.f, c2 = 1.f;
        if (latent) { sincosf((float)pos * inv_ret, &sr, &cr); sincosf((float)(pos >> 6) * inv_ax, &s1, &c1); sincosf((float)(pos & 63) * inv_ax, &s2, &c2); }
#pragma unroll
        for (int sg = 0; sg < 8; ++sg) {
            bf16* p = zr + sg * 128; bf16* pd = zd + sg * 128;
            const float x1 = bf2f(p[lane]), x2 = bf2f(p[64 + lane]);
            float o1 = x1 * cr - x2 * sr, o2 = x2 * cr + x1 * sr;
            if (sg >= 4) { o1 *= rsq; o2 *= rsq; }
            pd[lane] = (bf16)f2bf(o1); pd[64 + lane] = (bf16)f2bf(o2);
        }
#pragma unroll
        for (int sg = 0; sg < 10; ++sg) {
            bf16* p = zr + 3072 + sg * 128; bf16* pd = zd + 3072 + sg * 128; const float* gnp = sg < 8 ? qn : kn;
            float a = bf2f(p[lane]), b = bf2f(p[64 + lane]);
            const float rstd = rsqrtf(wave_sum(a * a + b * b) * (1.0f / 128.0f) + EPSN);
            a = a * rstd * gnp[lane]; b = b * rstd * gnp[64 + lane];
            const float ap = __shfl_xor(a, 32), bp = __shfl_xor(b, 32);
            float oa, ob;
            if (lane < 32) { oa = a * c1 - ap * s1; ob = b * c2 - bp * s2; }
            else { oa = a * c1 + ap * s1; ob = b * c2 + bp * s2; }
            if (sg < 8) { oa *= rsq; ob *= rsq; }
            pd[lane] = (bf16)f2bf(oa); pd[64 + lane] = (bf16)f2bf(ob);
        }
    }
}
__device__ __forceinline__ int scan_rowbase(int n, int b, int dir) {
    if (n < 4) { const int cc = dir ? 3 - n : n; return b * CTXL + cc * 64; }
    const int m = n - 4, cc = dir ? 127 - m : m; return NCTX + b * SEQ + cc * 64;
}
constexpr int QKD_UNIT = 16384 + 8192 + 16384 + 512;
__device__ __forceinline__ size_t qkd_off(int b, int h, int dir, int n) { return (size_t)((((b * 4 + h) * 2 + dir) * 132) + n) * QKD_UNIT; }
struct PreRegs { v4u q[2], k[2]; f32x4 lr; };
template <bool GLA>
__device__ __forceinline__ void prepass_load(Frame& F, int pu, int tid, PreRegs& R) {
    const int n = pu % 132, r_ = pu / 132, dir = r_ & 1, h = (r_ >> 1) & 3, b = r_ >> 3;
    const bf16* Z = (const bf16*)(F.ws + WS_Z);
    constexpr int ldz = GLA ? ZC0 : ODC;
    const bf16* Zq = Z + h * 128; const bf16* Zk = Z + 512 + h * 128;
    const float* LRp = (const float*)(F.ws + WS_LR) + dir * 16;
    const int rb = scan_rowbase(n, b, dir);
#pragma unroll
    for (int i = 0; i < 2; ++i) { const int idx = tid + 512 * i, r = idx >> 4, ch = idx & 15;
        R.q[i] = *(const v4u*)(Zq + (size_t)(rb + r) * ldz + ch * 8); R.k[i] = *(const v4u*)(Zk + (size_t)(rb + r) * ldz + ch * 8); }
    if (GLA && tid < 256) R.lr = *(const f32x4*)(LRp + (size_t)(rb + (tid >> 2)) * 32 + (tid & 3) * 4);
}
template <bool GLA>
__device__ __forceinline__ void prepass_unit(Frame& F, int pu, int pu_next, PreRegs& R) {
    const int n = pu % 132, r_ = pu / 132, dir = r_ & 1, h = (r_ >> 1) & 3, b = r_ >> 3;
    PHASE_LOCALS
    const int w = wave, l = lane, g = l >> 4, c = l & 15;
    LAS unsigned char* lds = F.lds;
    constexpr int S128 = 272, S64 = 144;
    constexpr int O_RQ = 0, O_RK = 17408, O_QE = 34816, O_KE = 52224, O_KDT = 69632, O_LR = 88064;
    const bf16* Z = (const bf16*)(F.ws + WS_Z);
    constexpr int ldz = GLA ? ZC0 : ODC;
    const bf16* Zq = Z + h * 128; const bf16* Zk = Z + 512 + h * 128;
    const float* LRp = (const float*)(F.ws + WS_LR) + dir * 16;
    unsigned char* qkd = F.ws + WS_QKD + qkd_off(b, h, dir, n);
    const float qscale = GLA ? 0.08838834764831845f : 1.0f;
    float wgv[4] = {0.f, 0.f, 0.f, 0.f}, bgv[4] = {0.f, 0.f, 0.f, 0.f}; float lgv = 0.f;
    if (GLA) {
        const float* wg = F.in[10] + dir * 16 * 512 + h * 128 + 16 * w; const float* bg = F.in[11] + dir * 512 + h * 128 + 16 * w;
#pragma unroll
        for (int ks = 0; ks < 4; ++ks) wgv[ks] = wg[(4 * ks + g) * 512 + c];
#pragma unroll
        for (int i = 0; i < 4; ++i) bgv[i] = bg[4 * g + i];
    } else {
        const int hh = dir ? 3 - h : h; lgv = log2f(1.0f - exp2f(-5.0f - (float)hh));
    }
    {
#pragma unroll
        for (int i = 0; i < 2; ++i) { const int idx = tid + 512 * i, r = idx >> 4, ch = idx & 15;
            *(LAS v4u*)(lds + O_RQ + r * S128 + ch * 16) = R.q[i]; *(LAS v4u*)(lds + O_RK + r * S128 + ch * 16) = R.k[i]; }
        if (GLA && tid < 256) { LAS float* lr = (LAS float*)(lds + O_LR) + (tid >> 2) * 17 + (tid & 3) * 4; lr[0] = R.lr[0]; lr[1] = R.lr[1]; lr[2] = R.lr[2]; lr[3] = R.lr[3]; }
        if (pu_next < 2112) prepass_load<GLA>(F, pu_next, tid, R);
        LDS_BARRIER();
        f32x4 cum[4]; float tot[4];
        if (GLA) {
            const LAS float* lrs = (const LAS float*)(lds + O_LR);
            f32x4 la[4];
#pragma unroll
            for (int tt = 0; tt < 4; ++tt) {
                f32x4 a = {0.f, 0.f, 0.f, 0.f};
#pragma unroll
                for (int ks = 0; ks < 4; ++ks) a = __builtin_amdgcn_mfma_f32_16x16x4f32(wgv[ks], lrs[(16 * tt + c) * 17 + 4 * ks + g], a, 0, 0, 0);
#pragma unroll
                for (int i = 0; i < 4; ++i) {
                    const float y = (a[i] + bgv[i]) * -1.44269504089f;
                    la[tt][i] = (fmaxf(y, 0.f) + __builtin_amdgcn_logf(1.0f + __builtin_amdgcn_exp2f(-fabsf(y)))) * -0.0625f; }
            }
            float carry[4] = {0.f, 0.f, 0.f, 0.f};
#pragma unroll
            for (int tt = 0; tt < 4; ++tt)
#pragma unroll
                for (int i = 0; i < 4; ++i) {
                    const float x = la[tt][i];
#if SCAN_DPP
                    float v = x; v += row_shr<1>(v); v += row_shr<2>(v); v += row_shr<4>(v); v += row_shr<8>(v);
                    float r = x; r += row_ror<8>(r); r += row_ror<4>(r); r += row_ror<2>(r); r += row_ror<1>(r);
#else
                    float v = x, u;
                    u = __shfl_up(v, 1, 16); if (c >= 1) v += u;
                    u = __shfl_up(v, 2, 16); if (c >= 2) v += u;
                    u = __shfl_up(v, 4, 16); if (c >= 4) v += u;
                    u = __shfl_up(v, 8, 16); if (c >= 8) v += u;
                    const float r = __shfl(v, 15, 16);
#endif
                    cum[tt][i] = v + carry[i]; carry[i] += r;
                }
#pragma unroll
            for (int i = 0; i < 4; ++i) tot[i] = carry[i];
            if (dir) {
#pragma unroll
                for (int tt = 0; tt < 4; ++tt)
#pragma unroll
                    for (int i = 0; i < 4; ++i) cum[tt][i] = tot[i] - cum[tt][i] + la[tt][i];
            }
        } else {
#pragma unroll
            for (int tt = 0; tt < 4; ++tt) { const int t = 16 * tt + c; const float cv = dir ? (float)(64 - t) * lgv : (float)(t + 1) * lgv;
#pragma unroll
                for (int i = 0; i < 4; ++i) cum[tt][i] = cv; }
#pragma unroll
            for (int i = 0; i < 4; ++i) tot[i] = 64.0f * lgv;
        }
        float dec[4];
#pragma unroll
        for (int i = 0; i < 4; ++i) dec[i] = __builtin_amdgcn_exp2f(tot[i]);
#pragma unroll
        for (int tt = 0; tt < 4; ++tt) {
            const int t = 16 * tt + c;
            const v2u q4 = *(const LAS v2u*)(lds + O_RQ + t * S128 + (16 * w + 4 * g) * 2), k4 = *(const LAS v2u*)(lds + O_RK + t * S128 + (16 * w + 4 * g) * 2);
            const float qv[4] = {bflo(q4.x), bfhi(q4.x), bflo(q4.y), bfhi(q4.y)}, kv[4] = {bflo(k4.x), bfhi(k4.x), bflo(k4.y), bfhi(k4.y)};
            float qe[4], ke[4], kd[4];
            if (GLA) {
#pragma unroll
                for (int i = 0; i < 4; ++i) { const float e1 = __builtin_amdgcn_exp2f(cum[tt][i]), e2 = __builtin_amdgcn_exp2f(-cum[tt][i]);
                    qe[i] = qv[i] * qscale * e1; ke[i] = kv[i] * e2; kd[i] = ke[i] * dec[i]; }
            } else {
                const float e1 = __builtin_amdgcn_exp2f(cum[tt][0]), e2 = __builtin_amdgcn_exp2f(-cum[tt][0]), e3 = e2 * dec[0];
#pragma unroll
                for (int i = 0; i < 4; ++i) { qe[i] = qv[i] * e1; ke[i] = kv[i] * e2; kd[i] = kv[i] * e3; }
            }
            const unsigned d01 = cvt_pk(kd[0], kd[1]), d23 = cvt_pk(kd[2], kd[3]);
            *(LAS unsigned short*)(lds + O_KDT + (16 * w + 4 * g + 0) * S64 + t * 2) = (unsigned short)(d01 & 0xffffu);
            *(LAS unsigned short*)(lds + O_KDT + (16 * w + 4 * g + 1) * S64 + t * 2) = (unsigned short)(d01 >> 16);
            *(LAS unsigned short*)(lds + O_KDT + (16 * w + 4 * g + 2) * S64 + t * 2) = (unsigned short)(d23 & 0xffffu);
            *(LAS unsigned short*)(lds + O_KDT + (16 * w + 4 * g + 3) * S64 + t * 2) = (unsigned short)(d23 >> 16);
            v2u o; o.x = cvt_pk(qe[0], qe[1]); o.y = cvt_pk(qe[2], qe[3]); *(LAS v2u*)(lds + O_QE + t * S128 + (16 * w + 4 * g) * 2) = o;
            o.x = cvt_pk(ke[0], ke[1]); o.y = cvt_pk(ke[2], ke[3]); *(LAS v2u*)(lds + O_KE + t * S128 + (16 * w + 4 * g) * 2) = o;
        }
        if (c == 0) { f32x4 dv; dv[0] = dec[0]; dv[1] = dec[1]; dv[2] = dec[2]; dv[3] = dec[3]; *(f32x4*)(qkd + 40960 + (16 * w + 4 * g) * 4) = dv; }
        LDS_BARRIER();
        {
            const int it = w >> 1, p = w & 1;
            f32x4 sa[2];
#pragma unroll
            for (int jj = 0; jj < 2; ++jj) {
                const int jt = 2 * p + jj;
                sa[jj] = (f32x4){0.f, 0.f, 0.f, 0.f};
#pragma unroll
                for (int ks = 0; ks < 4; ++ks) { const bf16x8 a = *(const LAS bf16x8*)(lds + O_KE + (16 * jt + c) * S128 + (32 * ks + 8 * g) * 2), qf = *(const LAS bf16x8*)(lds + O_QE + (16 * it + c) * S128 + (32 * ks + 8 * g) * 2);
                    sa[jj] = mfma_bf16(a, qf, sa[jj]); }
                const int itok = 16 * it + c;
#pragma unroll
                for (int r = 0; r < 4; ++r) { const int j = 16 * jt + 4 * g + r; const bool keep = dir ? (j >= itok) : (j <= itok); sa[jj][r] = keep ? sa[jj][r] : 0.f; }
            }
            v4u t4; t4.x = cvt_pk(sa[0][0], sa[0][1]); t4.y = cvt_pk(sa[0][2], sa[0][3]); t4.z = cvt_pk(sa[1][0], sa[1][1]); t4.w = cvt_pk(sa[1][2], sa[1][3]);
            *(v4u*)(qkd + 16384 + ((it * 2 + p) * 64 + l) * 16) = t4;
        }
#pragma unroll
        for (int i = 0; i < 2; ++i) { const int idx = tid + 512 * i;
            *(v4u*)(qkd + (idx >> 4) * 256 + (idx & 15) * 16) = *(const LAS v4u*)(lds + O_QE + (idx >> 4) * S128 + (idx & 15) * 16);
            { const int r = idx >> 3, chn = idx & 7, pp = chn >> 2, gg = chn & 3;
              const v2u lo = *(const LAS v2u*)(lds + O_KDT + r * S64 + (32 * pp + 4 * gg) * 2), hi = *(const LAS v2u*)(lds + O_KDT + r * S64 + (32 * pp + 16 + 4 * gg) * 2);
              v4u o; o.x = lo.x; o.y = lo.y; o.z = hi.x; o.w = hi.y; *(v4u*)(qkd + 24576 + r * 128 + chn * 16) = o; } }
        LDS_BARRIER();
    }
}
typedef short trv4 __attribute__((ext_vector_type(4)));
template <bool GLA, bool NOSTORE = false, bool NOLOAD = false, bool NOBAR = false>
__device__ __forceinline__ void scan_unit(Frame& F, int unit) {
    const int s = unit & 3, dir = (unit >> 2) & 1, h = (unit >> 3) & 3, b = unit >> 5;
    PHASE_LOCALS
    const int w = wave, l = lane, g = l >> 4, c = l & 15;
    LAS unsigned char* lds = F.lds;
    constexpr int S128 = 272, S64 = 144;
    constexpr int O_VT = 0, O_ST = 18432, O_OI = 18432 + 34816;
    const bf16* Z = (const bf16*)(F.ws + WS_Z);
    constexpr int ldz = GLA ? ZC0 : ODC;
    const bf16* Zv = Z + 1024 + h * 256 + s * 64;
    bf16* O = (bf16*)(F.ws + (dir ? WS_OB : WS_OF)) + h * 256 + s * 64;
    const unsigned char* qkd0 = F.ws + WS_QKD + qkd_off(b, h, dir, 0);
    const int it = w >> 1, ep = w & 1;
    for (int i = tid; i < 17408 / 4; i += NTHR) ((LAS unsigned*)(lds + O_ST))[i] = 0u;
    f32x4 S[4];
#pragma unroll
    for (int et = 0; et < 4; ++et) S[et] = (f32x4){0.f, 0.f, 0.f, 0.f};
    struct StepRegs { v4u qf[4], P[2], ka[2], rv; f32x4 dec; };
    StepRegs RA, RB, RC;
#define SCAN_LOAD(R_, n_) do { const unsigned char* q_ = qkd0 + (size_t)(n_) * QKD_UNIT; const int rb_ = scan_rowbase((n_), b, dir); \
        _Pragma("unroll") for (int ks_ = 0; ks_ < 4; ++ks_) R_.qf[ks_] = *(const v4u*)(q_ + (16 * it + c) * 256 + (32 * ks_ + 8 * g) * 2); \
        _Pragma("unroll") for (int p_ = 0; p_ < 2; ++p_) { R_.P[p_] = *(const v4u*)(q_ + 16384 + ((it * 2 + p_) * 64 + l) * 16); R_.ka[p_] = *(const v4u*)(q_ + 24576 + (16 * w + c) * 128 + (32 * p_ + 8 * g) * 2); } \
        R_.dec = *(const f32x4*)(q_ + 40960 + (16 * w + 4 * g) * 4); \
        if ((n_) + 1 < 132) { const int rb1_ = scan_rowbase((n_) + 1, b, dir); R_.rv = *(const v4u*)(Zv + (size_t)(rb1_ + (tid >> 3)) * ldz + (tid & 7) * 8); } (void)rb_; } while (0)
#define OI_STORE(n_, buf_) do { const int rbp_ = scan_rowbase((n_), b, dir); \
        *(v4u*)(O + (size_t)(rbp_ + (tid >> 3)) * 1024 + (tid & 7) * 8) = *(const LAS v4u*)(lds + O_OI + (buf_) * 9216 + (tid >> 3) * S64 + (tid & 7) * 16); } while (0)
#define VT_WRITE(R_, buf_) do { *(LAS v4u*)(lds + O_VT + (buf_) * 9216 + (tid >> 3) * S64 + (tid & 7) * 16) = R_.rv; } while (0)
#define SCAN_STEP(R_, R1_, R2_, n_) do { \
        if (!NOSTORE && (n_) >= 1 && (GLA || (n_) >= 5)) OI_STORE((n_) - 1, cur ^ 1);     \
        if (!NOLOAD && (n_) + 2 < 132) SCAN_LOAD(R2_, (n_) + 2); \
        const LAS unsigned char* vtc = lds + O_VT + cur * 9216; const LAS unsigned char* stc = lds + O_ST + cur * 17408; \
          \
          \
        v4u vfr[4][2]; bf16x8 sf[2][4]; \
        _Pragma("unroll") for (int et = 0; et < 4; ++et) \
            _Pragma("unroll") for (int p = 0; p < 2; ++p) { \
                const trv4 lo = __builtin_amdgcn_ds_read_tr16_b64_v4i16((LAS trv4*)(vtc + (32 * p + 4 * g + (c >> 2)) * S64 + (16 * et + 4 * (c & 3)) * 2)); \
                const trv4 hi = __builtin_amdgcn_ds_read_tr16_b64_v4i16((LAS trv4*)(vtc + (32 * p + 16 + 4 * g + (c >> 2)) * S64 + (16 * et + 4 * (c & 3)) * 2)); \
                const v2u l2 = __builtin_bit_cast(v2u, lo), h2 = __builtin_bit_cast(v2u, hi); vfr[et][p] = (v4u){l2.x, l2.y, h2.x, h2.y}; } \
        _Pragma("unroll") for (int en = 0; en < 2; ++en) \
            _Pragma("unroll") for (int ks = 0; ks < 4; ++ks) sf[en][ks] = *(const LAS bf16x8*)(stc + (16 * (2 * ep + en) + c) * S128 + (32 * ks + 8 * g) * 2); \
        if ((n_) + 1 < 132) VT_WRITE(R_, cur ^ 1); \
        _Pragma("unroll") for (int en = 0; en < 2; ++en) { \
            const int et = 2 * ep + en; f32x4 acc = {0.f, 0.f, 0.f, 0.f}; \
            _Pragma("unroll") for (int p = 0; p < 2; ++p) acc = mfma_bf16(__builtin_bit_cast(bf16x8, en == 0 ? (ep == 0 ? vfr[0][p] : vfr[2][p]) : (ep == 0 ? vfr[1][p] : vfr[3][p])), __builtin_bit_cast(bf16x8, R_.P[p]), acc); \
            _Pragma("unroll") for (int ks = 0; ks < 4; ++ks) acc = mfma_bf16(sf[en][ks], __builtin_bit_cast(bf16x8, R_.qf[ks]), acc); \
            { v2u o; o.x = cvt_pk(acc[0], acc[1]); o.y = cvt_pk(acc[2], acc[3]); *(LAS v2u*)(lds + O_OI + cur * 9216 + (16 * it + c) * S64 + (16 * et + 4 * g) * 2) = o; } } \
        { LAS unsigned char* stn = lds + O_ST + (cur ^ 1) * 17408; \
            _Pragma("unroll") for (int et = 0; et < 4; ++et) { \
                _Pragma("unroll") for (int i = 0; i < 4; ++i) S[et][i] *= R_.dec[i]; \
                _Pragma("unroll") for (int p = 0; p < 2; ++p) S[et] = mfma_bf16(__builtin_bit_cast(bf16x8, R_.ka[p]), __builtin_bit_cast(bf16x8, vfr[et][p]), S[et]); \
                v2u o; o.x = cvt_pk(S[et][0], S[et][1]); o.y = cvt_pk(S[et][2], S[et][3]); \
                *(LAS v2u*)(stn + (16 * et + c) * S128 + (16 * w + 4 * g) * 2) = o; } } \
        cur ^= 1; \
        if (!NOBAR) LDS_BARRIER(); } while (0)
    { const int rb0 = scan_rowbase(0, b, dir); RC.rv = *(const v4u*)(Zv + (size_t)(rb0 + (tid >> 3)) * ldz + (tid & 7) * 8); }
    SCAN_LOAD(RA, 0); SCAN_LOAD(RB, 1); if (NOLOAD) SCAN_LOAD(RC, 2);
    int cur = 0;
    VT_WRITE(RC, 0);
    LDS_BARRIER();
#pragma unroll 1
    for (int n = 0; n < 132; n += 3) { SCAN_STEP(RA, RB, RC, n); SCAN_STEP(RB, RC, RA, n + 1); SCAN_STEP(RC, RA, RB, n + 2); }
    if (!NOSTORE) OI_STORE(131, cur ^ 1);
#undef VT_WRITE
#undef OI_STORE
#undef SCAN_STEP
    __syncthreads();
#undef SCAN_LOAD
}
__device__ __forceinline__ f32x2v cmul(f32x2v a, f32x2v b) { return (f32x2v){a.x * b.x - a.y * b.y, a.x * b.y + a.y * b.x}; }
__device__ __forceinline__ f32x2v twid(float turns) { return (f32x2v){__builtin_amdgcn_cosf(turns), __builtin_amdgcn_sinf(turns)}; }
__device__ __forceinline__ int rev4_14(int p) { const unsigned y = __brev((unsigned)p) >> 18; return (int)(((y & 0x1555u) << 1) | ((y >> 1) & 0x1555u)); }

__device__ __forceinline__ int fpad(int i) { return i + ((i >> 6) << 2); }
__device__ __forceinline__ f32x2v cmulp(f32x2v a, f32x2v w) { f32x2v r = a.x * w; r += a.y * (f32x2v){-w.y, w.x}; return r; }
__device__ __forceinline__ f32x2v cmulc(f32x2v a, f32x2v w) { f32x2v r = a.x * (f32x2v){w.x, -w.y}; r += a.y * (f32x2v){w.y, w.x}; return r; }
__device__ __forceinline__ f32x2v mul_mi(f32x2v t) { return (f32x2v){t.y, -t.x}; }
__device__ __forceinline__ f32x2v mul_pi(f32x2v t) { return (f32x2v){-t.y, t.x}; }
#define BF4F(A0, A1, A2, A3) do { const f32x2v b0_ = A0 + A2, b1_ = A0 - A2, b2_ = A1 + A3, b3_ = mul_mi(A1 - A3); A0 = b0_ + b2_; A1 = b1_ + b3_; A2 = b0_ - b2_; A3 = b1_ - b3_; } while (0)
#define BF4I(A0, A1, A2, A3) do { const f32x2v b0_ = A0 + A2, b1_ = A0 - A2, b2_ = A1 + A3, b3_ = mul_pi(A1 - A3); A0 = b0_ + b2_; A1 = b1_ + b3_; A2 = b0_ - b2_; A3 = b1_ - b3_; } while (0)
#define W16_1 ((f32x2v){0.92387953251f, -0.38268343236f})
#define W16_2 ((f32x2v){0.70710678118f, -0.70710678118f})
#define W16_3 ((f32x2v){0.38268343236f, -0.92387953251f})
#define W16_6 ((f32x2v){-0.70710678118f, -0.70710678118f})
#define W16_9 ((f32x2v){-0.92387953251f, 0.38268343236f})
template <int M, bool ZPAD>
__device__ __forceinline__ void fft_fwd16(LAS f32x2v* x, int tid) {
    constexpr int Q16 = M / 16;
#pragma unroll 1
    for (int i = 0; i < 2; ++i) {
        const int bf = tid + 512 * i, blk = bf / Q16, k = bf % Q16, base = blk * M + k;
        f32x2v a[16];
#pragma unroll
        for (int j = 0; j < 16; ++j) a[j] = (ZPAD && j >= 8) ? (f32x2v){0.f, 0.f} : x[fpad(base + j * Q16)];
        const f32x2v w1 = twid(-(float)k * (1.0f / (float)M)), w2 = cmulp(w1, w1), w3 = cmulp(w2, w1), w4 = cmulp(w2, w2), w8 = cmulp(w4, w4), w12 = cmulp(w8, w4);
#pragma unroll
        for (int jp = 0; jp < 4; ++jp) {
            if (ZPAD) { const f32x2v a0 = a[jp], a1 = a[jp + 4], b3 = mul_mi(a1); a[jp] = a0 + a1; a[jp + 4] = a0 + b3; a[jp + 8] = a0 - a1; a[jp + 12] = a0 - b3; }
            else BF4F(a[jp], a[jp + 4], a[jp + 8], a[jp + 12]);
            a[jp + 4] = cmulp(a[jp + 4], w1); a[jp + 8] = cmulp(a[jp + 8], w2); a[jp + 12] = cmulp(a[jp + 12], w3);
        }
        a[5] = cmulp(a[5], W16_1); a[9] = cmulp(a[9], W16_2); a[13] = cmulp(a[13], W16_3);
        a[6] = cmulp(a[6], W16_2); a[10] = mul_mi(a[10]);      a[14] = cmulp(a[14], W16_6);
        a[7] = cmulp(a[7], W16_3); a[11] = cmulp(a[11], W16_6); a[15] = cmulp(a[15], W16_9);
#pragma unroll
        for (int q = 0; q < 4; ++q) {
            BF4F(a[4 * q], a[4 * q + 1], a[4 * q + 2], a[4 * q + 3]);
            a[4 * q + 1] = cmulp(a[4 * q + 1], w4); a[4 * q + 2] = cmulp(a[4 * q + 2], w8); a[4 * q + 3] = cmulp(a[4 * q + 3], w12);
        }
#pragma unroll
        for (int j = 0; j < 16; ++j) x[fpad(base + j * Q16)] = a[j];
    }
    __syncthreads();
}
template <int M, bool HALF>
__device__ __forceinline__ void fft_inv16(LAS f32x2v* x, int tid) {
    constexpr int Q16 = M / 16;
#pragma unroll 1
    for (int i = 0; i < 2; ++i) {
        const int bf = tid + 512 * i, blk = bf / Q16, k = bf % Q16, base = blk * M + k;
        f32x2v a[16];
#pragma unroll
        for (int j = 0; j < 16; ++j) a[j] = x[fpad(base + j * Q16)];
        const f32x2v w1 = twid(-(float)k * (1.0f / (float)M)), w2 = cmulp(w1, w1), w3 = cmulp(w2, w1), w4 = cmulp(w2, w2), w8 = cmulp(w4, w4), w12 = cmulp(w8, w4);
#pragma unroll
        for (int q = 0; q < 4; ++q) {
            a[4 * q + 1] = cmulc(a[4 * q + 1], w4); a[4 * q + 2] = cmulc(a[4 * q + 2], w8); a[4 * q + 3] = cmulc(a[4 * q + 3], w12);
            BF4I(a[4 * q], a[4 * q + 1], a[4 * q + 2], a[4 * q + 3]);
        }
        a[5] = cmulc(a[5], W16_1); a[9] = cmulc(a[9], W16_2); a[13] = cmulc(a[13], W16_3);
        a[6] = cmulc(a[6], W16_2); a[10] = mul_pi(a[10]);      a[14] = cmulc(a[14], W16_6);
        a[7] = cmulc(a[7], W16_3); a[11] = cmulc(a[11], W16_6); a[15] = cmulc(a[15], W16_9);
#pragma unroll
        for (int jp = 0; jp < 4; ++jp) {
            a[jp + 4] = cmulc(a[jp + 4], w1); a[jp + 8] = cmulc(a[jp + 8], w2); a[jp + 12] = cmulc(a[jp + 12], w3);
            if (HALF) { const f32x2v b0 = a[jp] + a[jp + 8], b1 = a[jp] - a[jp + 8], b2 = a[jp + 4] + a[jp + 12], b3 = mul_pi(a[jp + 4] - a[jp + 12]); a[jp] = b0 + b2; a[jp + 4] = b1 + b3; }
            else BF4I(a[jp], a[jp + 4], a[jp + 8], a[jp + 12]);
        }
#pragma unroll
        for (int j = 0; j < (HALF ? 8 : 16); ++j) x[fpad(base + j * Q16)] = a[j];
    }
    __syncthreads();
}
template <bool INV>
__device__ __forceinline__ void fft_r4(LAS f32x2v* x, int tid) {
#pragma unroll 2
    for (int i = 0; i < 8; ++i) {
        const int bf = tid + 512 * i; LAS f32x4* p = (LAS f32x4*)(x + fpad(4 * bf));
        const f32x4 u = p[0], v = p[1];
        f32x2v a0 = {u[0], u[1]}, a1 = {u[2], u[3]}, a2 = {v[0], v[1]}, a3 = {v[2], v[3]};
        if (INV) BF4I(a0, a1, a2, a3); else BF4F(a0, a1, a2, a3);
        p[0] = (f32x4){a0.x, a0.y, a1.x, a1.y}; p[1] = (f32x4){a2.x, a2.y, a3.x, a3.y};
    }
    __syncthreads();
}
template <bool ZPAD> __device__ __forceinline__ void fft_fwd(LAS f32x2v* x, int tid) { fft_fwd16<16384, ZPAD>(x, tid); fft_fwd16<1024, false>(x, tid); fft_fwd16<64, false>(x, tid); fft_r4<false>(x, tid); }
template <bool HALF> __device__ __forceinline__ void fft_inv(LAS f32x2v* x, int tid) { fft_r4<true>(x, tid); fft_inv16<64, false>(x, tid); fft_inv16<1024, false>(x, tid); fft_inv16<16384, HALF>(x, tid); }
__device__ __forceinline__ void spec_mul(LAS f32x2v* x, const f32x2v* ks, float kny, int tid) {
#pragma unroll 1
    for (int h = 0; h < 2; ++h) {
        f32x2v kv[8];
#pragma unroll
        for (int i = 0; i < 8; ++i) kv[i] = ks[tid + 512 * (8 * h + i)];
#pragma unroll
        for (int i = 0; i < 8; ++i) {
            const int idx = tid + 512 * (8 * h + i), p = (idx >> 1) * 4 + (idx & 1), f = rev4_14(p), pp = rev4_14((FFTN - f) & (FFTN - 1));
            const f32x2v k = kv[i];
            const int ip = fpad(p), iq = fpad(pp);
            const f32x2v xp = x[ip], xq = x[iq];
            x[ip] = cmulp(xp, k);
            if (pp != p) x[iq] = cmulc(xq, k);
            if (idx == 0) { const f32x2v x2 = x[2]; x[2] = x2 * kny; }
        }
    }
    __syncthreads();
}
__device__ __forceinline__ float block_sum2(LAS float* red, float v, int tid, int wave, int lane, int slot) {
    v = wave_sum(v); if (lane == 0) red[slot * 8 + wave] = v; __syncthreads();
    float s = 0.f;
#pragma unroll
    for (int i = 0; i < 8; ++i) s += red[slot * 8 + i];
    return s;
}
template <int HYV, int PART = 0>
__device__ __forceinline__ void hyena_unit(Frame& F, int ch) {
    PHASE_LOCALS
    LAS f32x2v* cb = (LAS f32x2v*)F.lds;
    LAS float* cbf = (LAS float*)F.lds;
    LAS float* w3c = (LAS float*)(F.lds + LDSCTL_OFF + 2048);
    LAS float* red = (LAS float*)(F.lds + LDSCTL_OFF + 3072);
    const bf16* UT = (const bf16*)F.out; bf16* HYO = (bf16*)(F.ws + (HYV ? WS_END : WS_H));
    const float* hdnL = (const float*)(F.ws + WS_HDNL); const float* hdnC = (const float*)(F.ws + WS_HDNC);
    unsigned char* hs = F.ws + WS_ACT + (size_t)F.bx * HYS_BYTES;
    f32x2v* KA = (f32x2v*)hs; f32x2v* KB = (f32x2v*)(hs + 65536); f32x2v* ZS = (f32x2v*)(hs + 131072); float* KX = (float*)(hs + 196608);
    const float bias0 = F.in[20][ch], bias1 = F.in[20][1024 + ch];
    const float delta = fabsf(-3.0701134573253945f + (-15.350567286626972f + 3.0701134573253945f) * ((float)ch / 1023.0f));
    const bf16* uz = UT + (size_t)ch * NROW; const bf16* ug1 = UT + (size_t)(1024 + ch) * NROW; const bf16* ug2 = UT + (size_t)(2048 + ch) * NROW;
    bf16* ho = HYO + (size_t)ch * NROW;
    __syncthreads();
    if (PART != 1 && tid < 256) { const int q = tid >> 6, j = tid & 63; w3c[tid] = F.in[19][(size_t)j * 4096 + q * 1024 + ch]; }
    __syncthreads();
    if (!(HYV & 2) && PART != 1) {
        LAS float* kf = cbf;
        LAS float* zc = cbf + 1024;
        LAS float* g1c = cbf + 1536; LAS float* g2c = cbf + 2048; LAS float* y1c = cbf + 2560;
        float s0 = 0.f, s1 = 0.f;
        if (tid < 256) {
            const int l = tid; const float* hr = hdnC + l * 64; float a[4] = {0.f, 0.f, 0.f, 0.f};
#pragma unroll
            for (int jj = 0; jj < 16; ++jj) { const f32x4 hv = *(const f32x4*)(hr + 4 * jj);
#pragma unroll
                for (int q = 0; q < 4; ++q) { const f32x4 wv = *(const LAS f32x4*)(w3c + q * 64 + 4 * jj); a[q] += hv[0] * wv[0] + hv[1] * wv[1] + hv[2] * wv[2] + hv[3] * wv[3]; } }
            const float mult = __expf(-((float)l / 255.0f) * delta) + 0.05f;
#pragma unroll
            for (int q = 0; q < 4; ++q) { a[q] *= mult; kf[q * 256 + l] = a[q]; }
            s0 = fabsf(a[0]) + (l >= 1 ? fabsf(a[1]) : 0.f); s1 = fabsf(a[2]) + (l >= 1 ? fabsf(a[3]) : 0.f);
        }
        zc[tid] = bf2f(uz[tid]); g1c[tid] = bf2f(ug1[tid]); g2c[tid] = bf2f(ug2[tid]);
        const float n0 = block_sum2(red, s0, tid, wave, lane, 0), n1 = block_sum2(red, s1, tid, wave, lane, 1);
        const int bb = tid >> 8, t = tid & 255;
        float y = 0.f;
        for (int sidx = 0; sidx < 256; ++sidx) { const int m = t - sidx; const float kv = m >= 0 ? kf[m] : kf[256 - m]; y += kv * zc[bb * 256 + sidx]; }
        const float y1 = g1c[tid] * (y / n0 + zc[tid] * bias0);
        y1c[tid] = y1;
        __syncthreads();
        y = 0.f;
        for (int sidx = 0; sidx < 256; ++sidx) { const int m = t - sidx; const float kv = m >= 0 ? kf[512 + m] : kf[768 - m]; y += kv * y1c[bb * 256 + sidx]; }
        const float o = g2c[tid] * (y / n1 + y1 * bias1);
        ho[tid] = (bf16)f2bf(o);
        __syncthreads();
    }
    if (PART == 2) return;
    if (!(HYV & 4)) {
        float s0 = 0.f, s1 = 0.f;
        const float* f0p = (const float*)(F.ws + WS_FILT0) + (size_t)ch * 8192; const float* f1p = (const float*)(F.ws + WS_FILT1) + (size_t)ch * 8192;
        const float* f2p = (const float*)(F.ws + WS_FILT2) + (size_t)ch * 8192; const float* f3p = (const float*)(F.ws + WS_FILT3) + (size_t)ch * 8192;
#pragma unroll
        for (int i = 0; i < 4; ++i) {
            const int l4 = (tid + 512 * i) * 4;
            const f32x4 a0 = *(const f32x4*)(f0p + l4), a1 = *(const f32x4*)(f1p + l4), a2 = *(const f32x4*)(f2p + l4), a3 = *(const f32x4*)(f3p + l4);
#pragma unroll
            for (int j = 0; j < 4; ++j) {
                const int l = l4 + j;
                const float mult = __expf(-((float)l / 8191.0f) * delta) + 0.05f;
                const float b0 = a0[j] * mult, b1 = a1[j] * mult, b2 = a2[j] * mult, b3 = a3[j] * mult;
                cb[fpad(l)] = (f32x2v){b0, b2};
                if (l >= 1) { cb[fpad(FFTN - l)] = (f32x2v){b1, b3}; s0 += fabsf(b1); s1 += fabsf(b3); } else cb[fpad(8192)] = (f32x2v){0.f, 0.f};
                s0 += fabsf(b0); s1 += fabsf(b2);
            }
        }
        const float n0 = block_sum2(red, s0, tid, wave, lane, 2), n1 = block_sum2(red, s1, tid, wave, lane, 3);
        if (!(HYV & 1)) fft_fwd<false>(cb, tid);
        const float sc0 = 1.0f / (n0 * (float)FFTN), sc1 = 1.0f / (n1 * (float)FFTN);
#pragma unroll 2
        for (int i = 0; i < 16; ++i) {
            const int idx = tid + 512 * i, p = (idx >> 1) * 4 + (idx & 1), f = rev4_14(p), pp = rev4_14((FFTN - f) & (FFTN - 1));
            const f32x2v zf = cb[fpad(p)], zq = cb[fpad(pp)]; const f32x2v zc = (f32x2v){zq.x, -zq.y};
            const f32x2v sm = zf + zc, df = zf - zc;
            KA[idx] = sm * (0.5f * sc0); KB[idx] = (f32x2v){df.y, -df.x} * (0.5f * sc1);
            if (idx == 0) { const f32x2v z2 = cb[2]; KX[0] = z2.x * sc0; KX[1] = z2.y * sc1; }
        }
        __syncthreads();
    }
    const float kny0 = KX[0], kny1 = KX[1];
#pragma unroll
    for (int i = 0; i < 2; ++i) {
        const int t8 = (tid + 512 * i) * 8;
        const v4u a = *(const v4u*)(uz + NCTX + t8), b = *(const v4u*)(uz + NCTX + SEQ + t8);
        const unsigned av[4] = {a.x, a.y, a.z, a.w}, bv[4] = {b.x, b.y, b.z, b.w};
#pragma unroll
        for (int q = 0; q < 4; ++q) { cb[fpad(t8) + 2 * q] = (f32x2v){bflo(av[q]), bflo(bv[q])}; cb[fpad(t8) + 2 * q + 1] = (f32x2v){bfhi(av[q]), bfhi(bv[q])}; }
    }
    __syncthreads();
    if (!(HYV & 1)) fft_fwd<true>(cb, tid); spec_mul(cb, KA, kny0, tid); if (!(HYV & 1)) fft_inv<true>(cb, tid);
#pragma unroll
    for (int i = 0; i < 2; ++i) {
        const int t8 = (tid + 512 * i) * 8;
        const v4u a = *(const v4u*)(uz + NCTX + t8), b = *(const v4u*)(uz + NCTX + SEQ + t8), ga = *(const v4u*)(ug1 + NCTX + t8), gb = *(const v4u*)(ug1 + NCTX + SEQ + t8);
        const unsigned av[4] = {a.x, a.y, a.z, a.w}, bv[4] = {b.x, b.y, b.z, b.w}, gav[4] = {ga.x, ga.y, ga.z, ga.w}, gbv[4] = {gb.x, gb.y, gb.z, gb.w};
#pragma unroll
        for (int q = 0; q < 8; ++q) {
            const float z0 = (q & 1) ? bfhi(av[q >> 1]) : bflo(av[q >> 1]), z1 = (q & 1) ? bfhi(bv[q >> 1]) : bflo(bv[q >> 1]);
            const float g0 = (q & 1) ? bfhi(gav[q >> 1]) : bflo(gav[q >> 1]), g1 = (q & 1) ? bfhi(gbv[q >> 1]) : bflo(gbv[q >> 1]);
            const f32x2v cv = cb[fpad(t8) + q];
            const f32x2v y = (f32x2v){g0 * (cv.x + z0 * bias0), g1 * (cv.y + z1 * bias0)};
            cb[fpad(t8) + q] = y; ZS[t8 + q] = y;
        }
    }
    __syncthreads();
    if (!(HYV & 1)) fft_fwd<true>(cb, tid); spec_mul(cb, KB, kny1, tid); if (!(HYV & 1)) fft_inv<true>(cb, tid);
#pragma unroll
    for (int i = 0; i < 2; ++i) {
        const int t8 = (tid + 512 * i) * 8;
        const v4u ga = *(const v4u*)(ug2 + NCTX + t8), gb = *(const v4u*)(ug2 + NCTX + SEQ + t8);
        const unsigned gav[4] = {ga.x, ga.y, ga.z, ga.w}, gbv[4] = {gb.x, gb.y, gb.z, gb.w};
        float o0[8], o1[8];
#pragma unroll
        for (int q = 0; q < 8; ++q) {
            const float g0 = (q & 1) ? bfhi(gav[q >> 1]) : bflo(gav[q >> 1]), g1 = (q & 1) ? bfhi(gbv[q >> 1]) : bflo(gbv[q >> 1]);
            const f32x2v cv = cb[fpad(t8) + q], y1 = ZS[t8 + q];
            o0[q] = g0 * (cv.x + y1.x * bias1); o1[q] = g1 * (cv.y + y1.y * bias1);
        }
        v4u w0, w1; w0.x = pk2(o0[0], o0[1]); w0.y = pk2(o0[2], o0[3]); w0.z = pk2(o0[4], o0[5]); w0.w = pk2(o0[6], o0[7]);
        w1.x = pk2(o1[0], o1[1]); w1.y = pk2(o1[2], o1[3]); w1.z = pk2(o1[4], o1[5]); w1.w = pk2(o1[6], o1[7]);
        *(v4u*)(ho + NCTX + t8) = w0; *(v4u*)(ho + NCTX + SEQ + t8) = w1;
    }
    __syncthreads();
}
__device__ __forceinline__ void attn_unit(Frame& F, int unit) {
    const int qb = unit & 127, kvh = (unit >> 7) & 1, b = unit >> 8;
    PHASE_LOCALS
    const int w = wave, l = lane, g = l >> 4, c = l & 15;
    const int hq = w >> 1, th = w & 1, head = kvh * 4 + hq, q0 = qb * 64;
    LAS unsigned char* lds = F.lds;
    constexpr int O_KT = 0, O_VT = 17408;
    const bf16* Z = (const bf16*)(F.ws + WS_Z); bf16* MIX = (bf16*)(F.ws + WS_MIX);
    bf16x8 qf[2][4];
#pragma unroll
    for (int it = 0; it < 2; ++it)
#pragma unroll
        for (int ks = 0; ks < 4; ++ks) qf[it][ks] = *(const bf16x8*)(Z + (size_t)(NCTX + b * SEQ + q0 + 32 * th + 16 * it + c) * ODC + 3072 + head * 128 + 32 * ks + 8 * g);
    const float sink = F.in[26][head];
    float m_run[2] = {sink, sink}, l_run[2] = {1.f, 1.f};
    f32x4 Oa[8][2];
#pragma unroll
    for (int dt = 0; dt < 8; ++dt) { Oa[dt][0] = (f32x4){0.f, 0.f, 0.f, 0.f}; Oa[dt][1] = (f32x4){0.f, 0.f, 0.f, 0.f}; }
    v4u kvr[2], vvr[2];
#define ATTN_LOAD(kt_) do { _Pragma("unroll") for (int i = 0; i < 2; ++i) { \
            const int idx = tid + 512 * i, key = idx >> 4, chn = idx & 15; int row; bool valid = true; \
            if ((kt_) < 4) row = b * CTXL + 64 * (kt_) + key; \
            else { const int pos = q0 - 128 + 64 * ((kt_) - 4) + key; valid = pos >= 0 && pos < SEQ; row = NCTX + b * SEQ + pos; } \
            kvr[i] = (v4u){0u, 0u, 0u, 0u}; vvr[i] = (v4u){0u, 0u, 0u, 0u}; \
            if (valid) { const bf16* zr = Z + (size_t)row * ODC; kvr[i] = *(const v4u*)(zr + 4096 + kvh * 128 + chn * 8); vvr[i] = *(const v4u*)(zr + 4352 + kvh * 128 + chn * 8); } } } while (0)
    ATTN_LOAD(0);
    __syncthreads();
#pragma unroll 1
    for (int kt = 0; kt < 9; ++kt) {
        if (kt) LDS_BARRIER();
#pragma unroll
        for (int i = 0; i < 2; ++i) {
            const int idx = tid + 512 * i, key = idx >> 4, chn = idx & 15;
            *(LAS v4u*)(lds + O_KT + key * 272 + chn * 16) = kvr[i];
            *(LAS v4u*)(lds + O_VT + key * 272 + chn * 16) = vvr[i];
        }
        if (kt + 1 < 9) ATTN_LOAD(kt + 1);
        LDS_BARRIER();
        f32x4 sa[4][2];
#pragma unroll
        for (int jt = 0; jt < 4; ++jt) {
            sa[jt][0] = (f32x4){0.f, 0.f, 0.f, 0.f}; sa[jt][1] = (f32x4){0.f, 0.f, 0.f, 0.f};
#pragma unroll
            for (int ks = 0; ks < 4; ++ks) { const bf16x8 a = *(const LAS bf16x8*)(lds + O_KT + (16 * jt + c) * 272 + (32 * ks + 8 * g) * 2);
                sa[jt][0] = mfma_bf16(a, qf[0][ks], sa[jt][0]); sa[jt][1] = mfma_bf16(a, qf[1][ks], sa[jt][1]); }
        }
        if (kt >= 4) {
#pragma unroll
            for (int jt = 0; jt < 4; ++jt)
#pragma unroll
                for (int it = 0; it < 2; ++it)
#pragma unroll
                    for (int r = 0; r < 4; ++r) {
                        const int kpos = q0 - 128 + 64 * (kt - 4) + 16 * jt + 4 * g + r, qpos = q0 + 32 * th + 16 * it + c, d = qpos - kpos;
                        const bool ok = kpos >= 0 && kpos < SEQ && d <= 128 && d >= -128;
                        sa[jt][it][r] = ok ? sa[jt][it][r] : -1.0e30f;
                    }
        }
        bf16x8 P[2][2];
#pragma unroll
        for (int it = 0; it < 2; ++it) {
            float mx = -3.0e38f;
#pragma unroll
            for (int jt = 0; jt < 4; ++jt)
#pragma unroll
                for (int r = 0; r < 4; ++r) mx = fmaxf(mx, sa[jt][it][r]);
            mx = fmaxf(mx, __shfl_xor(mx, 16)); mx = fmaxf(mx, __shfl_xor(mx, 32));
            const float mn = fmaxf(m_run[it], mx), alpha = __expf(m_run[it] - mn);
            float rs = 0.f;
#pragma unroll
            for (int jt = 0; jt < 4; ++jt)
#pragma unroll
                for (int r = 0; r < 4; ++r) { const float p = __expf(sa[jt][it][r] - mn); sa[jt][it][r] = p; rs += p; }
            rs += __shfl_xor(rs, 16); rs += __shfl_xor(rs, 32);
            l_run[it] = l_run[it] * alpha + rs; m_run[it] = mn;
#pragma unroll
            for (int dt = 0; dt < 8; ++dt) Oa[dt][it] *= alpha;
#pragma unroll
            for (int p2 = 0; p2 < 2; ++p2) { v4u t4; t4.x = cvt_pk(sa[2 * p2][it][0], sa[2 * p2][it][1]); t4.y = cvt_pk(sa[2 * p2][it][2], sa[2 * p2][it][3]);
                t4.z = cvt_pk(sa[2 * p2 + 1][it][0], sa[2 * p2 + 1][it][1]); t4.w = cvt_pk(sa[2 * p2 + 1][it][2], sa[2 * p2 + 1][it][3]); P[p2][it] = __builtin_bit_cast(bf16x8, t4); }
        }
#pragma unroll
        for (int dt = 0; dt < 8; ++dt)
#pragma unroll
            for (int p2 = 0; p2 < 2; ++p2) {
                const trv4 lo4 = __builtin_amdgcn_ds_read_tr16_b64_v4i16((LAS trv4*)(lds + O_VT + (32 * p2 + 4 * g + (c >> 2)) * 272 + (16 * dt + 4 * (c & 3)) * 2));
                const trv4 hi4 = __builtin_amdgcn_ds_read_tr16_b64_v4i16((LAS trv4*)(lds + O_VT + (32 * p2 + 16 + 4 * g + (c >> 2)) * 272 + (16 * dt + 4 * (c & 3)) * 2));
                const v2u lo = __builtin_bit_cast(v2u, lo4), hi = __builtin_bit_cast(v2u, hi4);
                v4u a4; a4.x = lo.x; a4.y = lo.y; a4.z = hi.x; a4.w = hi.y; const bf16x8 a = __builtin_bit_cast(bf16x8, a4);
                Oa[dt][0] = mfma_bf16(a, P[p2][0], Oa[dt][0]); Oa[dt][1] = mfma_bf16(a, P[p2][1], Oa[dt][1]);
            }
    }
#pragma unroll
    for (int it = 0; it < 2; ++it) {
        const float inv = 1.0f / l_run[it];
        bf16* orow = MIX + (size_t)(NCTX + b * SEQ + q0 + 32 * th + 16 * it + c) * DM + 1024 + head * 128 + 4 * g;
#pragma unroll
        for (int dt = 0; dt < 8; ++dt) { const f32x4 o = Oa[dt][it] * inv; v2u wv; wv.x = cvt_pk(o[0], o[1]); wv.y = cvt_pk(o[2], o[3]); *(v2u*)(orow + 16 * dt) = wv; }
    }
#undef ATTN_LOAD
    __syncthreads();
}
constexpr int N_PHASES = 25;
constexpr int QSLOT_OFF = LDSCTL_OFF + 256;

__global__ void __launch_bounds__(NTHR, 2) mk_fwd(Args args) {
    extern __shared__ __attribute__((aligned(16))) unsigned char lds_raw[];
    Frame F;
    F.lds = (LAS unsigned char*)lds_raw;
    F.G = gridDim.x; F.bx = blockIdx.x; F.NGW = F.G * NWAVES;
    F.in = (const float* const __attribute__((address_space(4)))*)__builtin_amdgcn_kernarg_segment_ptr();
    F.out = args.out; F.ws = args.ws;
    for (int u = threadIdx.x; u < (LDS_BYTES - LDSCTL_OFF) / 4; u += NTHR) ((LAS unsigned*)(F.lds + LDSCTL_OFF))[u] = 0u;
    __syncthreads();
    const int lo = args.ph_lo, hi = args.ph_hi;
    XcdBarrier bar; bar.bar = (unsigned*)(F.ws + WS_CTL) + CW_BAR; bar.x = 0; bar.st = nullptr;
    if (hi - lo > 1) bar = xcd_barrier_post((unsigned*)(F.ws + WS_CTL) + CW_BAR, (volatile LAS unsigned*)(F.lds + MISC_OFF) + 8);
#ifndef PHASE_ENABLE
#define PHASE_ENABLE 0xFFFFFFFFu
#endif
#ifndef DUP_SITE
#define DUP_SITE -1
#endif
#ifndef DUP_LAYER
#define DUP_LAYER 0
#endif
#define TAILCONV 1
#ifndef DUP_HYV
#define DUP_HYV 0
#endif
#ifndef DUP_MIX_EN
#define DUP_MIX_EN 15
#endif
#ifndef MIX_EN
#define MIX_EN 31
#endif
#define EN(s) (((PHASE_ENABLE) >> (s)) & 1u)
#define IN(k) (lo <= (k) && (k) < hi)
#define SEAM(k) do { if (IN(k) && IN((k) + 1)) { xcd_barrier(bar); if (DUP_SITE == 99) xcd_barrier(bar); } } while (0)
    unsigned char* ws = F.ws;
    float* X = (float*)(ws + WS_X); bf16* H = (bf16*)(ws + WS_H); bf16* Zb = (bf16*)(ws + WS_Z); bf16* MIX = (bf16*)(ws + WS_MIX); bf16* ACT = (bf16*)(ws + WS_ACT);
    const float* mod = (const float*)(ws + WS_MOD);
    const LAS int* toff = (const LAS int*)(F.lds + TOFF_OFF);

    if (EN(0) && IN(0)) phase_pre(F);
    if (DUP_SITE == 0) { xcd_barrier(bar); phase_pre(F); }
    SEAM(0);
    if (EN(1) && IN(1)) phase_modfin(F);
    SEAM(1);
    {
        constexpr int layer = 0;
        const int pb = 2 + 11 * layer;
#define SITE_NORM if (EN(2) && IN(pb)) { if (layer == 0) { route_fold(F); phase_norm<0>(F, 0); } else phase_norm<1>(F, 1); }
        SITE_NORM
#if DUP_SITE == 2
        if (DUP_LAYER == layer) { xcd_barrier(bar); SITE_NORM }
#endif
        SEAM(pb);
#define SITE_GIN if (EN(3) && IN(pb + 1)) { \
            const int N = layer ? ODC : EVN; \
            pg8::Gemm g{H, (const bf16*)(ws + (layer ? WS_WIN1 : WS_WIN0)), NROW, N, DM}; pg8::StaticOrder S; S.init(NROW, N, F.G, F.bx); \
            pg8::EpiStore E{Zb, layer ? ODC : ZC0, 0x7fffffff, layer ? 18 : 24, (float*)(ws + WS_LR)}; \
            pg8::gemm_phase<pg8::EpiStore, pg8::StaticOrder, true, true>(F.lds, g, S, E); \
              \
            if (layer == 0 && TAILCONV && F.G == 256 && F.bx >= 114) conv_unit<8>(F, 0, F.bx - 114); }
        SITE_GIN
#if DUP_SITE == 3
        if (DUP_LAYER == layer) { xcd_barrier(bar); SITE_GIN }
#endif
        SEAM(pb + 1);
#define SITE_PREMIX(REP_) if (EN(4) && IN(pb + 2)) { if (layer == 0) { phase_ht(F); __syncthreads(); \
                if ((REP_) == 0) { PreRegs PR; __syncthreads(); prepass_load<true>(F, F.bx, threadIdx.x, PR); for (int pu = F.bx; pu < 2112; pu += F.G) prepass_unit<true>(F, pu, pu + F.G, PR); __syncthreads(); }     \
                  \
                pg8::Gemm g{(const bf16*)(ws + WS_W3S), (const bf16*)(ws + WS_HDS), 4096, 8192, 256}; pg8::StaticOrder S; S.init(4096, 8192, F.G, F.bx); \
                pg8::EpiFilt E{ws}; \
                pg8::gemm_phase<pg8::EpiFilt, pg8::StaticOrder, true, true>(F.lds, g, S, E); } \
            else phase_prep(F, REP_); }
        SITE_PREMIX(0)
#if DUP_SITE == 4
        if (DUP_LAYER == layer) { xcd_barrier(bar); SITE_PREMIX(1) }
#endif
        SEAM(pb + 2);
#define SITE_PREPASS if (EN(13) && IN(pb + 3)) { \
            if (layer != 0) { PreRegs PR; __syncthreads(); prepass_load<false>(F, F.bx, threadIdx.x, PR); for (int pu = F.bx; pu < 2112; pu += F.G) prepass_unit<false>(F, pu, pu + F.G, PR); __syncthreads(); } }
        SITE_PREPASS
#if DUP_SITE == 13
        if (DUP_LAYER == layer) { xcd_barrier(bar); SITE_PREPASS }
#endif
        if (layer != 0) SEAM(pb + 3);
#define SITE_MIXER(REP_, MEN_, HYV_) if (EN(5) && IN(pb + 4)) { \
            unsigned* qhead = (unsigned*)(ws + WS_CTL) + (layer == 0 ? CW_HYQ : CW_ATQ) + 16 * (REP_); \
            const int nunits = layer == 0 ? 2048 : 512 + 1536; \
            for (int u = F.bx; u < 64; u += F.G) { __syncthreads(); if (layer == 0) { if ((MEN_) & 1) scan_unit<true, ((HYV_) & 8) != 0, ((HYV_) & 16) != 0, ((HYV_) & 32) != 0>(F, u); } else { if ((MEN_) & 2) scan_unit<false, ((HYV_) & 8) != 0, ((HYV_) & 16) != 0, ((HYV_) & 32) != 0>(F, u); } } \
            for (;;) { \
                __syncthreads(); \
                if (threadIdx.x == 0) *(LAS int*)(F.lds + QSLOT_OFF) = (int)__hip_atomic_fetch_add(qhead, 1u, __ATOMIC_RELAXED, __HIP_MEMORY_SCOPE_AGENT); \
                __syncthreads(); \
                const int u = *(LAS int*)(F.lds + QSLOT_OFF); \
                if (u >= nunits) break; \
                if (layer == 0) { if ((MEN_) & 4) { if (u < 1024) hyena_unit<HYV_, 1>(F, u); else hyena_unit<HYV_, 2>(F, u - 1024); } } else if (u < 512) { if ((MEN_) & 8) attn_unit(F, u); } else { if ((MEN_) & 16) conv_unit<2>(F, 1, u - 512); } \
            } \
            __syncthreads(); }
        SITE_MIXER(0, MIX_EN, 0)
#if DUP_SITE == 5
        if (DUP_LAYER == layer) { xcd_barrier(bar); SITE_MIXER(1, DUP_MIX_EN, DUP_HYV) }
#endif
        SEAM(pb + 4);
#define SITE_MERGE if (EN(6) && IN(pb + 5)) { \
            if (layer == 0) { merge_heads(F, F.in[12], ZC0, 0); __syncthreads(); merge_hyena(F); } \
            else merge_heads(F, F.in[23], ODC, NCTX); }
        SITE_MERGE
#if DUP_SITE == 6
        if (DUP_LAYER == layer) { xcd_barrier(bar); SITE_MERGE }
#endif
        SEAM(pb + 5);
#define SITE_GOUT(XP_) if (EN(7) && IN(pb + 6)) { \
            const int row_off = layer ? NCTX : 0, M = NROW - row_off; \
            pg8::Gemm g{MIX + (size_t)row_off * DM, (const bf16*)(ws + (layer ? WS_WOUT1 : WS_WOUT0)), M, DM, DM}; pg8::StaticOrder S; S.init(M, DM, F.G, F.bx); \
            const float* gb = mod + (size_t)layer * 3 * 12288 + 2 * DM; \
            pg8::EpiOut E{XP_, row_off, gb, layer == 0 ? F.in[2] : nullptr, layer == 0 ? F.in[0] : nullptr}; \
            pg8::gemm_phase<pg8::EpiOut, pg8::StaticOrder, true, true>(F.lds, g, S, E); \
              \
            if (layer == 0 && TAILCONV && F.G == 256 && F.bx >= 16) { conv_unit<8>(F, 0, 142 + F.bx - 16); if (F.bx < 18) conv_unit<8>(F, 0, 382 + F.bx - 16); } }
        SITE_GOUT(X)
#if DUP_SITE == 7
        if (DUP_LAYER == layer) { xcd_barrier(bar); SITE_GOUT((float*)(ws + WS_Z)) }
#endif
        SEAM(pb + 6);
        if (EN(8) && IN(pb + 7)) phase_route(F, layer);
#if DUP_SITE == 8
        if (DUP_LAYER == layer) { xcd_barrier(bar); phase_route(F, layer, 1); }
#endif
        SEAM(pb + 7);
#define SITE_GATHER if (EN(9) && IN(pb + 8)) phase_gather(F, layer);
        SITE_GATHER
#if DUP_SITE == 9
        if (DUP_LAYER == layer) { xcd_barrier(bar); SITE_GATHER }
#endif
        SEAM(pb + 8);
#define SITE_MOE1 if (EN(10) && IN(pb + 9)) { \
            moe_offsets(F, layer); \
            pg8::Gemm g{Zb, (const bf16*)(ws + WS_WM13) + (size_t)layer * 16 * 2048 * DM, 0, 0, DM}; \
            pg8::MoeOrder S{F.G, F.bx, __builtin_amdgcn_readfirstlane(toff[16]), toff}; pg8::EpiMoe1 E{ACT}; \
            pg8::gemm_phase<pg8::EpiMoe1, pg8::MoeOrder, true, true>(F.lds, g, S, E); }
        SITE_MOE1
#if DUP_SITE == 10
        if (DUP_LAYER == layer) { xcd_barrier(bar); SITE_MOE1 }
#endif
        SEAM(pb + 9);
#define SITE_MOE2 if (EN(11) && IN(pb + 10)) { \
            moe_offsets(F, layer); \
            pg8::Gemm g{ACT, (const bf16*)(ws + WS_WM2) + (size_t)layer * 16 * 2048 * DFF, 0, 0, DFF}; \
            pg8::MoeOrder S{F.G, F.bx, __builtin_amdgcn_readfirstlane(toff[16]), toff}; pg8::EpiStore E{(bf16*)(ws + WS_W), DM, 7, 8, nullptr}; \
            pg8::gemm_phase<pg8::EpiStore, pg8::MoeOrder, true, true>(F.lds, g, S, E); }
        SITE_MOE2
#if DUP_SITE == 11
        if (DUP_LAYER == layer) { xcd_barrier(bar); SITE_MOE2 }
#endif
        SEAM(pb + 10);
#undef SITE_NORM
#undef SITE_GIN
#undef SITE_PREMIX
#undef SITE_PREPASS
#undef SITE_MIXER
#undef SITE_MERGE
#undef SITE_GATHER
#undef SITE_GOUT
#undef SITE_MOE1
#undef SITE_MOE2
    }
    {
        constexpr int layer = 1;
        const int pb = 2 + 11 * layer;
#define SITE_NORM if (EN(2) && IN(pb)) { if (layer == 0) { route_fold(F); phase_norm<0>(F, 0); } else phase_norm<1>(F, 1); }
        SITE_NORM
#if DUP_SITE == 2
        if (DUP_LAYER == layer) { xcd_barrier(bar); SITE_NORM }
#endif
        SEAM(pb);
#define SITE_GIN if (EN(3) && IN(pb + 1)) { \
            const int N = layer ? ODC : EVN; \
            pg8::Gemm g{H, (const bf16*)(ws + (layer ? WS_WIN1 : WS_WIN0)), NROW, N, DM}; pg8::StaticOrder S; S.init(NROW, N, F.G, F.bx); \
            pg8::EpiStore E{Zb, layer ? ODC : ZC0, 0x7fffffff, layer ? 18 : 24, (float*)(ws + WS_LR)}; \
            pg8::gemm_phase<pg8::EpiStore, pg8::StaticOrder, true, true>(F.lds, g, S, E); \
              \
            if (layer == 0 && TAILCONV && F.G == 256 && F.bx >= 114) conv_unit<8>(F, 0, F.bx - 114); }
        SITE_GIN
#if DUP_SITE == 3
        if (DUP_LAYER == layer) { xcd_barrier(bar); SITE_GIN }
#endif
        SEAM(pb + 1);
#define SITE_PREMIX(REP_) if (EN(4) && IN(pb + 2)) { if (layer == 0) { phase_ht(F); __syncthreads(); \
                if ((REP_) == 0) { PreRegs PR; __syncthreads(); prepass_load<true>(F, F.bx, threadIdx.x, PR); for (int pu = F.bx; pu < 2112; pu += F.G) prepass_unit<true>(F, pu, pu + F.G, PR); __syncthreads(); }     \
                  \
                pg8::Gemm g{(const bf16*)(ws + WS_W3S), (const bf16*)(ws + WS_HDS), 4096, 8192, 256}; pg8::StaticOrder S; S.init(4096, 8192, F.G, F.bx); \
                pg8::EpiFilt E{ws}; \
                pg8::gemm_phase<pg8::EpiFilt, pg8::StaticOrder, true, true>(F.lds, g, S, E); } \
            else phase_prep(F, REP_); }
        SITE_PREMIX(0)
#if DUP_SITE == 4
        if (DUP_LAYER == layer) { xcd_barrier(bar); SITE_PREMIX(1) }
#endif
        SEAM(pb + 2);
#define SITE_PREPASS if (EN(13) && IN(pb + 3)) { \
            if (layer != 0) { PreRegs PR; __syncthreads(); prepass_load<false>(F, F.bx, threadIdx.x, PR); for (int pu = F.bx; pu < 2112; pu += F.G) prepass_unit<false>(F, pu, pu + F.G, PR); __syncthreads(); } }
        SITE_PREPASS
#if DUP_SITE == 13
        if (DUP_LAYER == layer) { xcd_barrier(bar); SITE_PREPASS }
#endif
        if (layer != 0) SEAM(pb + 3);
#define SITE_MIXER(REP_, MEN_, HYV_) if (EN(5) && IN(pb + 4)) { \
            unsigned* qhead = (unsigned*)(ws + WS_CTL) + (layer == 0 ? CW_HYQ : CW_ATQ) + 16 * (REP_); \
            const int nunits = layer == 0 ? 2048 : 512 + 1536; \
            for (int u = F.bx; u < 64; u += F.G) { __syncthreads(); if (layer == 0) { if ((MEN_) & 1) scan_unit<true, ((HYV_) & 8) != 0, ((HYV_) & 16) != 0, ((HYV_) & 32) != 0>(F, u); } else { if ((MEN_) & 2) scan_unit<false, ((HYV_) & 8) != 0, ((HYV_) & 16) != 0, ((HYV_) & 32) != 0>(F, u); } } \
            for (;;) { \
                __syncthreads(); \
                if (threadIdx.x == 0) *(LAS int*)(F.lds + QSLOT_OFF) = (int)__hip_atomic_fetch_add(qhead, 1u, __ATOMIC_RELAXED, __HIP_MEMORY_SCOPE_AGENT); \
                __syncthreads(); \
                const int u = *(LAS int*)(F.lds + QSLOT_OFF); \
                if (u >= nunits) break; \
                if (layer == 0) { if ((MEN_) & 4) { if (u < 1024) hyena_unit<HYV_, 1>(F, u); else hyena_unit<HYV_, 2>(F, u - 1024); } } else if (u < 512) { if ((MEN_) & 8) attn_unit(F, u); } else { if ((MEN_) & 16) conv_unit<2>(F, 1, u - 512); } \
            } \
            __syncthreads(); }
        SITE_MIXER(0, MIX_EN, 0)
#if DUP_SITE == 5
        if (DUP_LAYER == layer) { xcd_barrier(bar); SITE_MIXER(1, DUP_MIX_EN, DUP_HYV) }
#endif
        SEAM(pb + 4);
#define SITE_MERGE if (EN(6) && IN(pb + 5)) { \
            if (layer == 0) { merge_heads(F, F.in[12], ZC0, 0); __syncthreads(); merge_hyena(F); } \
            else merge_heads(F, F.in[23], ODC, NCTX); }
        SITE_MERGE
#if DUP_SITE == 6
        if (DUP_LAYER == layer) { xcd_barrier(bar); SITE_MERGE }
#endif
        SEAM(pb + 5);
#define SITE_GOUT(XP_) if (EN(7) && IN(pb + 6)) { \
            const int row_off = layer ? NCTX : 0, M = NROW - row_off; \
            pg8::Gemm g{MIX + (size_t)row_off * DM, (const bf16*)(ws + (layer ? WS_WOUT1 : WS_WOUT0)), M, DM, DM}; pg8::StaticOrder S; S.init(M, DM, F.G, F.bx); \
            const float* gb = mod + (size_t)layer * 3 * 12288 + 2 * DM; \
            pg8::EpiOut E{XP_, row_off, gb, layer == 0 ? F.in[2] : nullptr, layer == 0 ? F.in[0] : nullptr}; \
            pg8::gemm_phase<pg8::EpiOut, pg8::StaticOrder, true, true>(F.lds, g, S, E); \
              \
            if (layer == 0 && TAILCONV && F.G == 256 && F.bx >= 16) { conv_unit<8>(F, 0, 142 + F.bx - 16); if (F.bx < 18) conv_unit<8>(F, 0, 382 + F.bx - 16); } }
        SITE_GOUT(X)
#if DUP_SITE == 7
        if (DUP_LAYER == layer) { xcd_barrier(bar); SITE_GOUT((float*)(ws + WS_Z)) }
#endif
        SEAM(pb + 6);
        if (EN(8) && IN(pb + 7)) phase_route(F, layer);
#if DUP_SITE == 8
        if (DUP_LAYER == layer) { xcd_barrier(bar); phase_route(F, layer, 1); }
#endif
        SEAM(pb + 7);
#define SITE_GATHER if (EN(9) && IN(pb + 8)) phase_gather(F, layer);
        SITE_GATHER
#if DUP_SITE == 9
        if (DUP_LAYER == layer) { xcd_barrier(bar); SITE_GATHER }
#endif
        SEAM(pb + 8);
#define SITE_MOE1 if (EN(10) && IN(pb + 9)) { \
            moe_offsets(F, layer); \
            pg8::Gemm g{Zb, (const bf16*)(ws + WS_WM13) + (size_t)layer * 16 * 2048 * DM, 0, 0, DM}; \
            pg8::MoeOrder S{F.G, F.bx, __builtin_amdgcn_readfirstlane(toff[16]), toff}; pg8::EpiMoe1 E{ACT}; \
            pg8::gemm_phase<pg8::EpiMoe1, pg8::MoeOrder, true, true>(F.lds, g, S, E); }
        SITE_MOE1
#if DUP_SITE == 10
        if (DUP_LAYER == layer) { xcd_barrier(bar); SITE_MOE1 }
#endif
        SEAM(pb + 9);
#define SITE_MOE2 if (EN(11) && IN(pb + 10)) { \
            moe_offsets(F, layer); \
            pg8::Gemm g{ACT, (const bf16*)(ws + WS_WM2) + (size_t)layer * 16 * 2048 * DFF, 0, 0, DFF}; \
            pg8::MoeOrder S{F.G, F.bx, __builtin_amdgcn_readfirstlane(toff[16]), toff}; pg8::EpiStore E{(bf16*)(ws + WS_W), DM, 7, 8, nullptr}; \
            pg8::gemm_phase<pg8::EpiStore, pg8::MoeOrder, true, true>(F.lds, g, S, E); }
        SITE_MOE2
#if DUP_SITE == 11
        if (DUP_LAYER == layer) { xcd_barrier(bar); SITE_MOE2 }
#endif
        SEAM(pb + 10);
#undef SITE_NORM
#undef SITE_GIN
#undef SITE_PREMIX
#undef SITE_PREPASS
#undef SITE_MIXER
#undef SITE_MERGE
#undef SITE_GATHER
#undef SITE_GOUT
#undef SITE_MOE1
#undef SITE_MOE2
    }
    if (EN(12) && IN(24)) phase_norm<2>(F, 1);
#undef IN
#undef SEAM
}

extern "C" void kernel_launch(void* const* d_in, const int* in_sizes, int n_in, void* d_out, int out_size, void* d_ws, size_t ws_size, hipStream_t stream) {
    static int grid = 0;
    if (grid == 0) {
        if (n_in != 32 || out_size != NLAT * DM || ws_size < WS_END) { fprintf(stderr, "kernel_launch: unexpected shapes (n_in %d, out %d, ws %zu < %zu)\n", n_in, out_size, ws_size, (size_t)WS_END); grid = -1; return; }
        int dev = 0, cus = 0;
        if (hipGetDevice(&dev) != hipSuccess || hipDeviceGetAttribute(&cus, hipDeviceAttributeMultiprocessorCount, dev) != hipSuccess) { grid = -1; return; }
        if (hipFuncSetAttribute((const void*)mk_fwd, hipFuncAttributeMaxDynamicSharedMemorySize, LDS_BYTES) != hipSuccess) { fprintf(stderr, "kernel_launch: hipFuncSetAttribute failed\n"); grid = -1; return; }
        int per_cu = 0;
        if (hipOccupancyMaxActiveBlocksPerMultiprocessor(&per_cu, (const void*)mk_fwd, NTHR, LDS_BYTES) != hipSuccess || per_cu < 1) { fprintf(stderr, "kernel_launch: occupancy query says %d\n", per_cu); }
        (void)hipGetLastError();
        grid = cus;
    }
    if (grid < 0) return;
    if (hipMemsetAsync((char*)d_ws + WS_CTL, 0, CTL_ZERO_BYTES, stream) != hipSuccess) return;
    Args a{};
    for (int i = 0; i < 32; ++i) a.in[i] = (const float*)d_in[i];
    a.out = (float*)d_out; a.ws = (unsigned char*)d_ws;
#if MK_ONE_LAUNCH
    a.ph_lo = 0; a.ph_hi = N_PHASES;
    hipLaunchKernelGGL(mk_fwd, dim3(grid), dim3(NTHR), LDS_BYTES, stream, a);
#else
    for (int p = 0; p < N_PHASES; ++p) { a.ph_lo = p; a.ph_hi = p + 1; hipLaunchKernelGGL(mk_fwd, dim3(grid), dim3(NTHR), LDS_BYTES, stream, a); }
#endif
}
```

```cpp
#include <hip/hip_runtime.h>
#include <cstdio>
#include <cstdint>
#include <cmath>

#ifndef MK_ONE_LAUNCH
#define MK_ONE_LAUNCH 1
#endif
#ifndef SCAN_DPP
#define SCAN_DPP 1
#endif
namespace pg8 {
#define PG8_LAS __attribute__((address_space(3)))
typedef unsigned short bf16_t;
typedef short bf16x8 __attribute__((ext_vector_type(8)));
typedef float f32x4 __attribute__((ext_vector_type(4)));
typedef unsigned u32x4 __attribute__((ext_vector_type(4)));
constexpr int BM = 256, BK = 64, HALF = 128, HTB = HALF * BK * 2  , STAGE_BYTES = 8 * HTB, NXCD = 8, WGM = 8;

__host__ __device__ __forceinline__ int lds_byte(int r, int c) { const int st = (r >> 4) * 2 + (c >> 5), rr = r & 15, cc = c & 31, ob = rr * 64 + cc * 2; return st * 1024 + (ob ^ (((ob >> 9) & 1) << 5)); }
__host__ __device__ __forceinline__ void stage_rc(int b, int& R, int& C) { const int st = b / 1024, sb = b % 1024, swz = sb ^ (((sb >> 9) & 1) << 5); R = (st >> 1) * 16 + swz / 64; C = (st & 1) * 32 + (swz % 64) / 2; }
__host__ __device__ __forceinline__ int perm32(int rho) { const int n = rho >> 4, i = rho & 15; return 8 * (i >> 2) + 4 * n + (i & 3); }

struct Unit { int pm, pn; };
struct Gemm { const bf16_t* A; const bf16_t* Bt; int M, N, K; };

struct StaticOrder {
    int nM, nN, nwg, G, c;
    __host__ __device__ void init(int M, int N, int G_, int c_) { nM = M / BM; nN = N / BM; nwg = nM * nN; G = G_; c = c_; }
    __host__ __device__ bool next(int i, Unit& u) const {
        const long L = (long)i * G + c; if (L >= nwg) return false;
        int wgid = (int)L; { const int q = nwg / NXCD, r = nwg % NXCD, xcd = wgid % NXCD, off = wgid / NXCD; wgid = (xcd < r ? xcd * (q + 1) : r * (q + 1) + (xcd - r) * q) + off; }
        const int nig = WGM * nN, gid = wgid / nig, fm = gid * WGM, gsz = (nM - fm) < WGM ? (nM - fm) : WGM;
        u.pm = fm + ((wgid % nig) % gsz); u.pn = (wgid % nig) / gsz; return true;
    }
    __device__ __forceinline__ void a_ready(const Unit&) const {}
    __device__ __forceinline__ void done(const Unit&) const {}
};

__device__ __forceinline__ unsigned cvt_pk_bf16(float lo, float hi) { unsigned r; asm volatile("v_cvt_pk_bf16_f32 %0, %1, %2" : "=v"(r) : "v"(lo), "v"(hi)); return r; }
typedef float f32x2 __attribute__((ext_vector_type(2)));

template <class Epi, class Sched, bool ALIGN_EPI = false, bool SP2 = false>
__device__ __forceinline__ void gemm_phase(PG8_LAS unsigned char* lds, const Gemm g, const Sched& S, const Epi& E) {
    const int tid = threadIdx.x, wid = __builtin_amdgcn_readfirstlane(tid >> 6), lane = tid & 63, wr = wid >> 2, wc = wid & 3, fr = lane & 15, fq = lane >> 4;
    const int K = g.K, nt = K / BK;
    unsigned voffA[2], voffB[2];
#pragma unroll
    for (int i = 0; i < 2; ++i) { int R, C; stage_rc(tid * 16 + i * 8192, R, C); const int Rb = Epi::PERM ? ((R & ~31) + perm32(R & 31)) : R;
        voffA[i] = (unsigned)(R * K + C) * 2u; voffB[i] = (unsigned)(Rb * K + C) * 2u; }
    const size_t kstep = (size_t)(BK * 2);
    const size_t hstep = (size_t)HALF * K * 2;
    const size_t tstep = 2 * hstep;
    const unsigned ldsw = (unsigned)wid * 1024u;
    const int aoff = lds_byte(wr * 64 + fr, fq * 8), boff = lds_byte(wc * 32 + fr, fq * 8);
#define PG8_SA(b, h) (((b) * 2 + (h)) * HTB)
#define PG8_SB(b, h) ((4 + (b) * 2 + (h)) * HTB)
#define PG8_STAGE(bufoff, gbase, voff) do { _Pragma("unroll") for (int _i = 0; _i < 2; ++_i) \
        __builtin_amdgcn_global_load_lds((const unsigned*)((const char*)(gbase) + (voff)[_i]), (PG8_LAS unsigned*)(lds + (bufoff) + ldsw + _i * 8192), 16, 0, 0); } while (0)
#define PG8_LDA(dst, b, h) do { _Pragma("unroll") for (int m = 0; m < 4; ++m) _Pragma("unroll") for (int k = 0; k < 2; ++k) dst[m][k] = *(const PG8_LAS bf16x8*)(lds + PG8_SA(b, h) + aoff + m * 2048 + k * 1024); } while (0)
#define PG8_LDB(dst, b, h) do { _Pragma("unroll") for (int n = 0; n < 2; ++n) _Pragma("unroll") for (int k = 0; k < 2; ++k) dst[n][k] = *(const PG8_LAS bf16x8*)(lds + PG8_SB(b, h) + boff + n * 2048 + k * 1024); } while (0)
#define PG8_MMA(ai, bj, At, Bt) do { __builtin_amdgcn_s_setprio(1); _Pragma("unroll") for (int m = 0; m < 4; ++m) _Pragma("unroll") for (int n = 0; n < 2; ++n) _Pragma("unroll") for (int k = 0; k < 2; ++k) \
        acc[ai][bj][m][n] = __builtin_amdgcn_mfma_f32_16x16x32_bf16(Bt[n][k], At[m][k], acc[ai][bj][m][n], 0, 0, 0); __builtin_amdgcn_s_setprio(0); } while (0)
#define PG8_WAIT_V(n) asm volatile("s_waitcnt vmcnt(" #n ")" ::: "memory")
#define PG8_WAIT_L(n) asm volatile("s_waitcnt lgkmcnt(" #n ")" ::: "memory")
#define PG8_BAR __builtin_amdgcn_s_barrier()
#define PG8_SCHED __builtin_amdgcn_sched_barrier(0)
    Unit cur, nxt; int ui = 0;
    if (!S.next(0, cur)) return;
    f32x4 acc[2][2][4][2];
#pragma unroll
    for (int a = 0; a < 2; ++a)
#pragma unroll
        for (int b = 0; b < 2; ++b)
#pragma unroll
            for (int m = 0; m < 4; ++m)
#pragma unroll
                for (int n = 0; n < 2; ++n) acc[a][b][m][n] = (f32x4){0.f, 0.f, 0.f, 0.f};
    bf16x8 At[4][2], B0[2][2], B1[2][2];
    const char* cA = (const char*)g.A + (size_t)cur.pm * tstep; const char* cB = (const char*)g.Bt + (size_t)cur.pn * tstep;
    S.a_ready(cur);
    if constexpr (SP2) {
        PG8_STAGE(PG8_SB(0, 0), cB, voffB); PG8_STAGE(PG8_SB(0, 1), cB + hstep, voffB); PG8_STAGE(PG8_SA(0, 0), cA, voffA); PG8_STAGE(PG8_SA(0, 1), cA + hstep, voffA);
        if (wr == 1) PG8_BAR;
        PG8_WAIT_V(2); PG8_BAR;
        PG8_STAGE(PG8_SB(1, 0), cB + kstep, voffB); PG8_STAGE(PG8_SA(1, 0), cA + kstep, voffA); PG8_STAGE(PG8_SB(1, 1), cB + hstep + kstep, voffB);
        PG8_WAIT_V(6); PG8_BAR;
    } else {
        PG8_STAGE(PG8_SB(0, 0), cB, voffB); PG8_STAGE(PG8_SA(0, 0), cA, voffA); PG8_STAGE(PG8_SB(0, 1), cB + hstep, voffB); PG8_STAGE(PG8_SA(0, 1), cA + hstep, voffA);
        if (wr == 1) PG8_BAR;
        PG8_WAIT_V(4); PG8_BAR;
        PG8_STAGE(PG8_SB(1, 0), cB + kstep, voffB); PG8_STAGE(PG8_SA(1, 0), cA + kstep, voffA); PG8_STAGE(PG8_SB(1, 1), cB + hstep + kstep, voffB);
        PG8_WAIT_V(6); PG8_BAR;
    }
    for (;;) {
        const bool has_next = S.next(ui + 1, nxt);
        const char* nA = has_next ? (const char*)g.A + (size_t)nxt.pm * tstep : cA; const char* nB = has_next ? (const char*)g.Bt + (size_t)nxt.pn * tstep : cB;
        for (int t = 0; t < nt; t += 2) {
            const bool last = (t == nt - 2);
            const char* a1 = cA + (size_t)(t + 1) * kstep;
            const char* a2 = last ? nA : cA + (size_t)(t + 2) * kstep; const char* b2 = last ? nB : cB + (size_t)(t + 2) * kstep;
            const char* a3 = a2 + kstep; const char* b3 = b2 + kstep;
            if (last && has_next) S.a_ready(nxt);
            if constexpr (SP2) {
            PG8_LDB(B0, 0, 0); PG8_LDB(B1, 0, 1); PG8_SCHED; PG8_LDA(At, 0, 0); PG8_STAGE(PG8_SA(1, 1), a1 + hstep, voffA);
            PG8_WAIT_V(8); PG8_WAIT_L(0); PG8_BAR; PG8_MMA(0, 0, At, B0); PG8_MMA(0, 1, At, B1); PG8_BAR; PG8_SCHED;
            PG8_LDA(At, 0, 1); PG8_STAGE(PG8_SB(0, 0), b2, voffB); PG8_STAGE(PG8_SB(0, 1), b2 + hstep, voffB); PG8_STAGE(PG8_SA(0, 0), a2, voffA);
            PG8_WAIT_V(8); PG8_WAIT_L(0); PG8_BAR; PG8_MMA(1, 0, At, B0); PG8_MMA(1, 1, At, B1); PG8_BAR; PG8_SCHED;
            PG8_LDB(B0, 1, 0); PG8_LDB(B1, 1, 1); PG8_SCHED; PG8_LDA(At, 1, 0); PG8_STAGE(PG8_SA(0, 1), a2 + hstep, voffA);
            PG8_WAIT_V(8); PG8_WAIT_L(0); PG8_BAR; PG8_MMA(0, 0, At, B0); PG8_MMA(0, 1, At, B1); PG8_BAR; PG8_SCHED;
            PG8_LDA(At, 1, 1); PG8_STAGE(PG8_SB(1, 0), b3, voffB); PG8_STAGE(PG8_SB(1, 1), b3 + hstep, voffB); PG8_STAGE(PG8_SA(1, 0), a3, voffA);
            PG8_WAIT_V(8); PG8_WAIT_L(0); PG8_BAR; PG8_MMA(1, 0, At, B0); PG8_MMA(1, 1, At, B1); PG8_BAR; PG8_SCHED;
            } else {
            PG8_LDB(B0, 0, 0); PG8_SCHED; PG8_LDA(At, 0, 0); PG8_STAGE(PG8_SA(1, 1), a1 + hstep, voffA);
            PG8_WAIT_L(8); PG8_BAR; PG8_WAIT_L(0); PG8_MMA(0, 0, At, B0); PG8_BAR; PG8_SCHED;
            PG8_LDB(B1, 0, 1); PG8_STAGE(PG8_SB(0, 0), b2, voffB);
            PG8_BAR; PG8_WAIT_L(0); PG8_MMA(0, 1, At, B1); PG8_BAR;
            PG8_LDA(At, 0, 1); PG8_STAGE(PG8_SA(0, 0), a2, voffA);
            PG8_BAR; PG8_WAIT_L(0); PG8_MMA(1, 0, At, B0); PG8_BAR; PG8_SCHED;
            PG8_STAGE(PG8_SB(0, 1), b2 + hstep, voffB);
            PG8_WAIT_V(6); PG8_BAR; PG8_MMA(1, 1, At, B1); PG8_BAR;
            PG8_LDB(B0, 1, 0); PG8_SCHED; PG8_LDA(At, 1, 0); PG8_STAGE(PG8_SA(0, 1), a2 + hstep, voffA);
            PG8_WAIT_L(8); PG8_BAR; PG8_WAIT_L(0); PG8_MMA(0, 0, At, B0); PG8_BAR; PG8_SCHED;
            PG8_LDB(B1, 1, 1); PG8_STAGE(PG8_SB(1, 0), b3, voffB);
            PG8_BAR; PG8_WAIT_L(0); PG8_MMA(0, 1, At, B1); PG8_BAR;
            PG8_LDA(At, 1, 1); PG8_STAGE(PG8_SA(1, 0), a3, voffA);
            PG8_BAR; PG8_WAIT_L(0); PG8_MMA(1, 0, At, B0); PG8_BAR; PG8_SCHED;
            PG8_STAGE(PG8_SB(1, 1), b3 + hstep, voffB);
            PG8_WAIT_V(6); PG8_BAR; PG8_MMA(1, 1, At, B1); PG8_BAR;
            }
        }
        if constexpr (ALIGN_EPI) { if (wr == 0) PG8_BAR; }
        if constexpr (!Epi::AFTER_DRAIN) { E(acc, cur, wr, wc, fr, fq); S.done(cur); }
        if (!has_next) break;
#pragma unroll
        for (int a = 0; a < 2; ++a)
#pragma unroll
            for (int b = 0; b < 2; ++b)
#pragma unroll
                for (int m = 0; m < 4; ++m)
#pragma unroll
                    for (int n = 0; n < 2; ++n) acc[a][b][m][n] = (f32x4){0.f, 0.f, 0.f, 0.f};
        cur = nxt; cA = nA; cB = nB; ++ui;
        if constexpr (ALIGN_EPI) { if (wr == 1) PG8_BAR; }
    }
    PG8_WAIT_V(0);
    if constexpr (!ALIGN_EPI) { if (wr == 0) PG8_BAR; }
    PG8_BAR;
    if constexpr (Epi::AFTER_DRAIN) { E.fused(acc, cur, wr, wc, fr, fq, lds, wid, lane); S.done(cur); }
#undef PG8_SA
#undef PG8_SB
#undef PG8_STAGE
#undef PG8_LDA
#undef PG8_LDB
#undef PG8_MMA
#undef PG8_WAIT_V
#undef PG8_WAIT_L
#undef PG8_BAR
#undef PG8_SCHED
}
}
namespace pg8 {
struct EpiStore {
    static constexpr bool PERM = true, AFTER_DRAIN = false;
    bf16_t* O; int ldo; int pn_mask; int nz; float* LR;
    __device__ __forceinline__ void operator()(const f32x4 (&acc)[2][2][4][2], const Unit& u, int wr, int wc, int fr, int fq) const {
        const int row0 = u.pm * BM + wr * 64 + fr; const int ct = u.pn & pn_mask;
        if (ct < nz) {
            const int col0 = ct * BM + wc * 32 + 8 * fq;
#pragma unroll
            for (int ai = 0; ai < 2; ++ai)
#pragma unroll
                for (int m = 0; m < 4; ++m) { bf16_t* rowp = O + (size_t)(row0 + ai * HALF + m * 16) * ldo + col0;
#pragma unroll
                    for (int bj = 0; bj < 2; ++bj) { const f32x4 v0 = acc[ai][bj][m][0], v1 = acc[ai][bj][m][1];
                        u32x4 w; w.x = cvt_pk_bf16(v0[0], v0[1]); w.y = cvt_pk_bf16(v0[2], v0[3]); w.z = cvt_pk_bf16(v1[0], v1[1]); w.w = cvt_pk_bf16(v1[2], v1[3]);
                        *(u32x4*)(rowp + bj * HALF) = w; } }
        } else if (wc == 0) {
#pragma unroll
            for (int ai = 0; ai < 2; ++ai)
#pragma unroll
                for (int m = 0; m < 4; ++m) { float* rp = LR + (size_t)(row0 + ai * HALF + m * 16) * 32 + 8 * fq;
                    *(f32x4*)rp = acc[ai][0][m][0]; *(f32x4*)(rp + 4) = acc[ai][0][m][1]; }
        }
    }
};
struct EpiOut {
    static constexpr bool PERM = false, AFTER_DRAIN = false;
    float* X; int row_off; const float* gbase;
    const float* in_ctx; const float* in_lat;
    __device__ __forceinline__ void operator()(const f32x4 (&acc)[2][2][4][2], const Unit& u, int wr, int wc, int fr, int fq) const {
        const int rt = row_off + u.pm * BM; const int cls = rt < 512 ? 2 : (rt < 512 + 8192 ? 0 : 1); const float* gate = gbase + cls * 12288;
        const int row0 = rt + wr * 64 + fr, col0 = u.pn * BM + wc * 32 + 4 * fq;
        f32x4 gv[2][2];
#pragma unroll
        for (int bj = 0; bj < 2; ++bj)
#pragma unroll
            for (int n = 0; n < 2; ++n) gv[bj][n] = *(const f32x4*)(gate + col0 + bj * HALF + n * 16);
#pragma unroll
        for (int ai = 0; ai < 2; ++ai)
#pragma unroll
            for (int m = 0; m < 4; ++m) { const int rr = row0 + ai * HALF + m * 16; float* rowp = X + (size_t)rr * 2048 + col0;
                const float* srcp = in_lat ? (rt < 512 ? in_ctx + (size_t)rr * 2048 : in_lat + (size_t)(rr - 512) * 2048) + col0 : rowp;
#pragma unroll
                for (int bj = 0; bj < 2; ++bj)
#pragma unroll
                    for (int n = 0; n < 2; ++n) { const f32x4 o = *(const f32x4*)(srcp + bj * HALF + n * 16) + gv[bj][n] * acc[ai][bj][m][n]; *(f32x4*)(rowp + bj * HALF + n * 16) = o; }
                if (m == 3) asm volatile("" ::: "memory"); }
    }
};
struct EpiMoe1 {
    static constexpr bool PERM = true, AFTER_DRAIN = false;
    bf16_t* ACT;
    __device__ __forceinline__ void operator()(const f32x4 (&acc)[2][2][4][2], const Unit& u, int wr, int wc, int fr, int fq) const {
        const int row0 = u.pm * BM + wr * 64 + fr, col0 = (u.pn & 7) * HALF + wc * 32 + 8 * fq;
#pragma unroll
        for (int ai = 0; ai < 2; ++ai)
#pragma unroll
            for (int m = 0; m < 4; ++m) { float a[8];
#pragma unroll
                for (int n = 0; n < 2; ++n)
#pragma unroll
                    for (int j = 0; j < 4; ++j) { const float g = acc[ai][0][m][n][j], uu = acc[ai][1][m][n][j]; a[n * 4 + j] = g * __builtin_amdgcn_rcpf(1.0f + __expf(-g)) * uu; }
                u32x4 w; w.x = cvt_pk_bf16(a[0], a[1]); w.y = cvt_pk_bf16(a[2], a[3]); w.z = cvt_pk_bf16(a[4], a[5]); w.w = cvt_pk_bf16(a[6], a[7]);
                *(u32x4*)(ACT + (size_t)(row0 + ai * HALF + m * 16) * 1024 + col0) = w; }
    }
};
struct MoeOrder {
    int G, c, ntiles; const PG8_LAS int* toff;
    __device__ __forceinline__ bool next(int i, Unit& u) const {
        int pm, j;
        if (G == 256) { const int x = c & 7, q = c >> 3; pm = (i * 8 + (q >> 2)) * 4 + (x >> 1); j = (x & 1) * 4 + (q & 3); if (pm >= ntiles) return false; }
        else { const int L = i * G + c; if (L >= ntiles * 8) return false; pm = L >> 3; j = L & 7; }
        int e = 0;
#pragma unroll
        for (int k = 1; k < 16; ++k) e += (pm >= toff[k]) ? 1 : 0;
        u.pm = pm; u.pn = __builtin_amdgcn_readfirstlane(e * 8 + j); return true;
    }
    __device__ __forceinline__ void a_ready(const Unit&) const {}
    __device__ __forceinline__ void done(const Unit&) const {}
};
}
#define GAS __attribute__((address_space(1)))
#define LAS __attribute__((address_space(3)))
typedef unsigned short bf16;
typedef unsigned v4u __attribute__((ext_vector_type(4)));
typedef float f32x4 __attribute__((ext_vector_type(4)));
typedef short bf16x8 __attribute__((ext_vector_type(8)));
typedef GAS unsigned gu32;
typedef GAS unsigned long long gu64;
#define RLX_AGENT __ATOMIC_RELAXED, __HIP_MEMORY_SCOPE_AGENT
#define LDS_WAIT() asm volatile("s_waitcnt lgkmcnt(0)" ::: "memory")
#define VM_WAIT() asm volatile("s_waitcnt vmcnt(0)" ::: "memory")
__device__ __forceinline__ unsigned long long rt() { return __builtin_amdgcn_s_memrealtime(); }
__device__ __forceinline__ unsigned f2bf(float f) { unsigned u = __builtin_bit_cast(unsigned, f); return (u + 0x7fffu + ((u >> 16) & 1u)) >> 16; }
__device__ __forceinline__ unsigned pk2(float lo, float hi) { return f2bf(lo) | (f2bf(hi) << 16); }
#define XB_TMO      128
#define XB_XCNT(j)  (256  + 64 * (j))
#define XB_XSUB(j)  (1280 + 64 * (j))
#define XB_XGEN(j)  (2304 + 64 * (j))
#define XB_TOP      3328
#define XB_TOPGEN   3392
#define XCD_BAR_WORDS 3456
#define XB_SPIN_CAP (1u << 18)

__device__ __forceinline__ unsigned xb_ld(unsigned* p)              { return __hip_atomic_load(p, __ATOMIC_RELAXED, __HIP_MEMORY_SCOPE_AGENT); }
__device__ __forceinline__ unsigned xb_add(unsigned* p, unsigned v) { return __hip_atomic_fetch_add(p, v, __ATOMIC_RELAXED, __HIP_MEMORY_SCOPE_AGENT); }
__device__ __forceinline__ unsigned xb_xcc_id() { return (unsigned)__builtin_amdgcn_s_getreg((3 << 11) | 20) & 0xFu; }
#define XB_SPIN(cond, bar) do { unsigned _sp = 0; while (cond) { __builtin_amdgcn_s_sleep(1); \
    if ((++_sp & 255u) == 0u) { if (xb_ld(&(bar)[XB_TMO])) break; if (_sp > XB_SPIN_CAP) { atomicAdd(&(bar)[XB_TMO], 1u); break; } } } } while (0)

struct XcdBarrier {
    unsigned* bar; unsigned x;
    volatile LAS unsigned* st;
};

__device__ __forceinline__ XcdBarrier xcd_barrier_post(unsigned* bar, volatile LAS unsigned* st) {
    XcdBarrier b; b.bar = bar; b.x = xb_xcc_id(); b.st = st;
    if (threadIdx.x == 0) (void)xb_add(&bar[XB_XCNT(b.x)], 1u);
    return b;
}
__device__ __forceinline__ void xcd_barrier_complete(unsigned* bar, unsigned x, unsigned& nloc, unsigned& nx) {
    const unsigned G = gridDim.x * gridDim.y * gridDim.z;
    unsigned sum, cnt, mine, sp = 0u;
    for (;;) {
        sum = 0u; cnt = 0u; mine = 0u;
#pragma unroll
        for (unsigned j = 0; j < 16; ++j) { const unsigned c = xb_ld(&bar[XB_XCNT(j)]); sum += c; cnt += (c > 0u) ? 1u : 0u; mine = (j == x) ? c : mine; }
        if (sum == G) break;
        __builtin_amdgcn_s_sleep(1);
        if ((++sp & 255u) == 0u) { if (xb_ld(&bar[XB_TMO])) break; if (sp > XB_SPIN_CAP) { atomicAdd(&bar[XB_TMO], 1u); break; } }
    }
    nloc = mine > 0u ? mine : 1u; nx = cnt > 0u ? cnt : 1u;
}

__device__ __forceinline__ void xcd_barrier(const XcdBarrier& b) {
    asm volatile("s_waitcnt vmcnt(0)" ::: "memory");
    __syncthreads();
    if (threadIdx.x == 0) {
        unsigned* bar = b.bar;
        __builtin_amdgcn_s_waitcnt(0);
        unsigned nloc = b.st[0], nx = b.st[1];
        if (nloc == 0u) { xcd_barrier_complete(bar, b.x, nloc, nx); b.st[0] = nloc; b.st[1] = nx; }
        const unsigned old = xb_add(&bar[XB_XSUB(b.x)], 1u);
        const unsigned gen = old / nloc;
        if (old + 1u == (gen + 1u) * nloc) {
            __builtin_amdgcn_fence(__ATOMIC_RELEASE, "agent");
            asm volatile("s_waitcnt vmcnt(0)" ::: "memory");
            const unsigned og = xb_add(&bar[XB_TOP], 1u);
            const unsigned tg = og / nx;
            if (og + 1u == (tg + 1u) * nx) xb_add(&bar[XB_TOPGEN], 1u);
            else XB_SPIN(xb_ld(&bar[XB_TOPGEN]) == tg, bar);
            __builtin_amdgcn_fence(__ATOMIC_ACQUIRE, "agent");
            xb_add(&bar[XB_XGEN(b.x)], 1u);
            asm volatile("s_waitcnt vmcnt(0)" ::: "memory");
        } else {
            XB_SPIN(xb_ld(&bar[XB_XGEN(b.x)]) == gen, bar);
            __builtin_amdgcn_fence(__ATOMIC_ACQUIRE, "agent");
            asm volatile("s_waitcnt vmcnt(0)" ::: "memory");
        }
    }
    __syncthreads();
}
constexpr int NWAVES = 8, NTHR = 512;
constexpr int DM = 2048, NBATCH = 2, SEQ = 8192, CTXL = 256;
constexpr int NCTX = NBATCH * CTXL;
constexpr int NLAT = NBATCH * SEQ;
constexpr int NROW = NCTX + NLAT;
constexpr int EVC = 6176, EVN = 6400, ZC0 = 6144;
constexpr int ODC = 4608;
constexpr int NEXP = 16, DFF = 1024;
constexpr int MP_MAX = 37888;
constexpr float EPSN = 1e-6f;
constexpr int FFTN = 16384;

constexpr size_t MiB = 1u << 20;
constexpr size_t WS_CTL = 0, CTL_ZERO_BYTES = 1 * MiB;
constexpr size_t WS_MODP = 1 * MiB;
constexpr size_t WS_MOD = 11 * MiB;
constexpr size_t WS_HDNL = 12 * MiB;
constexpr size_t WS_HDNC = 14 * MiB;
constexpr size_t WS_ROUTE = 15 * MiB;
constexpr size_t WS_LR = 16 * MiB;
constexpr size_t WS_WIN0 = 19 * MiB;
constexpr size_t WS_WOUT0 = 44 * MiB;
constexpr size_t WS_WIN1 = 52 * MiB;
constexpr size_t WS_WOUT1 = 70 * MiB;
constexpr size_t WS_WM13 = 78 * MiB;
constexpr size_t WS_WM2 = 334 * MiB;
constexpr size_t WS_X = 462 * MiB;
constexpr size_t WS_H = 594 * MiB;
constexpr size_t WS_Z = 660 * MiB;
constexpr size_t WS_W = 858 * MiB;
constexpr size_t WS_OF = WS_W, WS_OB = WS_W + 33 * MiB, WS_MIX = WS_W + 66 * MiB;
constexpr size_t WS_ACT = 1006 * MiB;
constexpr size_t WS_W3S = 1088 * MiB;
constexpr size_t WS_HDS = 1090 * MiB;
constexpr size_t WS_QKD = 1094 * MiB;
constexpr size_t WS_END = 1178 * MiB;
constexpr size_t WS_FILT0 = WS_MIX, WS_FILT1 = WS_MIX + 32 * MiB, WS_FILT2 = WS_H + 34 * MiB, WS_FILT3 = WS_ACT + 50 * MiB;
constexpr size_t HYS_BYTES = 196608 + 256;
static_assert(WS_QKD + (size_t)2112 * 41472 <= WS_END, "ws map 4");
static_assert(WS_MODP + (size_t)2 * 32 * 3 * 12288 * 4 <= WS_MOD && WS_LR + (size_t)NROW * 32 * 4 <= WS_WIN0 && WS_WIN0 + (size_t)EVN * DM * 2 <= WS_WOUT0 && WS_WIN1 + (size_t)ODC * DM * 2 <= WS_WOUT1, "ws map 1");
static_assert(WS_X + (size_t)NROW * DM * 4 <= WS_H && WS_H + (size_t)NROW * DM * 2 <= WS_Z && WS_Z + (size_t)NROW * ZC0 * 2 <= WS_W && WS_Z + (size_t)MP_MAX * DM * 2 <= WS_W, "ws map 2");
static_assert(WS_W + (size_t)MP_MAX * DM * 2 <= WS_ACT && WS_MIX + (size_t)NROW * DM * 2 <= WS_ACT && WS_ACT + (size_t)MP_MAX * DFF * 2 <= WS_END && WS_ACT + 256 * HYS_BYTES <= WS_FILT3 && WS_FILT3 + 32 * MiB <= WS_W3S && WS_FILT2 + 32 * MiB <= WS_Z && WS_H + (size_t)1024 * NROW * 2 <= WS_FILT2, "ws map 3");
constexpr int CW_CNT = 8192;
constexpr int CW_HYQ = 256;
constexpr int CW_ATQ = 320;
constexpr int CW_BAR = 4096;

constexpr int RING_BYTES = 139264;
constexpr int LDSCTL_OFF = RING_BYTES;
constexpr int MISC_OFF = LDSCTL_OFF + 320;
constexpr int LDS_BYTES = 147456;
namespace pg8 {
struct EpiFilt {
    static constexpr bool PERM = false, AFTER_DRAIN = false;
    unsigned char* base;
    __device__ __forceinline__ void operator()(const f32x4 (&acc)[2][2][4][2], const Unit& u, int wr, int wc, int fr, int fq) const {
        const int q = u.pm >> 2; size_t off = WS_FILT0; if (q == 1) off = WS_FILT1; if (q == 2) off = WS_FILT2; if (q == 3) off = WS_FILT3;
        float* C = (float*)(base + off);
        const int row0 = (u.pm & 3) * BM + wr * 64 + fr, col0 = u.pn * BM + wc * 32 + 4 * fq;
#pragma unroll
        for (int ai = 0; ai < 2; ++ai)
#pragma unroll
            for (int m = 0; m < 4; ++m) { float* rowp = C + (size_t)(row0 + ai * HALF + m * 16) * 8192 + col0;
#pragma unroll
                for (int bj = 0; bj < 2; ++bj)
#pragma unroll
                    for (int n = 0; n < 2; ++n) *(f32x4*)(rowp + bj * HALF + n * 16) = acc[ai][bj][m][n]; }
    }
};
}
constexpr int TOFF_OFF = LDSCTL_OFF + 512;
typedef float f32x2v __attribute__((ext_vector_type(2)));
typedef unsigned v2u __attribute__((ext_vector_type(2)));
typedef short bf16x4 __attribute__((ext_vector_type(4)));

struct Args { const float* in[32]; float* out; unsigned char* ws; int ph_lo, ph_hi; };

struct Frame {
    LAS unsigned char* lds;
    int G, bx, NGW;
    const float* const __attribute__((address_space(4)))* in;
    float* out; unsigned char* ws;
};

__device__ __forceinline__ float bf2f(unsigned h) { return __uint_as_float(h << 16); }
__device__ __forceinline__ float bflo(unsigned w) { return __uint_as_float(w << 16); }
__device__ __forceinline__ float bfhi(unsigned w) { return __uint_as_float(w & 0xffff0000u); }
__device__ __forceinline__ float wave_sum(float v) {
#pragma unroll
    for (int o = 1; o < 64; o <<= 1) v += __shfl_xor(v, o);
    return v;
}
__device__ __forceinline__ float wave_max(float v) {
#pragma unroll
    for (int o = 1; o < 64; o <<= 1) v = fmaxf(v, __shfl_xor(v, o));
    return v;
}
__device__ __forceinline__ float silu_f(float x) { return x / (1.0f + __expf(-x)); }
__device__ __forceinline__ f32x4 mfma_bf16(bf16x8 a, bf16x8 b, f32x4 c) { return __builtin_amdgcn_mfma_f32_16x16x32_bf16(a, b, c, 0, 0, 0); }
__device__ __forceinline__ int row_cls(int row) { return row < NCTX ? 2 : ((row - NCTX) >> 13); }
#define PHASE_LOCALS int tid = threadIdx.x; asm volatile("" : "+v"(tid)); const int lane = tid & 63, wave = __builtin_amdgcn_readfirstlane(tid >> 6), gw = F.bx * NWAVES + wave; (void)lane; (void)wave; (void)gw;
template <int N> __device__ __forceinline__ float row_shr(float v) { return __builtin_bit_cast(float, __builtin_amdgcn_update_dpp(0, __builtin_bit_cast(int, v), 0x110 + N, 0xF, 0xF, true)); }
template <int N> __device__ __forceinline__ float row_ror(float v) { return __builtin_bit_cast(float, __builtin_amdgcn_update_dpp(0, __builtin_bit_cast(int, v), 0x120 + N, 0xF, 0xF, false)); }
typedef __bf16 bf16x2n __attribute__((ext_vector_type(2)));
__device__ __forceinline__ unsigned cvt_pk(float lo, float hi) { const f32x2v v = {lo, hi}; return __builtin_bit_cast(unsigned, __builtin_convertvector(v, bf16x2n)); }
#define LDS_BARRIER() do { asm volatile("s_waitcnt lgkmcnt(0)" ::: "memory"); __builtin_amdgcn_s_barrier(); asm volatile("" ::: "memory"); } while (0)
__device__ __forceinline__ void tr_item(const float* W, int N, int ncols, bf16* WT, int K, int k0, int n0, int drow0, int drow1, LAS float* scr, int lane) {
    const int cc = 4 * (lane & 15);
    f32x4 v[16];
#pragma unroll
    for (int i = 0; i < 16; ++i) {
        const int r = 4 * i + (lane >> 4);
        v[i] = (f32x4){0.f, 0.f, 0.f, 0.f};
        if (cc < ncols) v[i] = *(const f32x4*)(W + (size_t)(k0 + r) * N + n0 + cc);
    }
#pragma unroll
    for (int i = 0; i < 16; ++i) { const int r = 4 * i + (lane >> 4); LAS float* s = scr + r * 65 + cc; s[0] = v[i][0]; s[1] = v[i][1]; s[2] = v[i][2]; s[3] = v[i][3]; }
    LDS_WAIT();
    const int c = lane & 7;
#pragma unroll
    for (int j = 0; j < 8; ++j) {
        const int n = (lane >> 3) + 8 * j;
        if (n < ncols) {
            const LAS float* s = scr + (8 * c) * 65 + n;
            v4u o; o.x = cvt_pk(s[0], s[65]); o.y = cvt_pk(s[2 * 65], s[3 * 65]); o.z = cvt_pk(s[4 * 65], s[5 * 65]); o.w = cvt_pk(s[6 * 65], s[7 * 65]);
            const int drow = n < 32 ? drow0 + n : drow1 + (n - 32);
            *(v4u*)(WT + (size_t)drow * K + k0 + 8 * c) = o;
        }
    }
    LDS_WAIT();
}
__device__ __forceinline__ int map_evin(int c0) { return c0 < 3072 ? c0 : (c0 < 3104 ? 6144 + (c0 - 3072) : c0 - 32); }

__device__ __forceinline__ void tr_moe_item(Frame& F, int layer, int r, LAS float* scr, int lane) {
    bf16* wm13 = (bf16*)(F.ws + WS_WM13) + (size_t)layer * 16 * 2048 * DM; bf16* wm2 = (bf16*)(F.ws + WS_WM2) + (size_t)layer * 16 * 2048 * DFF;
    if (r < 16384) {
        const int which = r >= 8192 ? 1 : 0; if (which) r -= 8192;
        const int e = r / 512, q = r % 512, kb = q / 16, nb = q % 16, n0 = nb * 64, le = layer * 16 + e;
        const float* W = (which ? F.in[30] : F.in[29]) + (size_t)le * DM * DFF;
        const int d0 = e * 2048 + (n0 >> 7) * 256 + which * 128 + (n0 & 127);
        tr_item(W, DFF, 64, wm13, DM, kb * 64, n0, d0, d0 + 32, scr, lane);
    } else {
        r -= 16384;
        const int e = r / 512, q = r % 512, kb = q / 32, nb = q % 32, n0 = nb * 64, le = layer * 16 + e;
        const float* W = F.in[31] + (size_t)le * DFF * DM;
        tr_item(W, DM, 64, wm2, DFF, kb * 64, n0, e * 2048 + n0, e * 2048 + n0 + 32, scr, lane);
    }
}
struct TrDesc { const float* src; bf16* dst; int N, K; };
__device__ __forceinline__ TrDesc moe_desc(Frame& F, int layer, int r) {
    TrDesc d;
    if (r < 16384) {
        const int which = r >= 8192 ? 1 : 0; if (which) r -= 8192;
        const int e = r / 512, q = r % 512, kb = q % 32, nb = q / 32, n0 = nb * 64, le = layer * 16 + e;
        const float* W = (which ? F.in[30] : F.in[29]) + (size_t)le * DM * DFF;
        const int d0 = e * 2048 + (n0 >> 7) * 256 + which * 128 + (n0 & 127);
        d.src = W + (size_t)(kb * 64) * DFF + n0; d.N = DFF; d.K = DM;
        d.dst = (bf16*)(F.ws + WS_WM13) + (size_t)layer * 16 * 2048 * DM + (size_t)d0 * DM + kb * 64;
    } else {
        r -= 16384;
        const int e = r / 512, q = r % 512, kb = q % 16, nb = q / 16, n0 = nb * 64, le = layer * 16 + e;
        const float* W = F.in[31] + (size_t)le * DFF * DM;
        d.src = W + (size_t)(kb * 64) * DM + n0; d.N = DM; d.K = DFF;
        d.dst = (bf16*)(F.ws + WS_WM2) + (size_t)layer * 16 * 2048 * DFF + (size_t)(e * 2048 + n0) * DFF + kb * 64;
    }
    return d;
}
__device__ __forceinline__ void tr_load(const TrDesc& d, int lane, f32x4 (&v)[16]) {
#pragma unroll
    for (int i = 0; i < 16; ++i) v[i] = *(const f32x4*)(d.src + (size_t)(4 * i + (lane >> 4)) * d.N + 4 * (lane & 15));
}
__device__ __forceinline__ void tr_commit(const TrDesc& d, const f32x4 (&v)[16], LAS float* scr, int lane) {
    const int cc = 4 * (lane & 15);
#pragma unroll
    for (int i = 0; i < 16; ++i) { const int r = 4 * i + (lane >> 4); LAS float* s = scr + r * 65 + cc; s[0] = v[i][0]; s[1] = v[i][1]; s[2] = v[i][2]; s[3] = v[i][3]; }
    LDS_WAIT();
    const int c = lane & 7;
#pragma unroll
    for (int j = 0; j < 8; ++j) {
        const int n = (lane >> 3) + 8 * j;
        const LAS float* s = scr + (8 * c) * 65 + n;
        v4u o; o.x = cvt_pk(s[0], s[65]); o.y = cvt_pk(s[2 * 65], s[3 * 65]); o.z = cvt_pk(s[4 * 65], s[5 * 65]); o.w = cvt_pk(s[6 * 65], s[7 * 65]);
        *(v4u*)(d.dst + (size_t)n * d.K + 8 * c) = o;
    }
    LDS_WAIT();
}
template <int NI>
__device__ __forceinline__ void conv_unit(Frame& F, int layer, int cu) {
    PHASE_LOCALS
    LAS float* scr = (LAS float*)(F.lds) + wave * (64 * 65);
    __syncthreads();
    const int r0 = cu * (8 * NI) + wave * NI;
    f32x4 va[16], vb[16];
    TrDesc da = moe_desc(F, layer, r0), db = da;
    tr_load(da, lane, va);
#pragma unroll
    for (int i = 0; i < NI; i += 2) {
        db = moe_desc(F, layer, r0 + i + 1); tr_load(db, lane, vb);
        tr_commit(da, va, scr, lane);
        if (i + 2 < NI) { da = moe_desc(F, layer, r0 + i + 2); tr_load(da, lane, va); }
        tr_commit(db, vb, scr, lane);
    }
    __syncthreads();
}

__device__ __forceinline__ void phase_pre(Frame& F) {
    PHASE_LOCALS
    {
        LAS float* sv = (LAS float*)F.lds;
        const float* cvec = F.in[1]; const float* cctx = F.in[3]; const float* adaw = F.in[4];
        float* modp = (float*)(F.ws + WS_ACT);
        for (int u = F.bx; u < 768; u += F.G) {
            const int layer = u / 384, r = u % 384, kc = r / 6, cb = r % 6, k0 = kc * 32;
            __syncthreads();
            if (tid < 96) { const int v = tid >> 5, k = tid & 31; const float c = v < 2 ? cvec[v * DM + k0 + k] : cctx[k0 + k]; sv[tid] = silu_f(c); }
            __syncthreads();
            const int col0 = cb * 2048 + tid * 4;
            const float* wp = adaw + ((size_t)layer * DM + k0) * 12288 + col0;
            f32x4 a0 = {0.f, 0.f, 0.f, 0.f}, a1 = a0, a2 = a0;
#pragma unroll 8
            for (int k = 0; k < 32; ++k) { const f32x4 w = *(const f32x4*)(wp + (size_t)k * 12288); a0 += w * sv[k]; a1 += w * sv[32 + k]; a2 += w * sv[64 + k]; }
            float* op = modp + ((size_t)(layer * 64 + kc) * 3) * 12288 + col0;
            *(f32x4*)op = a0; *(f32x4*)(op + 12288) = a1; *(f32x4*)(op + 2 * 12288) = a2;
        }
        __syncthreads();
    }
    {
        const float* w1 = F.in[15]; const float* b1 = F.in[16]; const float* w2 = F.in[17]; const float* b2 = F.in[18];
        float* hdn = (float*)(F.ws + WS_HDNL);
        for (int rr = gw; rr < 8192 + 256; rr += F.NGW) {
            const int L = rr < 8192 ? 8192 : 256, l = rr < 8192 ? rr : rr - 8192;
            const float t = (float)l / (float)(L - 1);
            const float w = (float)(2.0 * 3.14159265358979323846 / (double)L) * (float)l;
            float h1 = b1[lane] + t * w1[lane];
            const float band = 1e-4f + (float)(lane & 15) * ((15.0f - 1e-4f) / 15.0f);
            float sn, cs; sincosf(band * w, &sn, &cs);
#pragma unroll
            for (int i = 0; i < 16; ++i) h1 += __shfl(cs, i) * w1[(1 + i) * 64 + lane] - __shfl(sn, i) * w1[(17 + i) * 64 + lane];
            h1 = sinf(h1);
            float h2 = b2[lane];
#pragma unroll 8
            for (int i = 0; i < 64; ++i) h2 += __shfl(h1, i) * w2[i * 64 + lane];
            const float hv = sinf(h2);
            hdn[(size_t)rr * 64 + lane] = hv;
            if (rr < 8192) {
                bf16* hs = (bf16*)(F.ws + WS_HDS) + (size_t)rr * 256;
                const unsigned hi = f2bf(hv), lo = f2bf(hv - bf2f(hi));
                hs[lane] = (bf16)hi; hs[64 + lane] = (bf16)lo; hs[128 + lane] = (bf16)hi; hs[192 + lane] = (bf16)0;
            }
        }
        const float* w3 = F.in[19]; bf16* w3s = (bf16*)(F.ws + WS_W3S);
        for (int r = gw; r < 4096; r += F.NGW) {
            const float wv = w3[(size_t)lane * 4096 + r];
            const unsigned hi = f2bf(wv), lo = f2bf(wv - bf2f(hi));
            bf16* o = w3s + (size_t)r * 256;
            o[lane] = (bf16)hi; o[64 + lane] = (bf16)hi; o[128 + lane] = (bf16)lo; o[192 + lane] = (bf16)0;
        }
    }
    {
        LAS float* scr = (LAS float*)(F.lds) + wave * (64 * 65);
        bf16* win0 = (bf16*)(F.ws + WS_WIN0); bf16* wout0 = (bf16*)(F.ws + WS_WOUT0); bf16* win1 = (bf16*)(F.ws + WS_WIN1); bf16* wout1 = (bf16*)(F.ws + WS_WOUT1);
        constexpr int I0 = 32 * 97, I1 = 32 * 32, I2 = 32 * 72, I3 = 32 * 32;
        constexpr int NITEMS = I0 + I1 + I2 + I3;
        for (int it = gw; it < NITEMS; it += F.NGW) {
            int r = it;
            if (r < I0) { const int kb = r / 97, nb = r % 97, n0 = nb * 64; tr_item(F.in[8], EVC, nb == 96 ? 32 : 64, win0, DM, kb * 64, n0, map_evin(n0), map_evin(n0 + 32), scr, lane); continue; } r -= I0;
            if (r < I1) { const int kb = r / 32, nb = r % 32, n0 = nb * 64; tr_item(F.in[9], DM, 64, wout0, DM, kb * 64, n0, n0, n0 + 32, scr, lane); continue; } r -= I1;
            if (r < I2) { const int kb = r / 72, nb = r % 72, n0 = nb * 64; tr_item(F.in[21], ODC, 64, win1, DM, kb * 64, n0, n0, n0 + 32, scr, lane); continue; } r -= I2;
            { const int kb = r / 32, nb = r % 32, n0 = nb * 64; tr_item(F.in[22], DM, 64, wout1, DM, kb * 64, n0, n0, n0 + 32, scr, lane); }
        }
        if (F.G != 256) for (int it = gw; it < 24576; it += F.NGW) tr_moe_item(F, 0, it, scr, lane);
    }
}
__device__ __forceinline__ void phase_modfin(Frame& F) {
    PHASE_LOCALS
    const float* adab = F.in[5]; const float* modp = (const float*)(F.ws + WS_ACT); float* mod = (float*)(F.ws + WS_MOD);
    for (int idx = F.bx * NTHR + tid; idx < 2 * 3 * 12288; idx += F.G * NTHR) {
        const int layer = idx / 36864, rem = idx % 36864, v = rem / 12288, col = rem % 12288;
        float s = adab[layer * 12288 + col];
        for (int kc = 0; kc < 64; ++kc) s += modp[((size_t)(layer * 64 + kc) * 3 + v) * 12288 + col];
        mod[idx] = s;
    }
}
template <int MODE>
__device__ __forceinline__ void phase_norm(Frame& F, int layer) {
    PHASE_LOCALS
    float* X = (float*)(F.ws + WS_X); bf16* H = (bf16*)(F.ws + WS_H);
    const float* mod = (const float*)(F.ws + WS_MOD); const bf16* yperm = (const bf16*)(F.ws + WS_W);
    const unsigned* route = (const unsigned*)(F.ws + WS_ROUTE);
    const float* gain = F.in[6] + layer * DM;
    const int r_begin = MODE == 2 ? NCTX : 0;
    v4u rt_next = {0u, 0u, 0u, 0u};
    if (MODE != 0 && r_begin + gw < NROW) rt_next = *(const v4u*)(route + (size_t)(r_begin + gw) * 8 + 4);
    for (int row = r_begin + gw; row < NROW; row += F.NGW) {
        const int cls = row_cls(row);
        const v4u rt = rt_next;
        if (MODE != 0 && row + F.NGW < NROW) rt_next = *(const v4u*)(route + (size_t)(row + F.NGW) * 8 + 4);
        f32x4 v[8];
        if (MODE == 0) {
            const float* src = row < NCTX ? F.in[2] + (size_t)row * DM : F.in[0] + (size_t)(row - NCTX) * DM;
#pragma unroll
            for (int j = 0; j < 8; ++j) v[j] = *(const f32x4*)(src + 256 * j + 4 * lane);
        } else {
            const float* src = X + (size_t)row * DM;
            const float w0 = __uint_as_float(rt.x), w1 = __uint_as_float(rt.y);
            const bf16* y0 = yperm + (size_t)rt.z * DM; const bf16* y1 = yperm + (size_t)rt.w * DM;
            const float* g2 = mod + (size_t)((layer - (MODE == 1 ? 1 : 0)) * 3 + cls) * 12288 + 5 * DM;
#pragma unroll
            for (int j = 0; j < 8; ++j) {
                const int e = 256 * j + 4 * lane;
                const f32x4 x = *(const f32x4*)(src + e), g = *(const f32x4*)(g2 + e);
                const v2u a = *(const v2u*)(y0 + e), b = *(const v2u*)(y1 + e);
                f32x4 y; y[0] = w0 * bflo(a.x) + w1 * bflo(b.x); y[1] = w0 * bfhi(a.x) + w1 * bfhi(b.x); y[2] = w0 * bflo(a.y) + w1 * bflo(b.y); y[3] = w0 * bfhi(a.y) + w1 * bfhi(b.y);
                v[j] = x + g * y;
            }
        }
        if (MODE == 2) {
            float* o = F.out + (size_t)(row - NCTX) * DM;
#pragma unroll
            for (int j = 0; j < 8; ++j) *(f32x4*)(o + 256 * j + 4 * lane) = v[j];
        } else {
            float* xo = X + (size_t)row * DM; float ss = 0.f;
#pragma unroll
            for (int j = 0; j < 8; ++j) { if (MODE != 0) *(f32x4*)(xo + 256 * j + 4 * lane) = v[j]; ss += v[j][0] * v[j][0] + v[j][1] * v[j][1] + v[j][2] * v[j][2] + v[j][3] * v[j][3]; }
            const float rstd = rsqrtf(wave_sum(ss) * (1.0f / DM) + EPSN);
            const float* mrow = mod + (size_t)(layer * 3 + cls) * 12288;
            bf16* ho = H + (size_t)row * DM;
#pragma unroll
            for (int j = 0; j < 8; ++j) {
                const int e = 256 * j + 4 * lane;
                const f32x4 gn = *(const f32x4*)(gain + e), sh = *(const f32x4*)(mrow + e), sc = *(const f32x4*)(mrow + DM + e);
                const f32x4 h = v[j] * rstd * gn * (sc + 1.0f) + sh;
                v2u o; o.x = pk2(h[0], h[1]); o.y = pk2(h[2], h[3]); *(v2u*)(ho + e) = o;
            }
        }
    }
}
constexpr size_t WS_RWT = WS_HDNC + 128 * 1024, WS_RB = WS_HDNC + 64 * 1024;
__device__ __forceinline__ void route_fold(Frame& F) {
    PHASE_LOCALS
    const float* mod = (const float*)(F.ws + WS_MOD); const float* rw = F.in[27];
    float* rwt = (float*)(F.ws + WS_RWT); float* rbv = (float*)(F.ws + WS_RB);
    for (int idx = F.bx * NTHR + tid; idx < 2 * 3 * 16 * DM; idx += F.G * NTHR) {
        const int d = idx & (DM - 1), e = (idx >> 11) & 15, lc = idx >> 15;
        const int layer = lc / 3;
        rwt[idx] = F.in[7][layer * DM + d] * (1.0f + mod[(size_t)lc * 12288 + 4 * DM + d]) * rw[d * 16 + e];
    }
    if (gw < 96) {
        const int e = gw & 15, lc = gw >> 4; float s = 0.f;
        for (int d = lane; d < DM; d += 64) s += mod[(size_t)lc * 12288 + 3 * DM + d] * rw[d * 16 + e];
        s = wave_sum(s); if (lane == 0) rbv[gw] = s;
    }
}
template <int J> __device__ __forceinline__ float quad_bcast(float v) { return __builtin_bit_cast(float, __builtin_amdgcn_update_dpp(0, __builtin_bit_cast(int, v), J * 0x55, 0xF, 0xF, false)); }
__device__ __forceinline__ float row_sum16(float v) { v += row_ror<8>(v); v += row_ror<4>(v); v += row_ror<2>(v); v += row_ror<1>(v); return v; }
__device__ __forceinline__ float row_max16(float v) { v = fmaxf(v, row_ror<8>(v)); v = fmaxf(v, row_ror<4>(v)); v = fmaxf(v, row_ror<2>(v)); v = fmaxf(v, row_ror<1>(v)); return v; }
__device__ __forceinline__ void phase_route(Frame& F, int layer, int rep = 0) {
    PHASE_LOCALS
    const float* X = (const float*)(F.ws + WS_X); bf16* H = (bf16*)(F.ws + WS_H);
    const float* mod = (const float*)(F.ws + WS_MOD);
    unsigned* route = (unsigned*)(F.ws + WS_ROUTE) + (rep ? 8 * NROW : 0);
    unsigned* cnt = (unsigned*)(F.ws + WS_CTL) + CW_CNT + 64 * 16 * (2 * layer + rep);
    const float* gain = F.in[7] + layer * DM; const float* rb = F.in[28];
    constexpr int XS = DM + 4;
    LAS float* XT = (LAS float*)F.lds;
    LAS float* RSTD = (LAS float*)(F.lds + LDSCTL_OFF + 1024);
    LAS unsigned* lcnt = (LAS unsigned*)(F.lds + LDSCTL_OFF + 768);
    static_assert(16 * XS * 4 <= RING_BYTES, "route LDS map");
    __syncthreads();
    if (tid < 32) lcnt[tid] = 0u;
    const int r_begin = layer == 0 ? 0 : NCTX, ntile = (NROW - r_begin) / 16;
    const int m = lane & 15, kq = lane >> 4;
    for (int tl = F.bx; tl < ntile; tl += F.G) {
        const int row0 = r_begin + 16 * tl, cls = row_cls(row0);
        const float* mrow = mod + (size_t)(layer * 3 + cls) * 12288 + 3 * DM;
        __syncthreads();
#pragma unroll
        for (int rr = 0; rr < 2; ++rr) {
            const int mr = 2 * wave + rr, row = row0 + mr;
            const float* src = X + (size_t)row * DM;
            f32x4 v[8]; float ss = 0.f;
#pragma unroll
            for (int j = 0; j < 8; ++j) { v[j] = *(const f32x4*)(src + 256 * j + 4 * lane); ss += v[j][0] * v[j][0] + v[j][1] * v[j][1] + v[j][2] * v[j][2] + v[j][3] * v[j][3]; }
#pragma unroll
            for (int j = 0; j < 8; ++j) *(LAS f32x4*)(XT + mr * XS + 256 * j + 4 * lane) = v[j];
            const float rstd = rsqrtf(wave_sum(ss) * (1.0f / DM) + EPSN);
            if (lane == 0) RSTD[mr] = rstd;
            bf16* ho = H + (size_t)row * DM;
#pragma unroll
            for (int j = 0; j < 8; ++j) {
                const int e = 256 * j + 4 * lane;
                const f32x4 gn = *(const f32x4*)(gain + e), sh = *(const f32x4*)(mrow + e), sc = *(const f32x4*)(mrow + DM + e);
                const f32x4 h = v[j] * rstd * gn * (sc + 1.0f) + sh;
                v2u o; o.x = cvt_pk(h[0], h[1]); o.y = cvt_pk(h[2], h[3]); *(v2u*)(ho + e) = o;
            }
        }
        __syncthreads();
        const float* rwt = (const float*)(F.ws + WS_RWT) + (size_t)(layer * 3 + cls) * 16 * DM + (size_t)m * DM + 256 * wave + 4 * kq;
        const LAS float* xa = XT + m * XS + 256 * wave + 4 * kq;
        f32x4 acc0 = {0.f, 0.f, 0.f, 0.f}, acc1 = acc0;
#pragma unroll 4
        for (int j = 0; j < 16; ++j) {
            const f32x4 a4 = *(const LAS f32x4*)(xa + 16 * j), b4 = *(const f32x4*)(rwt + 16 * j);
            acc0 = __builtin_amdgcn_mfma_f32_16x16x4f32(a4[0], b4[0], acc0, 0, 0, 0); acc1 = __builtin_amdgcn_mfma_f32_16x16x4f32(a4[1], b4[1], acc1, 0, 0, 0);
            acc0 = __builtin_amdgcn_mfma_f32_16x16x4f32(a4[2], b4[2], acc0, 0, 0, 0); acc1 = __builtin_amdgcn_mfma_f32_16x16x4f32(a4[3], b4[3], acc1, 0, 0, 0);
        }
        acc0 += acc1;
        __syncthreads();
        LAS float* PART = XT;
#pragma unroll
        for (int i = 0; i < 4; ++i) PART[wave * 256 + (4 * kq + i) * 16 + m] = acc0[i];
        __syncthreads();
        if (tid < 256) {
            const int mr = tid >> 4, e = tid & 15, row = row0 + mr;
            float s = 0.f;
#pragma unroll
            for (int w8 = 0; w8 < 8; ++w8) s += PART[w8 * 256 + mr * 16 + e];
            const float logit = RSTD[mr] * s + ((const float*)(F.ws + WS_RB))[(layer * 3 + cls) * 16 + e];
            const float mx = row_max16(logit), ex = expf(logit - mx), score = ex / row_sum16(ex), sel = score + rb[e];
            const float q0 = quad_bcast<0>(sel), q1 = quad_bcast<1>(sel), q2 = quad_bcast<2>(sel), q3 = quad_bcast<3>(sel);
            const float hi1 = fmaxf(q0, q1), lo1 = fminf(q0, q1), hi2 = fmaxf(q2, q3), lo2 = fminf(q2, q3);
            const float gs = fmaxf(hi1, hi2) + fmaxf(fminf(hi1, hi2), fmaxf(lo1, lo2));
            const int G = e >> 2, jq = e & 3;
            const float Gf = (float)G;
            const float g1 = row_ror<4>(gs), g2 = row_ror<8>(gs), g3 = row_ror<12>(gs);
            const float G1 = row_ror<4>(Gf), G2 = row_ror<8>(Gf), G3 = row_ror<12>(Gf);
            const bool in_best = (gs > g1 || (gs == g1 && Gf < G1)) && (gs > g2 || (gs == g2 && Gf < G2)) && (gs > g3 || (gs == g3 && Gf < G3));
            const int rank = ((q0 > sel || (q0 == sel && 0 < jq)) ? 1 : 0) + ((q1 > sel || (q1 == sel && 1 < jq)) ? 1 : 0) + ((q2 > sel || (q2 == sel && 2 < jq)) ? 1 : 0) + ((q3 > sel || (q3 == sel && 3 < jq)) ? 1 : 0);
            const bool is0 = in_best && rank == 0, is1 = in_best && rank == 1;
            const float e0f = row_sum16(is0 ? (float)e : 0.f), e1f = row_sum16(is1 ? (float)e : 0.f);
            float w0 = row_sum16(is0 ? score : 0.f), w1 = row_sum16(is1 ? score : 0.f);
            const float wsn = 1.0f / (w0 + w1); w0 *= wsn; w1 *= wsn;
            if (e == 0) {
                const int e0 = (int)e0f, e1 = (int)e1f;
                const unsigned r0 = __hip_atomic_fetch_add(lcnt + e0, 1u, __ATOMIC_RELAXED, __HIP_MEMORY_SCOPE_WORKGROUP);
                const unsigned r1 = __hip_atomic_fetch_add(lcnt + e1, 1u, __ATOMIC_RELAXED, __HIP_MEMORY_SCOPE_WORKGROUP);
                v4u a; a.x = (unsigned)e0; a.y = (unsigned)e1; a.z = r0; a.w = r1;
                v4u b; b.x = __float_as_uint(w0); b.y = __float_as_uint(w1); b.z = 0u; b.w = 0u;
                *(v4u*)(route + (size_t)row * 8) = a; *(v4u*)(route + (size_t)row * 8 + 4) = b;
            }
        }
    }
    __syncthreads();
    if (tid < 16) { const unsigned n = lcnt[tid]; lcnt[16 + tid] = n ? __hip_atomic_fetch_add(cnt + 64 * tid, n, __ATOMIC_RELAXED, __HIP_MEMORY_SCOPE_AGENT) : 0u; }
    __syncthreads();
    for (int tl = F.bx; tl < ntile; tl += F.G)
        if (tid < 16) {
            const int row = r_begin + 16 * tl + tid;
            v4u a = *(const v4u*)(route + (size_t)row * 8);
            a.z += lcnt[16 + a.x]; a.w += lcnt[16 + a.y];
            *(v4u*)(route + (size_t)row * 8) = a;
        }
    __syncthreads();
}
__device__ __forceinline__ void moe_offsets(Frame& F, int layer) {
    PHASE_LOCALS
    LAS int* toff = (LAS int*)(F.lds + TOFF_OFF);
    __syncthreads();
    if (tid == 0) {
        const unsigned* cnt = (const unsigned*)(F.ws + WS_CTL) + CW_CNT + 64 * 16 * (2 * layer); int acc = 0;
        for (int e = 0; e < 16; ++e) { toff[e] = acc; acc += (int)((__hip_atomic_load(cnt + 64 * e, __ATOMIC_RELAXED, __HIP_MEMORY_SCOPE_AGENT) + 255u) >> 8); }
        toff[16] = acc;
    }
    __syncthreads();
}
__device__ __forceinline__ void phase_gather(Frame& F, int layer) {
    PHASE_LOCALS
    moe_offsets(F, layer);
    const LAS int* toff = (const LAS int*)(F.lds + TOFF_OFF);
    const bf16* H = (const bf16*)(F.ws + WS_H); bf16* hperm = (bf16*)(F.ws + WS_Z);
    unsigned* route = (unsigned*)(F.ws + WS_ROUTE);
    const int r_begin = layer == 0 ? 0 : NCTX;
    v4u a_next = {0u, 0u, 0u, 0u};
    if (r_begin + gw < NROW) a_next = *(const v4u*)(route + (size_t)(r_begin + gw) * 8);
    for (int row = r_begin + gw; row < NROW; row += F.NGW) {
        const v4u a = a_next;
        if (row + F.NGW < NROW) a_next = *(const v4u*)(route + (size_t)(row + F.NGW) * 8);
        const unsigned p0 = (unsigned)toff[a.x] * 256u + a.z, p1 = (unsigned)toff[a.y] * 256u + a.w;
        const v4u* src = (const v4u*)(H + (size_t)row * DM); v4u* d0 = (v4u*)(hperm + (size_t)p0 * DM); v4u* d1 = (v4u*)(hperm + (size_t)p1 * DM);
#pragma unroll
        for (int j = 0; j < 4; ++j) { const v4u x = src[64 * j + lane]; d0[64 * j + lane] = x; d1[64 * j + lane] = x; }
        if (lane == 0) { v2u pp; pp.x = p0; pp.y = p1; *(v2u*)(route + (size_t)row * 8 + 6) = pp; }
    }
}
__device__ __forceinline__ void phase_ht(Frame& F) {
    PHASE_LOCALS
    const bf16* Z = (const bf16*)(F.ws + WS_Z); bf16* UT = (bf16*)F.out;
    const float* cw = F.in[13]; const float* cb = F.in[14];
    constexpr int NCB = 3072 / 64, NRB = NROW / 64;
    for (int it = gw; it < NCB * NRB; it += F.NGW) {
        const int cblk = it % NCB, rblk = it / NCB, ch = cblk * 64 + lane, r0 = rblk * 64;
        const float w0 = cw[ch], w1 = cw[3072 + ch], w2 = cw[2 * 3072 + ch], bb = cb[ch];
        const bool first = (r0 < NCTX) ? ((r0 & 255) == 0) : (((r0 - NCTX) & 8191) == 0);
        const bool last = (r0 < NCTX) ? (((r0 + 64) & 255) == 0) : (((r0 + 64 - NCTX) & 8191) == 0);
        const bf16* zp = Z + (size_t)r0 * ZC0 + 3072 + ch;
        bf16* up = UT + (size_t)ch * NROW + r0;
        unsigned short x[66];
        x[0] = first ? (unsigned short)0 : zp[-(ptrdiff_t)ZC0];
#pragma unroll
        for (int r = 0; r < 64; ++r) x[1 + r] = zp[(size_t)r * ZC0];
        x[65] = last ? (unsigned short)0 : zp[(size_t)64 * ZC0];
#pragma unroll
        for (int g8 = 0; g8 < 8; ++g8) {
            float o[8];
#pragma unroll
            for (int q = 0; q < 8; ++q) { const int r = g8 * 8 + q; o[q] = w0 * bf2f(x[r]) + w1 * bf2f(x[r + 1]) + w2 * bf2f(x[r + 2]) + bb; }
            v4u w; w.x = cvt_pk(o[0], o[1]); w.y = cvt_pk(o[2], o[3]); w.z = cvt_pk(o[4], o[5]); w.w = cvt_pk(o[6], o[7]);
            *(v4u*)(up + g8 * 8) = w;
        }
    }
}
__device__ __forceinline__ void merge_heads(Frame& F, const float* gain, int ldz, int r_begin) {
    PHASE_LOCALS
    const bf16* OF = (const bf16*)(F.ws + WS_OF); const bf16* OB = (const bf16*)(F.ws + WS_OB); const bf16* Z = (const bf16*)(F.ws + WS_Z);
    bf16* MIX = (bf16*)(F.ws + WS_MIX);
    const f32x4 gn = *(const f32x4*)(gain + 4 * lane);
    for (int row = r_begin + gw; row < NROW; row += F.NGW) {
#pragma unroll
        for (int h = 0; h < 4; ++h) {
            const size_t off = (size_t)row * 1024 + h * 256 + 4 * lane;
            const v2u a = *(const v2u*)(OF + off), b = *(const v2u*)(OB + off), g = *(const v2u*)(Z + (size_t)row * ldz + 2048 + h * 256 + 4 * lane);
            f32x4 o; o[0] = bflo(a.x) + bflo(b.x); o[1] = bfhi(a.x) + bfhi(b.x); o[2] = bflo(a.y) + bflo(b.y); o[3] = bfhi(a.y) + bfhi(b.y);
            const float ss = wave_sum(o[0] * o[0] + o[1] * o[1] + o[2] * o[2] + o[3] * o[3]);
            const float rstd = rsqrtf(ss * (1.0f / 256.0f) + EPSN);
            f32x4 gg; gg[0] = silu_f(bflo(g.x)); gg[1] = silu_f(bfhi(g.x)); gg[2] = silu_f(bflo(g.y)); gg[3] = silu_f(bfhi(g.y));
            const f32x4 r = o * rstd * gn * gg;
            v2u w; w.x = pk2(r[0], r[1]); w.y = pk2(r[2], r[3]);
            *(v2u*)(MIX + (size_t)row * DM + h * 256 + 4 * lane) = w;
        }
    }
}
__device__ __forceinline__ void merge_hyena(Frame& F) {
    PHASE_LOCALS
    const bf16* HYO = (const bf16*)(F.ws + WS_H); bf16* MIX = (bf16*)(F.ws + WS_MIX);
    LAS unsigned short* tl = (LAS unsigned short*)F.lds + wave * (64 * 72);
    constexpr int NCB = 1024 / 64, NRB = NROW / 64;
    for (int it = gw; it < NCB * NRB; it += F.NGW) {
        const int cblk = it % NCB, rblk = it / NCB, c0 = cblk * 64, r0 = rblk * 64;
#pragma unroll
        for (int i = 0; i < 8; ++i) {
            const int c = i * 8 + (lane >> 3), ch = lane & 7;
            const v4u x = *(const v4u*)(HYO + (size_t)(c0 + c) * NROW + r0 + ch * 8);
            *(LAS v4u*)(tl + c * 72 + ch * 8) = x;
        }
        LDS_WAIT();
#pragma unroll
        for (int i = 0; i < 8; ++i) {
            const int r = i * 8 + (lane >> 3), cq = (lane & 7) * 8;
            unsigned short e[8];
#pragma unroll
            for (int q = 0; q < 8; ++q) e[q] = tl[(cq + q) * 72 + r];
            v4u w; w.x = e[0] | ((unsigned)e[1] << 16); w.y = e[2] | ((unsigned)e[3] << 16); w.z = e[4] | ((unsigned)e[5] << 16); w.w = e[6] | ((unsigned)e[7] << 16);
            *(v4u*)(MIX + (size_t)(r0 + r) * DM + 1024 + c0 + cq) = w;
        }
        LDS_WAIT();
    }
}
__device__ __forceinline__ void phase_prep(Frame& F, int rep = 0) {
    PHASE_LOCALS
    bf16* Z = (bf16*)(F.ws + WS_Z); bf16* ZD = rep ? (bf16*)(F.ws + WS_W) : Z;
    const float* qn = F.in[24]; const float* kn = F.in[25];
    const float rsq = 0.08838834764831845f;
    const float inv_ret = powf(10000.0f, -(float)lane / 63.0f);
    const float inv_ax = powf(10000.0f, -(float)(lane & 31) / 32.0f);
    for (int row = gw; row < NROW; row += F.NGW) {
        const bool latent = row >= NCTX; const int pos = latent ? ((row - NCTX) & 8191) : 0;
        bf16* zr = Z + (size_t)row * ODC; bf16* zd = ZD + (size_t)row * ODC;
        float sr = 0.f, cr = 1.f, s1 = 0.f, c1 = 1.f, s2 = 0.f, c2 = 1.f;
        if (latent) { sincosf((float)pos * inv_ret, &sr, &cr); sincosf((float)(pos >> 6) * inv_ax, &s1, &c1); sincosf((float)(pos & 63) * inv_ax, &s2, &c2); }
#pragma unroll
        for (int sg = 0; sg < 8; ++sg) {
            bf16* p = zr + sg * 128; bf16* pd = zd + sg * 128;
            const float x1 = bf2f(p[lane]), x2 = bf2f(p[64 + lane]);
            float o1 = x1 * cr - x2 * sr, o2 = x2 * cr + x1 * sr;
            if (sg >= 4) { o1 *= rsq; o2 *= rsq; }
            pd[lane] = (bf16)f2bf(o1); pd[64 + lane] = (bf16)f2bf(o2);
        }
#pragma unroll
        for (int sg = 0; sg < 10; ++sg) {
            bf16* p = zr + 3072 + sg * 128; bf16* pd = zd + 3072 + sg * 128; const float* gnp = sg < 8 ? qn : kn;
            float a = bf2f(p[lane]), b = bf2f(p[64 + lane]);
            const float rstd = rsqrtf(wave_sum(a * a + b * b) * (1.0f / 128.0f) + EPSN);
            a = a * rstd * gnp[lane]; b = b * rstd * gnp[64 + lane];
            const float ap = __shfl_xor(a, 32), bp = __shfl_xor(b, 32);
            float oa, ob;
            if (lane < 32) { oa = a * c1 - ap * s1; ob = b * c2 - bp * s2; }
            else { oa = a * c1 + ap * s1; ob = b * c2 + bp * s2; }
            if (sg < 8) { oa *= rsq; ob *= rsq; }
            pd[lane] = (bf16)f2bf(oa); pd[64 + lane] = (bf16)f2bf(ob);
        }
    }
}
__device__ __forceinline__ int scan_rowbase(int n, int b, int dir) {
    if (n < 4) { const int cc = dir ? 3 - n : n; return b * CTXL + cc * 64; }
    const int m = n - 4, cc = dir ? 127 - m : m; return NCTX + b * SEQ + cc * 64;
}
constexpr int QKD_UNIT = 16384 + 8192 + 16384 + 512;
__device__ __forceinline__ size_t qkd_off(int b, int h, int dir, int n) { return (size_t)((((b * 4 + h) * 2 + dir) * 132) + n) * QKD_UNIT; }
struct PreRegs { v4u q[2], k[2]; f32x4 lr; };
template <bool GLA>
__device__ __forceinline__ void prepass_load(Frame& F, int pu, int tid, PreRegs& R) {
    const int n = pu % 132, r_ = pu / 132, dir = r_ & 1, h = (r_ >> 1) & 3, b = r_ >> 3;
    const bf16* Z = (const bf16*)(F.ws + WS_Z);
    constexpr int ldz = GLA ? ZC0 : ODC;
    const bf16* Zq = Z + h * 128; const bf16* Zk = Z + 512 + h * 128;
    const float* LRp = (const float*)(F.ws + WS_LR) + dir * 16;
    const int rb = scan_rowbase(n, b, dir);
#pragma unroll
    for (int i = 0; i < 2; ++i) { const int idx = tid + 512 * i, r = idx >> 4, ch = idx & 15;
        R.q[i] = *(const v4u*)(Zq + (size_t)(rb + r) * ldz + ch * 8); R.k[i] = *(const v4u*)(Zk + (size_t)(rb + r) * ldz + ch * 8); }
    if (GLA && tid < 256) R.lr = *(const f32x4*)(LRp + (size_t)(rb + (tid >> 2)) * 32 + (tid & 3) * 4);
}
template <bool GLA>
__device__ __forceinline__ void prepass_unit(Frame& F, int pu, int pu_next, PreRegs& R) {
    const int n = pu % 132, r_ = pu / 132, dir = r_ & 1, h = (r_ >> 1) & 3, b = r_ >> 3;
    PHASE_LOCALS
    const int w = wave, l = lane, g = l >> 4, c = l & 15;
    LAS unsigned char* lds = F.lds;
    constexpr int S128 = 272, S64 = 144;
    constexpr int O_RQ = 0, O_RK = 17408, O_QE = 34816, O_KE = 52224, O_KDT = 69632, O_LR = 88064;
    const bf16* Z = (const bf16*)(F.ws + WS_Z);
    constexpr int ldz = GLA ? ZC0 : ODC;
    const bf16* Zq = Z + h * 128; const bf16* Zk = Z + 512 + h * 128;
    const float* LRp = (const float*)(F.ws + WS_LR) + dir * 16;
    unsigned char* qkd = F.ws + WS_QKD + qkd_off(b, h, dir, n);
    const float qscale = GLA ? 0.08838834764831845f : 1.0f;
    float wgv[4] = {0.f, 0.f, 0.f, 0.f}, bgv[4] = {0.f, 0.f, 0.f, 0.f}; float lgv = 0.f;
    if (GLA) {
        const float* wg = F.in[10] + dir * 16 * 512 + h * 128 + 16 * w; const float* bg = F.in[11] + dir * 512 + h * 128 + 16 * w;
#pragma unroll
        for (int ks = 0; ks < 4; ++ks) wgv[ks] = wg[(4 * ks + g) * 512 + c];
#pragma unroll
        for (int i = 0; i < 4; ++i) bgv[i] = bg[4 * g + i];
    } else {
        const int hh = dir ? 3 - h : h; lgv = log2f(1.0f - exp2f(-5.0f - (float)hh));
    }
    {
#pragma unroll
        for (int i = 0; i < 2; ++i) { const int idx = tid + 512 * i, r = idx >> 4, ch = idx & 15;
            *(LAS v4u*)(lds + O_RQ + r * S128 + ch * 16) = R.q[i]; *(LAS v4u*)(lds + O_RK + r * S128 + ch * 16) = R.k[i]; }
        if (GLA && tid < 256) { LAS float* lr = (LAS float*)(lds + O_LR) + (tid >> 2) * 17 + (tid & 3) * 4; lr[0] = R.lr[0]; lr[1] = R.lr[1]; lr[2] = R.lr[2]; lr[3] = R.lr[3]; }
        if (pu_next < 2112) prepass_load<GLA>(F, pu_next, tid, R);
        LDS_BARRIER();
        f32x4 cum[4]; float tot[4];
        if (GLA) {
            const LAS float* lrs = (const LAS float*)(lds + O_LR);
            f32x4 la[4];
#pragma unroll
            for (int tt = 0; tt < 4; ++tt) {
                f32x4 a = {0.f, 0.f, 0.f, 0.f};
#pragma unroll
                for (int ks = 0; ks < 4; ++ks) a = __builtin_amdgcn_mfma_f32_16x16x4f32(wgv[ks], lrs[(16 * tt + c) * 17 + 4 * ks + g], a, 0, 0, 0);
#pragma unroll
                for (int i = 0; i < 4; ++i) {
                    const float y = (a[i] + bgv[i]) * -1.44269504089f;
                    la[tt][i] = (fmaxf(y, 0.f) + __builtin_amdgcn_logf(1.0f + __builtin_amdgcn_exp2f(-fabsf(y)))) * -0.0625f; }
            }
            float carry[4] = {0.f, 0.f, 0.f, 0.f};
#pragma unroll
            for (int tt = 0; tt < 4; ++tt)
#pragma unroll
                for (int i = 0; i < 4; ++i) {
                    const float x = la[tt][i];
#if SCAN_DPP
                    float v = x; v += row_shr<1>(v); v += row_shr<2>(v); v += row_shr<4>(v); v += row_shr<8>(v);
                    float r = x; r += row_ror<8>(r); r += row_ror<4>(r); r += row_ror<2>(r); r += row_ror<1>(r);
#else
                    float v = x, u;
                    u = __shfl_up(v, 1, 16); if (c >= 1) v += u;
                    u = __shfl_up(v, 2, 16); if (c >= 2) v += u;
                    u = __shfl_up(v, 4, 16); if (c >= 4) v += u;
                    u = __shfl_up(v, 8, 16); if (c >= 8) v += u;
                    const float r = __shfl(v, 15, 16);
#endif
                    cum[tt][i] = v + carry[i]; carry[i] += r;
                }
#pragma unroll
            for (int i = 0; i < 4; ++i) tot[i] = carry[i];
            if (dir) {
#pragma unroll
                for (int tt = 0; tt < 4; ++tt)
#pragma unroll
                    for (int i = 0; i < 4; ++i) cum[tt][i] = tot[i] - cum[tt][i] + la[tt][i];
            }
        } else {
#pragma unroll
            for (int tt = 0; tt < 4; ++tt) { const int t = 16 * tt + c; const float cv = dir ? (float)(64 - t) * lgv : (float)(t + 1) * lgv;
#pragma unroll
                for (int i = 0; i < 4; ++i) cum[tt][i] = cv; }
#pragma unroll
            for (int i = 0; i < 4; ++i) tot[i] = 64.0f * lgv;
        }
        float dec[4];
#pragma unroll
        for (int i = 0; i < 4; ++i) dec[i] = __builtin_amdgcn_exp2f(tot[i]);
#pragma unroll
        for (int tt = 0; tt < 4; ++tt) {
            const int t = 16 * tt + c;
            const v2u q4 = *(const LAS v2u*)(lds + O_RQ + t * S128 + (16 * w + 4 * g) * 2), k4 = *(const LAS v2u*)(lds + O_RK + t * S128 + (16 * w + 4 * g) * 2);
            const float qv[4] = {bflo(q4.x), bfhi(q4.x), bflo(q4.y), bfhi(q4.y)}, kv[4] = {bflo(k4.x), bfhi(k4.x), bflo(k4.y), bfhi(k4.y)};
            float qe[4], ke[4], kd[4];
            if (GLA) {
#pragma unroll
                for (int i = 0; i < 4; ++i) { const float e1 = __builtin_amdgcn_exp2f(cum[tt][i]), e2 = __builtin_amdgcn_exp2f(-cum[tt][i]);
                    qe[i] = qv[i] * qscale * e1; ke[i] = kv[i] * e2; kd[i] = ke[i] * dec[i]; }
            } else {
                const float e1 = __builtin_amdgcn_exp2f(cum[tt][0]), e2 = __builtin_amdgcn_exp2f(-cum[tt][0]), e3 = e2 * dec[0];
#pragma unroll
                for (int i = 0; i < 4; ++i) { qe[i] = qv[i] * e1; ke[i] = kv[i] * e2; kd[i] = kv[i] * e3; }
            }
            const unsigned d01 = cvt_pk(kd[0], kd[1]), d23 = cvt_pk(kd[2], kd[3]);
            *(LAS unsigned short*)(lds + O_KDT + (16 * w + 4 * g + 0) * S64 + t * 2) = (unsigned short)(d01 & 0xffffu);
            *(LAS unsigned short*)(lds + O_KDT + (16 * w + 4 * g + 1) * S64 + t * 2) = (unsigned short)(d01 >> 16);
            *(LAS unsigned short*)(lds + O_KDT + (16 * w + 4 * g + 2) * S64 + t * 2) = (unsigned short)(d23 & 0xffffu);
            *(LAS unsigned short*)(lds + O_KDT + (16 * w + 4 * g + 3) * S64 + t * 2) = (unsigned short)(d23 >> 16);
            v2u o; o.x = cvt_pk(qe[0], qe[1]); o.y = cvt_pk(qe[2], qe[3]); *(LAS v2u*)(lds + O_QE + t * S128 + (16 * w + 4 * g) * 2) = o;
            o.x = cvt_pk(ke[0], ke[1]); o.y = cvt_pk(ke[2], ke[3]); *(LAS v2u*)(lds + O_KE + t * S128 + (16 * w + 4 * g) * 2) = o;
        }
        if (c == 0) { f32x4 dv; dv[0] = dec[0]; dv[1] = dec[1]; dv[2] = dec[2]; dv[3] = dec[3]; *(f32x4*)(qkd + 40960 + (16 * w + 4 * g) * 4) = dv; }
        LDS_BARRIER();
        {
            const int it = w >> 1, p = w & 1;
            f32x4 sa[2];
#pragma unroll
            for (int jj = 0; jj < 2; ++jj) {
                const int jt = 2 * p + jj;
                sa[jj] = (f32x4){0.f, 0.f, 0.f, 0.f};
#pragma unroll
                for (int ks = 0; ks < 4; ++ks) { const bf16x8 a = *(const LAS bf16x8*)(lds + O_KE + (16 * jt + c) * S128 + (32 * ks + 8 * g) * 2), qf = *(const LAS bf16x8*)(lds + O_QE + (16 * it + c) * S128 + (32 * ks + 8 * g) * 2);
                    sa[jj] = mfma_bf16(a, qf, sa[jj]); }
                const int itok = 16 * it + c;
#pragma unroll
                for (int r = 0; r < 4; ++r) { const int j = 16 * jt + 4 * g + r; const bool keep = dir ? (j >= itok) : (j <= itok); sa[jj][r] = keep ? sa[jj][r] : 0.f; }
            }
            v4u t4; t4.x = cvt_pk(sa[0][0], sa[0][1]); t4.y = cvt_pk(sa[0][2], sa[0][3]); t4.z = cvt_pk(sa[1][0], sa[1][1]); t4.w = cvt_pk(sa[1][2], sa[1][3]);
            *(v4u*)(qkd + 16384 + ((it * 2 + p) * 64 + l) * 16) = t4;
        }
#pragma unroll
        for (int i = 0; i < 2; ++i) { const int idx = tid + 512 * i, ll = idx & 63, cc = ll & 15, gg = ll >> 4;
            { const int it2 = idx >> 8, ks = (idx >> 6) & 3;
              *(v4u*)(qkd + idx * 16) = *(const LAS v4u*)(lds + O_QE + (16 * it2 + cc) * S128 + (32 * ks + 8 * gg) * 2); }
            { const int w2 = idx >> 7, pp = (idx >> 6) & 1, r = 16 * w2 + cc;
              const v2u lo = *(const LAS v2u*)(lds + O_KDT + r * S64 + (32 * pp + 4 * gg) * 2), hi = *(const LAS v2u*)(lds + O_KDT + r * S64 + (32 * pp + 16 + 4 * gg) * 2);
              v4u o; o.x = lo.x; o.y = lo.y; o.z = hi.x; o.w = hi.y; *(v4u*)(qkd + 24576 + idx * 16) = o; } }
        LDS_BARRIER();
    }
}
typedef short trv4 __attribute__((ext_vector_type(4)));
template <bool GLA, bool NOSTORE = false, bool NOLOAD = false, bool NOBAR = false>
__device__ __forceinline__ void scan_unit(Frame& F, int unit) {
    const int s = unit & 3, dir = (unit >> 2) & 1, h = (unit >> 3) & 3, b = unit >> 5;
    PHASE_LOCALS
    const int w = wave, l = lane, g = l >> 4, c = l & 15;
    LAS unsigned char* lds = F.lds;
    constexpr int S128 = 272, S64 = 144;
    constexpr int O_VT = 0, O_ST = 18432, O_OI = 18432 + 34816;
    const bf16* Z = (const bf16*)(F.ws + WS_Z);
    constexpr int ldz = GLA ? ZC0 : ODC;
    const bf16* Zv = Z + 1024 + h * 256 + s * 64;
    bf16* O = (bf16*)(F.ws + (dir ? WS_OB : WS_OF)) + h * 256 + s * 64;
    const unsigned char* qkd0 = F.ws + WS_QKD + qkd_off(b, h, dir, 0);
    const int it = w >> 1, ep = w & 1;
    for (int i = tid; i < 17408 / 4; i += NTHR) ((LAS unsigned*)(lds + O_ST))[i] = 0u;
    f32x4 S[4];
#pragma unroll
    for (int et = 0; et < 4; ++et) S[et] = (f32x4){0.f, 0.f, 0.f, 0.f};
    struct StepRegs { v4u qf[4], P[2], ka[2], rv; f32x4 dec; };
    StepRegs RA, RB, RC;
#define SCAN_LOAD(R_, n_) do { const unsigned char* q_ = qkd0 + (size_t)(n_) * QKD_UNIT; const int rb_ = scan_rowbase((n_), b, dir); \
        _Pragma("unroll") for (int ks_ = 0; ks_ < 4; ++ks_) R_.qf[ks_] = *(const v4u*)(q_ + ((it * 4 + ks_) * 64 + l) * 16); \
        _Pragma("unroll") for (int p_ = 0; p_ < 2; ++p_) { R_.P[p_] = *(const v4u*)(q_ + 16384 + ((it * 2 + p_) * 64 + l) * 16); R_.ka[p_] = *(const v4u*)(q_ + 24576 + ((w * 2 + p_) * 64 + l) * 16); } \
        R_.dec = *(const f32x4*)(q_ + 40960 + (16 * w + 4 * g) * 4); \
        if ((n_) + 1 < 132) { const int rb1_ = scan_rowbase((n_) + 1, b, dir); R_.rv = *(const v4u*)(Zv + (size_t)(rb1_ + (tid >> 3)) * ldz + (tid & 7) * 8); } (void)rb_; } while (0)
#define OI_STORE(n_, buf_) do { const int rbp_ = scan_rowbase((n_), b, dir); \
        *(v4u*)(O + (size_t)(rbp_ + (tid >> 3)) * 1024 + (tid & 7) * 8) = *(const LAS v4u*)(lds + O_OI + (buf_) * 9216 + (tid >> 3) * S64 + (tid & 7) * 16); } while (0)
#define VT_WRITE(R_, buf_) do { *(LAS v4u*)(lds + O_VT + (buf_) * 9216 + (tid >> 3) * S64 + (tid & 7) * 16) = R_.rv; } while (0)
#define SCAN_STEP(R_, R1_, R2_, n_) do { \
        if (!NOSTORE && (n_) >= 1 && (GLA || (n_) >= 5)) OI_STORE((n_) - 1, cur ^ 1);     \
        if (!NOLOAD && (n_) + 2 < 132) SCAN_LOAD(R2_, (n_) + 2); \
        const LAS unsigned char* vtc = lds + O_VT + cur * 9216; const LAS unsigned char* stc = lds + O_ST + cur * 17408; \
          \
          \
        v4u vfr[4][2]; bf16x8 sf[2][4]; \
        _Pragma("unroll") for (int et = 0; et < 4; ++et) \
            _Pragma("unroll") for (int p = 0; p < 2; ++p) { \
                const trv4 lo = __builtin_amdgcn_ds_read_tr16_b64_v4i16((LAS trv4*)(vtc + (32 * p + 4 * g + (c >> 2)) * S64 + (16 * et + 4 * (c & 3)) * 2)); \
                const trv4 hi = __builtin_amdgcn_ds_read_tr16_b64_v4i16((LAS trv4*)(vtc + (32 * p + 16 + 4 * g + (c >> 2)) * S64 + (16 * et + 4 * (c & 3)) * 2)); \
                const v2u l2 = __builtin_bit_cast(v2u, lo), h2 = __builtin_bit_cast(v2u, hi); vfr[et][p] = (v4u){l2.x, l2.y, h2.x, h2.y}; } \
        _Pragma("unroll") for (int en = 0; en < 2; ++en) \
            _Pragma("unroll") for (int ks = 0; ks < 4; ++ks) sf[en][ks] = *(const LAS bf16x8*)(stc + (16 * (2 * ep + en) + c) * S128 + (32 * ks + 8 * g) * 2); \
        if ((n_) + 1 < 132) VT_WRITE(R_, cur ^ 1); \
        _Pragma("unroll") for (int en = 0; en < 2; ++en) { \
            const int et = 2 * ep + en; f32x4 acc = {0.f, 0.f, 0.f, 0.f}; \
            _Pragma("unroll") for (int p = 0; p < 2; ++p) acc = mfma_bf16(__builtin_bit_cast(bf16x8, en == 0 ? (ep == 0 ? vfr[0][p] : vfr[2][p]) : (ep == 0 ? vfr[1][p] : vfr[3][p])), __builtin_bit_cast(bf16x8, R_.P[p]), acc); \
            _Pragma("unroll") for (int ks = 0; ks < 4; ++ks) acc = mfma_bf16(sf[en][ks], __builtin_bit_cast(bf16x8, R_.qf[ks]), acc); \
            { v2u o; o.x = cvt_pk(acc[0], acc[1]); o.y = cvt_pk(acc[2], acc[3]); *(LAS v2u*)(lds + O_OI + cur * 9216 + (16 * it + c) * S64 + (16 * et + 4 * g) * 2) = o; } } \
        { LAS unsigned char* stn = lds + O_ST + (cur ^ 1) * 17408; \
            _Pragma("unroll") for (int et = 0; et < 4; ++et) { \
                _Pragma("unroll") for (int i = 0; i < 4; ++i) S[et][i] *= R_.dec[i]; \
                _Pragma("unroll") for (int p = 0; p < 2; ++p) S[et] = mfma_bf16(__builtin_bit_cast(bf16x8, R_.ka[p]), __builtin_bit_cast(bf16x8, vfr[et][p]), S[et]); \
                v2u o; o.x = cvt_pk(S[et][0], S[et][1]); o.y = cvt_pk(S[et][2], S[et][3]); \
                *(LAS v2u*)(stn + (16 * et + c) * S128 + (16 * w + 4 * g) * 2) = o; } } \
        cur ^= 1; \
        if (!NOBAR) LDS_BARRIER(); } while (0)
    { const int rb0 = scan_rowbase(0, b, dir); RC.rv = *(const v4u*)(Zv + (size_t)(rb0 + (tid >> 3)) * ldz + (tid & 7) * 8); }
    SCAN_LOAD(RA, 0); SCAN_LOAD(RB, 1); if (NOLOAD) SCAN_LOAD(RC, 2);
    int cur = 0;
    VT_WRITE(RC, 0);
    LDS_BARRIER();
#pragma unroll 1
    for (int n = 0; n < 132; n += 3) { SCAN_STEP(RA, RB, RC, n); SCAN_STEP(RB, RC, RA, n + 1); SCAN_STEP(RC, RA, RB, n + 2); }
    if (!NOSTORE) OI_STORE(131, cur ^ 1);
#undef VT_WRITE
#undef OI_STORE
#undef SCAN_STEP
    __syncthreads();
#undef SCAN_LOAD
}
__device__ __forceinline__ f32x2v cmul(f32x2v a, f32x2v b) { return (f32x2v){a.x * b.x - a.y * b.y, a.x * b.y + a.y * b.x}; }
__device__ __forceinline__ f32x2v twid(float turns) { return (f32x2v){__builtin_amdgcn_cosf(turns), __builtin_amdgcn_sinf(turns)}; }
__device__ __forceinline__ int rev4_14(int p) { const unsigned y = __brev((unsigned)p) >> 18; return (int)(((y & 0x1555u) << 1) | ((y >> 1) & 0x1555u)); }

__device__ __forceinline__ int fpad(int i) { return i + ((i >> 6) << 2); }
__device__ __forceinline__ f32x2v cmulp(f32x2v a, f32x2v w) { f32x2v r = a.x * w; r += a.y * (f32x2v){-w.y, w.x}; return r; }
__device__ __forceinline__ f32x2v cmulc(f32x2v a, f32x2v w) { f32x2v r = a.x * (f32x2v){w.x, -w.y}; r += a.y * (f32x2v){w.y, w.x}; return r; }
__device__ __forceinline__ f32x2v mul_mi(f32x2v t) { return (f32x2v){t.y, -t.x}; }
__device__ __forceinline__ f32x2v mul_pi(f32x2v t) { return (f32x2v){-t.y, t.x}; }
#define BF4F(A0, A1, A2, A3) do { const f32x2v b0_ = A0 + A2, b1_ = A0 - A2, b2_ = A1 + A3, b3_ = mul_mi(A1 - A3); A0 = b0_ + b2_; A1 = b1_ + b3_; A2 = b0_ - b2_; A3 = b1_ - b3_; } while (0)
#define BF4I(A0, A1, A2, A3) do { const f32x2v b0_ = A0 + A2, b1_ = A0 - A2, b2_ = A1 + A3, b3_ = mul_pi(A1 - A3); A0 = b0_ + b2_; A1 = b1_ + b3_; A2 = b0_ - b2_; A3 = b1_ - b3_; } while (0)
#define W16_1 ((f32x2v){0.92387953251f, -0.38268343236f})
#define W16_2 ((f32x2v){0.70710678118f, -0.70710678118f})
#define W16_3 ((f32x2v){0.38268343236f, -0.92387953251f})
#define W16_6 ((f32x2v){-0.70710678118f, -0.70710678118f})
#define W16_9 ((f32x2v){-0.92387953251f, 0.38268343236f})
template <int M, bool ZPAD>
__device__ __forceinline__ void fft_fwd16(LAS f32x2v* x, int tid) {
    constexpr int Q16 = M / 16;
#pragma unroll 1
    for (int i = 0; i < 2; ++i) {
        const int bf = tid + 512 * i, blk = bf / Q16, k = bf % Q16, base = blk * M + k;
        f32x2v a[16];
#pragma unroll
        for (int j = 0; j < 16; ++j) a[j] = (ZPAD && j >= 8) ? (f32x2v){0.f, 0.f} : x[fpad(base + j * Q16)];
        const f32x2v w1 = twid(-(float)k * (1.0f / (float)M)), w2 = cmulp(w1, w1), w3 = cmulp(w2, w1), w4 = cmulp(w2, w2), w8 = cmulp(w4, w4), w12 = cmulp(w8, w4);
#pragma unroll
        for (int jp = 0; jp < 4; ++jp) {
            if (ZPAD) { const f32x2v a0 = a[jp], a1 = a[jp + 4], b3 = mul_mi(a1); a[jp] = a0 + a1; a[jp + 4] = a0 + b3; a[jp + 8] = a0 - a1; a[jp + 12] = a0 - b3; }
            else BF4F(a[jp], a[jp + 4], a[jp + 8], a[jp + 12]);
            a[jp + 4] = cmulp(a[jp + 4], w1); a[jp + 8] = cmulp(a[jp + 8], w2); a[jp + 12] = cmulp(a[jp + 12], w3);
        }
        a[5] = cmulp(a[5], W16_1); a[9] = cmulp(a[9], W16_2); a[13] = cmulp(a[13], W16_3);
        a[6] = cmulp(a[6], W16_2); a[10] = mul_mi(a[10]);      a[14] = cmulp(a[14], W16_6);
        a[7] = cmulp(a[7], W16_3); a[11] = cmulp(a[11], W16_6); a[15] = cmulp(a[15], W16_9);
#pragma unroll
        for (int q = 0; q < 4; ++q) {
            BF4F(a[4 * q], a[4 * q + 1], a[4 * q + 2], a[4 * q + 3]);
            a[4 * q + 1] = cmulp(a[4 * q + 1], w4); a[4 * q + 2] = cmulp(a[4 * q + 2], w8); a[4 * q + 3] = cmulp(a[4 * q + 3], w12);
        }
#pragma unroll
        for (int j = 0; j < 16; ++j) x[fpad(base + j * Q16)] = a[j];
    }
    __syncthreads();
}
template <int M, bool HALF>
__device__ __forceinline__ void fft_inv16(LAS f32x2v* x, int tid) {
    constexpr int Q16 = M / 16;
#pragma unroll 1
    for (int i = 0; i < 2; ++i) {
        const int bf = tid + 512 * i, blk = bf / Q16, k = bf % Q16, base = blk * M + k;
        f32x2v a[16];
#pragma unroll
        for (int j = 0; j < 16; ++j) a[j] = x[fpad(base + j * Q16)];
        const f32x2v w1 = twid(-(float)k * (1.0f / (float)M)), w2 = cmulp(w1, w1), w3 = cmulp(w2, w1), w4 = cmulp(w2, w2), w8 = cmulp(w4, w4), w12 = cmulp(w8, w4);
#pragma unroll
        for (int q = 0; q < 4; ++q) {
            a[4 * q + 1] = cmulc(a[4 * q + 1], w4); a[4 * q + 2] = cmulc(a[4 * q + 2], w8); a[4 * q + 3] = cmulc(a[4 * q + 3], w12);
            BF4I(a[4 * q], a[4 * q + 1], a[4 * q + 2], a[4 * q + 3]);
        }
        a[5] = cmulc(a[5], W16_1); a[9] = cmulc(a[9], W16_2); a[13] = cmulc(a[13], W16_3);
        a[6] = cmulc(a[6], W16_2); a[10] = mul_pi(a[10]);      a[14] = cmulc(a[14], W16_6);
        a[7] = cmulc(a[7], W16_3); a[11] = cmulc(a[11], W16_6); a[15] = cmulc(a[15], W16_9);
#pragma unroll
        for (int jp = 0; jp < 4; ++jp) {
            a[jp + 4] = cmulc(a[jp + 4], w1); a[jp + 8] = cmulc(a[jp + 8], w2); a[jp + 12] = cmulc(a[jp + 12], w3);
            if (HALF) { const f32x2v b0 = a[jp] + a[jp + 8], b1 = a[jp] - a[jp + 8], b2 = a[jp + 4] + a[jp + 12], b3 = mul_pi(a[jp + 4] - a[jp + 12]); a[jp] = b0 + b2; a[jp + 4] = b1 + b3; }
            else BF4I(a[jp], a[jp + 4], a[jp + 8], a[jp + 12]);
        }
#pragma unroll
        for (int j = 0; j < (HALF ? 8 : 16); ++j) x[fpad(base + j * Q16)] = a[j];
    }
    __syncthreads();
}
template <bool INV>
__device__ __forceinline__ void fft_r4(LAS f32x2v* x, int tid) {
#pragma unroll 2
    for (int i = 0; i < 8; ++i) {
        const int bf = tid + 512 * i; LAS f32x4* p = (LAS f32x4*)(x + fpad(4 * bf));
        const f32x4 u = p[0], v = p[1];
        f32x2v a0 = {u[0], u[1]}, a1 = {u[2], u[3]}, a2 = {v[0], v[1]}, a3 = {v[2], v[3]};
        if (INV) BF4I(a0, a1, a2, a3); else BF4F(a0, a1, a2, a3);
        p[0] = (f32x4){a0.x, a0.y, a1.x, a1.y}; p[1] = (f32x4){a2.x, a2.y, a3.x, a3.y};
    }
    __syncthreads();
}
template <bool ZPAD> __device__ __forceinline__ void fft_fwd(LAS f32x2v* x, int tid) { fft_fwd16<16384, ZPAD>(x, tid); fft_fwd16<1024, false>(x, tid); fft_fwd16<64, false>(x, tid); fft_r4<false>(x, tid); }
template <bool HALF> __device__ __forceinline__ void fft_inv(LAS f32x2v* x, int tid) { fft_r4<true>(x, tid); fft_inv16<64, false>(x, tid); fft_inv16<1024, false>(x, tid); fft_inv16<16384, HALF>(x, tid); }
__device__ __forceinline__ void spec_mul(LAS f32x2v* x, const f32x2v* ks, float kny, int tid) {
#pragma unroll 1
    for (int h = 0; h < 2; ++h) {
        f32x2v kv[8];
#pragma unroll
        for (int i = 0; i < 8; ++i) kv[i] = ks[tid + 512 * (8 * h + i)];
#pragma unroll
        for (int i = 0; i < 8; ++i) {
            const int idx = tid + 512 * (8 * h + i), p = (idx >> 1) * 4 + (idx & 1), f = rev4_14(p), pp = rev4_14((FFTN - f) & (FFTN - 1));
            const f32x2v k = kv[i];
            const int ip = fpad(p), iq = fpad(pp);
            const f32x2v xp = x[ip], xq = x[iq];
            x[ip] = cmulp(xp, k);
            if (pp != p) x[iq] = cmulc(xq, k);
            if (idx == 0) { const f32x2v x2 = x[2]; x[2] = x2 * kny; }
        }
    }
    __syncthreads();
}
__device__ __forceinline__ float block_sum2(LAS float* red, float v, int tid, int wave, int lane, int slot) {
    v = wave_sum(v); if (lane == 0) red[slot * 8 + wave] = v; __syncthreads();
    float s = 0.f;
#pragma unroll
    for (int i = 0; i < 8; ++i) s += red[slot * 8 + i];
    return s;
}
template <int HYV, int PART = 0>
__device__ __forceinline__ void hyena_unit(Frame& F, int ch) {
    PHASE_LOCALS
    LAS f32x2v* cb = (LAS f32x2v*)F.lds;
    LAS float* cbf = (LAS float*)F.lds;
    LAS float* w3c = (LAS float*)(F.lds + LDSCTL_OFF + 2048);
    LAS float* red = (LAS float*)(F.lds + LDSCTL_OFF + 3072);
    const bf16* UT = (const bf16*)F.out; bf16* HYO = (bf16*)(F.ws + (HYV ? WS_END : WS_H));
    const float* hdnL = (const float*)(F.ws + WS_HDNL); const float* hdnC = (const float*)(F.ws + WS_HDNC);
    unsigned char* hs = F.ws + WS_ACT + (size_t)F.bx * HYS_BYTES;
    f32x2v* KA = (f32x2v*)hs; f32x2v* KB = (f32x2v*)(hs + 65536); f32x2v* ZS = (f32x2v*)(hs + 131072); float* KX = (float*)(hs + 196608);
    const float bias0 = F.in[20][ch], bias1 = F.in[20][1024 + ch];
    const float delta = fabsf(-3.0701134573253945f + (-15.350567286626972f + 3.0701134573253945f) * ((float)ch / 1023.0f));
    const bf16* uz = UT + (size_t)ch * NROW; const bf16* ug1 = UT + (size_t)(1024 + ch) * NROW; const bf16* ug2 = UT + (size_t)(2048 + ch) * NROW;
    bf16* ho = HYO + (size_t)ch * NROW;
    __syncthreads();
    if (PART != 1 && tid < 256) { const int q = tid >> 6, j = tid & 63; w3c[tid] = F.in[19][(size_t)j * 4096 + q * 1024 + ch]; }
    __syncthreads();
    if (!(HYV & 2) && PART != 1) {
        LAS float* kf = cbf;
        LAS float* zc = cbf + 1024;
        LAS float* g1c = cbf + 1536; LAS float* g2c = cbf + 2048; LAS float* y1c = cbf + 2560;
        float s0 = 0.f, s1 = 0.f;
        if (tid < 256) {
            const int l = tid; const float* hr = hdnC + l * 64; float a[4] = {0.f, 0.f, 0.f, 0.f};
#pragma unroll
            for (int jj = 0; jj < 16; ++jj) { const f32x4 hv = *(const f32x4*)(hr + 4 * jj);
#pragma unroll
                for (int q = 0; q < 4; ++q) { const f32x4 wv = *(const LAS f32x4*)(w3c + q * 64 + 4 * jj); a[q] += hv[0] * wv[0] + hv[1] * wv[1] + hv[2] * wv[2] + hv[3] * wv[3]; } }
            const float mult = __expf(-((float)l / 255.0f) * delta) + 0.05f;
#pragma unroll
            for (int q = 0; q < 4; ++q) { a[q] *= mult; kf[q * 256 + l] = a[q]; }
            s0 = fabsf(a[0]) + (l >= 1 ? fabsf(a[1]) : 0.f); s1 = fabsf(a[2]) + (l >= 1 ? fabsf(a[3]) : 0.f);
        }
        zc[tid] = bf2f(uz[tid]); g1c[tid] = bf2f(ug1[tid]); g2c[tid] = bf2f(ug2[tid]);
        const float n0 = block_sum2(red, s0, tid, wave, lane, 0), n1 = block_sum2(red, s1, tid, wave, lane, 1);
        const int bb = tid >> 8, t = tid & 255;
        float y = 0.f;
        for (int sidx = 0; sidx < 256; ++sidx) { const int m = t - sidx; const float kv = m >= 0 ? kf[m] : kf[256 - m]; y += kv * zc[bb * 256 + sidx]; }
        const float y1 = g1c[tid] * (y / n0 + zc[tid] * bias0);
        y1c[tid] = y1;
        __syncthreads();
        y = 0.f;
        for (int sidx = 0; sidx < 256; ++sidx) { const int m = t - sidx; const float kv = m >= 0 ? kf[512 + m] : kf[768 - m]; y += kv * y1c[bb * 256 + sidx]; }
        const float o = g2c[tid] * (y / n1 + y1 * bias1);
        ho[tid] = (bf16)f2bf(o);
        __syncthreads();
    }
    if (PART == 2) return;
    if (!(HYV & 4)) {
        float s0 = 0.f, s1 = 0.f;
        const float* f0p = (const float*)(F.ws + WS_FILT0) + (size_t)ch * 8192; const float* f1p = (const float*)(F.ws + WS_FILT1) + (size_t)ch * 8192;
        const float* f2p = (const float*)(F.ws + WS_FILT2) + (size_t)ch * 8192; const float* f3p = (const float*)(F.ws + WS_FILT3) + (size_t)ch * 8192;
#pragma unroll
        for (int i = 0; i < 4; ++i) {
            const int l4 = (tid + 512 * i) * 4;
            const f32x4 a0 = *(const f32x4*)(f0p + l4), a1 = *(const f32x4*)(f1p + l4), a2 = *(const f32x4*)(f2p + l4), a3 = *(const f32x4*)(f3p + l4);
#pragma unroll
            for (int j = 0; j < 4; ++j) {
                const int l = l4 + j;
                const float mult = __expf(-((float)l / 8191.0f) * delta) + 0.05f;
                const float b0 = a0[j] * mult, b1 = a1[j] * mult, b2 = a2[j] * mult, b3 = a3[j] * mult;
                cb[fpad(l)] = (f32x2v){b0, b2};
                if (l >= 1) { cb[fpad(FFTN - l)] = (f32x2v){b1, b3}; s0 += fabsf(b1); s1 += fabsf(b3); } else cb[fpad(8192)] = (f32x2v){0.f, 0.f};
                s0 += fabsf(b0); s1 += fabsf(b2);
            }
        }
        const float n0 = block_sum2(red, s0, tid, wave, lane, 2), n1 = block_sum2(red, s1, tid, wave, lane, 3);
        if (!(HYV & 1)) fft_fwd<false>(cb, tid);
        const float sc0 = 1.0f / (n0 * (float)FFTN), sc1 = 1.0f / (n1 * (float)FFTN);
#pragma unroll 2
        for (int i = 0; i < 16; ++i) {
            const int idx = tid + 512 * i, p = (idx >> 1) * 4 + (idx & 1), f = rev4_14(p), pp = rev4_14((FFTN - f) & (FFTN - 1));
            const f32x2v zf = cb[fpad(p)], zq = cb[fpad(pp)]; const f32x2v zc = (f32x2v){zq.x, -zq.y};
            const f32x2v sm = zf + zc, df = zf - zc;
            KA[idx] = sm * (0.5f * sc0); KB[idx] = (f32x2v){df.y, -df.x} * (0.5f * sc1);
            if (idx == 0) { const f32x2v z2 = cb[2]; KX[0] = z2.x * sc0; KX[1] = z2.y * sc1; }
        }
        __syncthreads();
    }
    const float kny0 = KX[0], kny1 = KX[1];
#pragma unroll
    for (int i = 0; i < 2; ++i) {
        const int t8 = (tid + 512 * i) * 8;
        const v4u a = *(const v4u*)(uz + NCTX + t8), b = *(const v4u*)(uz + NCTX + SEQ + t8);
        const unsigned av[4] = {a.x, a.y, a.z, a.w}, bv[4] = {b.x, b.y, b.z, b.w};
#pragma unroll
        for (int q = 0; q < 4; ++q) { cb[fpad(t8) + 2 * q] = (f32x2v){bflo(av[q]), bflo(bv[q])}; cb[fpad(t8) + 2 * q + 1] = (f32x2v){bfhi(av[q]), bfhi(bv[q])}; }
    }
    __syncthreads();
    if (!(HYV & 1)) fft_fwd<true>(cb, tid); spec_mul(cb, KA, kny0, tid); if (!(HYV & 1)) fft_inv<true>(cb, tid);
#pragma unroll
    for (int i = 0; i < 2; ++i) {
        const int t8 = (tid + 512 * i) * 8;
        const v4u a = *(const v4u*)(uz + NCTX + t8), b = *(const v4u*)(uz + NCTX + SEQ + t8), ga = *(const v4u*)(ug1 + NCTX + t8), gb = *(const v4u*)(ug1 + NCTX + SEQ + t8);
        const unsigned av[4] = {a.x, a.y, a.z, a.w}, bv[4] = {b.x, b.y, b.z, b.w}, gav[4] = {ga.x, ga.y, ga.z, ga.w}, gbv[4] = {gb.x, gb.y, gb.z, gb.w};
#pragma unroll
        for (int q = 0; q < 8; ++q) {
            const float z0 = (q & 1) ? bfhi(av[q >> 1]) : bflo(av[q >> 1]), z1 = (q & 1) ? bfhi(bv[q >> 1]) : bflo(bv[q >> 1]);
            const float g0 = (q & 1) ? bfhi(gav[q >> 1]) : bflo(gav[q >> 1]), g1 = (q & 1) ? bfhi(gbv[q >> 1]) : bflo(gbv[q >> 1]);
            const f32x2v cv = cb[fpad(t8) + q];
            const f32x2v y = (f32x2v){g0 * (cv.x + z0 * bias0), g1 * (cv.y + z1 * bias0)};
            cb[fpad(t8) + q] = y; ZS[t8 + q] = y;
        }
    }
    __syncthreads();
    if (!(HYV & 1)) fft_fwd<true>(cb, tid); spec_mul(cb, KB, kny1, tid); if (!(HYV & 1)) fft_inv<true>(cb, tid);
#pragma unroll
    for (int i = 0; i < 2; ++i) {
        const int t8 = (tid + 512 * i) * 8;
        const v4u ga = *(const v4u*)(ug2 + NCTX + t8), gb = *(const v4u*)(ug2 + NCTX + SEQ + t8);
        const unsigned gav[4] = {ga.x, ga.y, ga.z, ga.w}, gbv[4] = {gb.x, gb.y, gb.z, gb.w};
        float o0[8], o1[8];
#pragma unroll
        for (int q = 0; q < 8; ++q) {
            const float g0 = (q & 1) ? bfhi(gav[q >> 1]) : bflo(gav[q >> 1]), g1 = (q & 1) ? bfhi(gbv[q >> 1]) : bflo(gbv[q >> 1]);
            const f32x2v cv = cb[fpad(t8) + q], y1 = ZS[t8 + q];
            o0[q] = g0 * (cv.x + y1.x * bias1); o1[q] = g1 * (cv.y + y1.y * bias1);
        }
        v4u w0, w1; w0.x = pk2(o0[0], o0[1]); w0.y = pk2(o0[2], o0[3]); w0.z = pk2(o0[4], o0[5]); w0.w = pk2(o0[6], o0[7]);
        w1.x = pk2(o1[0], o1[1]); w1.y = pk2(o1[2], o1[3]); w1.z = pk2(o1[4], o1[5]); w1.w = pk2(o1[6], o1[7]);
        *(v4u*)(ho + NCTX + t8) = w0; *(v4u*)(ho + NCTX + SEQ + t8) = w1;
    }
    __syncthreads();
}
__device__ __forceinline__ void attn_unit(Frame& F, int unit) {
    const int qb = unit & 127, kvh = (unit >> 7) & 1, b = unit >> 8;
    PHASE_LOCALS
    const int w = wave, l = lane, g = l >> 4, c = l & 15;
    const int hq = w >> 1, th = w & 1, head = kvh * 4 + hq, q0 = qb * 64;
    LAS unsigned char* lds = F.lds;
    constexpr int O_KT = 0, O_VT = 17408;
    const bf16* Z = (const bf16*)(F.ws + WS_Z); bf16* MIX = (bf16*)(F.ws + WS_MIX);
    bf16x8 qf[2][4];
#pragma unroll
    for (int it = 0; it < 2; ++it)
#pragma unroll
        for (int ks = 0; ks < 4; ++ks) qf[it][ks] = *(const bf16x8*)(Z + (size_t)(NCTX + b * SEQ + q0 + 32 * th + 16 * it + c) * ODC + 3072 + head * 128 + 32 * ks + 8 * g);
    const float sink = F.in[26][head];
    float m_run[2] = {sink, sink}, l_run[2] = {1.f, 1.f};
    f32x4 Oa[8][2];
#pragma unroll
    for (int dt = 0; dt < 8; ++dt) { Oa[dt][0] = (f32x4){0.f, 0.f, 0.f, 0.f}; Oa[dt][1] = (f32x4){0.f, 0.f, 0.f, 0.f}; }
    v4u kvr[2], vvr[2];
#define ATTN_LOAD(kt_) do { _Pragma("unroll") for (int i = 0; i < 2; ++i) { \
            const int idx = tid + 512 * i, key = idx >> 4, chn = idx & 15; int row; bool valid = true; \
            if ((kt_) < 4) row = b * CTXL + 64 * (kt_) + key; \
            else { const int pos = q0 - 128 + 64 * ((kt_) - 4) + key; valid = pos >= 0 && pos < SEQ; row = NCTX + b * SEQ + pos; } \
            kvr[i] = (v4u){0u, 0u, 0u, 0u}; vvr[i] = (v4u){0u, 0u, 0u, 0u}; \
            if (valid) { const bf16* zr = Z + (size_t)row * ODC; kvr[i] = *(const v4u*)(zr + 4096 + kvh * 128 + chn * 8); vvr[i] = *(const v4u*)(zr + 4352 + kvh * 128 + chn * 8); } } } while (0)
    ATTN_LOAD(0);
    __syncthreads();
#pragma unroll 1
    for (int kt = 0; kt < 9; ++kt) {
        if (kt) LDS_BARRIER();
#pragma unroll
        for (int i = 0; i < 2; ++i) {
            const int idx = tid + 512 * i, key = idx >> 4, chn = idx & 15;
            *(LAS v4u*)(lds + O_KT + key * 272 + chn * 16) = kvr[i];
            *(LAS v4u*)(lds + O_VT + key * 272 + chn * 16) = vvr[i];
        }
        if (kt + 1 < 9) ATTN_LOAD(kt + 1);
        LDS_BARRIER();
        f32x4 sa[4][2];
#pragma unroll
        for (int jt = 0; jt < 4; ++jt) {
            sa[jt][0] = (f32x4){0.f, 0.f, 0.f, 0.f}; sa[jt][1] = (f32x4){0.f, 0.f, 0.f, 0.f};
#pragma unroll
            for (int ks = 0; ks < 4; ++ks) { const bf16x8 a = *(const LAS bf16x8*)(lds + O_KT + (16 * jt + c) * 272 + (32 * ks + 8 * g) * 2);
                sa[jt][0] = mfma_bf16(a, qf[0][ks], sa[jt][0]); sa[jt][1] = mfma_bf16(a, qf[1][ks], sa[jt][1]); }
        }
        if (kt >= 4) {
#pragma unroll
            for (int jt = 0; jt < 4; ++jt)
#pragma unroll
                for (int it = 0; it < 2; ++it)
#pragma unroll
                    for (int r = 0; r < 4; ++r) {
                        const int kpos = q0 - 128 + 64 * (kt - 4) + 16 * jt + 4 * g + r, qpos = q0 + 32 * th + 16 * it + c, d = qpos - kpos;
                        const bool ok = kpos >= 0 && kpos < SEQ && d <= 128 && d >= -128;
                        sa[jt][it][r] = ok ? sa[jt][it][r] : -1.0e30f;
                    }
        }
        bf16x8 P[2][2];
#pragma unroll
        for (int it = 0; it < 2; ++it) {
            float mx = -3.0e38f;
#pragma unroll
            for (int jt = 0; jt < 4; ++jt)
#pragma unroll
                for (int r = 0; r < 4; ++r) mx = fmaxf(mx, sa[jt][it][r]);
            mx = fmaxf(mx, __shfl_xor(mx, 16)); mx = fmaxf(mx, __shfl_xor(mx, 32));
            const float mn = fmaxf(m_run[it], mx), alpha = __expf(m_run[it] - mn);
            float rs = 0.f;
#pragma unroll
            for (int jt = 0; jt < 4; ++jt)
#pragma unroll
                for (int r = 0; r < 4; ++r) { const float p = __expf(sa[jt][it][r] - mn); sa[jt][it][r] = p; rs += p; }
            rs += __shfl_xor(rs, 16); rs += __shfl_xor(rs, 32);
            l_run[it] = l_run[it] * alpha + rs; m_run[it] = mn;
#pragma unroll
            for (int dt = 0; dt < 8; ++dt) Oa[dt][it] *= alpha;
#pragma unroll
            for (int p2 = 0; p2 < 2; ++p2) { v4u t4; t4.x = cvt_pk(sa[2 * p2][it][0], sa[2 * p2][it][1]); t4.y = cvt_pk(sa[2 * p2][it][2], sa[2 * p2][it][3]);
                t4.z = cvt_pk(sa[2 * p2 + 1][it][0], sa[2 * p2 + 1][it][1]); t4.w = cvt_pk(sa[2 * p2 + 1][it][2], sa[2 * p2 + 1][it][3]); P[p2][it] = __builtin_bit_cast(bf16x8, t4); }
        }
#pragma unroll
        for (int dt = 0; dt < 8; ++dt)
#pragma unroll
            for (int p2 = 0; p2 < 2; ++p2) {
                const trv4 lo4 = __builtin_amdgcn_ds_read_tr16_b64_v4i16((LAS trv4*)(lds + O_VT + (32 * p2 + 4 * g + (c >> 2)) * 272 + (16 * dt + 4 * (c & 3)) * 2));
                const trv4 hi4 = __builtin_amdgcn_ds_read_tr16_b64_v4i16((LAS trv4*)(lds + O_VT + (32 * p2 + 16 + 4 * g + (c >> 2)) * 272 + (16 * dt + 4 * (c & 3)) * 2));
                const v2u lo = __builtin_bit_cast(v2u, lo4), hi = __builtin_bit_cast(v2u, hi4);
                v4u a4; a4.x = lo.x; a4.y = lo.y; a4.z = hi.x; a4.w = hi.y; const bf16x8 a = __builtin_bit_cast(bf16x8, a4);
                Oa[dt][0] = mfma_bf16(a, P[p2][0], Oa[dt][0]); Oa[dt][1] = mfma_bf16(a, P[p2][1], Oa[dt][1]);
            }
    }
#pragma unroll
    for (int it = 0; it < 2; ++it) {
        const float inv = 1.0f / l_run[it];
        bf16* orow = MIX + (size_t)(NCTX + b * SEQ + q0 + 32 * th + 16 * it + c) * DM + 1024 + head * 128 + 4 * g;
#pragma unroll
        for (int dt = 0; dt < 8; ++dt) { const f32x4 o = Oa[dt][it] * inv; v2u wv; wv.x = cvt_pk(o[0], o[1]); wv.y = cvt_pk(o[2], o[3]); *(v2u*)(orow + 16 * dt) = wv; }
    }
#undef ATTN_LOAD
    __syncthreads();
}
constexpr int N_PHASES = 25;
constexpr int QSLOT_OFF = LDSCTL_OFF + 256;

__global__ void __launch_bounds__(NTHR, 2) mk_fwd(Args args) {
    extern __shared__ __attribute__((aligned(16))) unsigned char lds_raw[];
    Frame F;
    F.lds = (LAS unsigned char*)lds_raw;
    F.G = gridDim.x; F.bx = blockIdx.x; F.NGW = F.G * NWAVES;
    F.in = (const float* const __attribute__((address_space(4)))*)__builtin_amdgcn_kernarg_segment_ptr();
    F.out = args.out; F.ws = args.ws;
    for (int u = threadIdx.x; u < (LDS_BYTES - LDSCTL_OFF) / 4; u += NTHR) ((LAS unsigned*)(F.lds + LDSCTL_OFF))[u] = 0u;
    __syncthreads();
    const int lo = args.ph_lo, hi = args.ph_hi;
    XcdBarrier bar; bar.bar = (unsigned*)(F.ws + WS_CTL) + CW_BAR; bar.x = 0; bar.st = nullptr;
    if (hi - lo > 1) bar = xcd_barrier_post((unsigned*)(F.ws + WS_CTL) + CW_BAR, (volatile LAS unsigned*)(F.lds + MISC_OFF) + 8);
#ifndef PHASE_ENABLE
#define PHASE_ENABLE 0xFFFFFFFFu
#endif
#ifndef DUP_SITE
#define DUP_SITE -1
#endif
#ifndef DUP_LAYER
#define DUP_LAYER 0
#endif
#define TAILCONV 1
#ifndef DUP_HYV
#define DUP_HYV 0
#endif
#ifndef DUP_MIX_EN
#define DUP_MIX_EN 15
#endif
#ifndef MIX_EN
#define MIX_EN 31
#endif
#define EN(s) (((PHASE_ENABLE) >> (s)) & 1u)
#define IN(k) (lo <= (k) && (k) < hi)
#define SEAM(k) do { if (IN(k) && IN((k) + 1)) { xcd_barrier(bar); if (DUP_SITE == 99) xcd_barrier(bar); } } while (0)
    unsigned char* ws = F.ws;
    float* X = (float*)(ws + WS_X); bf16* H = (bf16*)(ws + WS_H); bf16* Zb = (bf16*)(ws + WS_Z); bf16* MIX = (bf16*)(ws + WS_MIX); bf16* ACT = (bf16*)(ws + WS_ACT);
    const float* mod = (const float*)(ws + WS_MOD);
    const LAS int* toff = (const LAS int*)(F.lds + TOFF_OFF);

    if (EN(0) && IN(0)) phase_pre(F);
    if (DUP_SITE == 0) { xcd_barrier(bar); phase_pre(F); }
    SEAM(0);
    if (EN(1) && IN(1)) phase_modfin(F);
    SEAM(1);
    {
        constexpr int layer = 0;
        const int pb = 2 + 11 * layer;
#define SITE_NORM if (EN(2) && IN(pb)) { if (layer == 0) { route_fold(F); phase_norm<0>(F, 0); } else phase_norm<1>(F, 1); }
        SITE_NORM
#if DUP_SITE == 2
        if (DUP_LAYER == layer) { xcd_barrier(bar); SITE_NORM }
#endif
        SEAM(pb);
#define SITE_GIN if (EN(3) && IN(pb + 1)) { \
            const int N = layer ? ODC : EVN; \
            pg8::Gemm g{H, (const bf16*)(ws + (layer ? WS_WIN1 : WS_WIN0)), NROW, N, DM}; pg8::StaticOrder S; S.init(NROW, N, F.G, F.bx); \
            pg8::EpiStore E{Zb, layer ? ODC : ZC0, 0x7fffffff, layer ? 18 : 24, (float*)(ws + WS_LR)}; \
            pg8::gemm_phase<pg8::EpiStore, pg8::StaticOrder, true, true>(F.lds, g, S, E); \
              \
            if (layer == 0 && TAILCONV && F.G == 256 && F.bx >= 114) conv_unit<8>(F, 0, F.bx - 114); }
        SITE_GIN
#if DUP_SITE == 3
        if (DUP_LAYER == layer) { xcd_barrier(bar); SITE_GIN }
#endif
        SEAM(pb + 1);
#define SITE_PREMIX(REP_) if (EN(4) && IN(pb + 2)) { if (layer == 0) { phase_ht(F); __syncthreads(); \
                if ((REP_) == 0) { PreRegs PR; __syncthreads(); prepass_load<true>(F, F.bx, threadIdx.x, PR); for (int pu = F.bx; pu < 2112; pu += F.G) prepass_unit<true>(F, pu, pu + F.G, PR); __syncthreads(); }     \
                  \
                pg8::Gemm g{(const bf16*)(ws + WS_W3S), (const bf16*)(ws + WS_HDS), 4096, 8192, 256}; pg8::StaticOrder S; S.init(4096, 8192, F.G, F.bx); \
                pg8::EpiFilt E{ws}; \
                pg8::gemm_phase<pg8::EpiFilt, pg8::StaticOrder, true, true>(F.lds, g, S, E); } \
            else phase_prep(F, REP_); }
        SITE_PREMIX(0)
#if DUP_SITE == 4
        if (DUP_LAYER == layer) { xcd_barrier(bar); SITE_PREMIX(1) }
#endif
        SEAM(pb + 2);
#define SITE_PREPASS if (EN(13) && IN(pb + 3)) { \
            if (layer != 0) { PreRegs PR; __syncthreads(); prepass_load<false>(F, F.bx, threadIdx.x, PR); for (int pu = F.bx; pu < 2112; pu += F.G) prepass_unit<false>(F, pu, pu + F.G, PR); __syncthreads(); } }
        SITE_PREPASS
#if DUP_SITE == 13
        if (DUP_LAYER == layer) { xcd_barrier(bar); SITE_PREPASS }
#endif
        if (layer != 0) SEAM(pb + 3);
#define SITE_MIXER(REP_, MEN_, HYV_) if (EN(5) && IN(pb + 4)) { \
            unsigned* qhead = (unsigned*)(ws + WS_CTL) + (layer == 0 ? CW_HYQ : CW_ATQ) + 16 * (REP_); \
            const int nunits = layer == 0 ? 2048 : 512 + 1536; \
            for (int u = F.bx; u < 64; u += F.G) { __syncthreads(); if (layer == 0) { if ((MEN_) & 1) scan_unit<true, ((HYV_) & 8) != 0, ((HYV_) & 16) != 0, ((HYV_) & 32) != 0>(F, u); } else { if ((MEN_) & 2) scan_unit<false, ((HYV_) & 8) != 0, ((HYV_) & 16) != 0, ((HYV_) & 32) != 0>(F, u); } } \
            for (;;) { \
                __syncthreads(); \
                if (threadIdx.x == 0) *(LAS int*)(F.lds + QSLOT_OFF) = (int)__hip_atomic_fetch_add(qhead, 1u, __ATOMIC_RELAXED, __HIP_MEMORY_SCOPE_AGENT); \
                __syncthreads(); \
                const int u = *(LAS int*)(F.lds + QSLOT_OFF); \
                if (u >= nunits) break; \
                if (layer == 0) { if ((MEN_) & 4) { if (u < 1024) hyena_unit<HYV_, 1>(F, u); else hyena_unit<HYV_, 2>(F, u - 1024); } } else if (u < 512) { if ((MEN_) & 8) attn_unit(F, u); } else { if ((MEN_) & 16) conv_unit<2>(F, 1, u - 512); } \
            } \
            __syncthreads(); }
        SITE_MIXER(0, MIX_EN, 0)
#if DUP_SITE == 5
        if (DUP_LAYER == layer) { xcd_barrier(bar); SITE_MIXER(1, DUP_MIX_EN, DUP_HYV) }
#endif
        SEAM(pb + 4);
#define SITE_MERGE if (EN(6) && IN(pb + 5)) { \
            if (layer == 0) { merge_heads(F, F.in[12], ZC0, 0); __syncthreads(); merge_hyena(F); } \
            else merge_heads(F, F.in[23], ODC, NCTX); }
        SITE_MERGE
#if DUP_SITE == 6
        if (DUP_LAYER == layer) { xcd_barrier(bar); SITE_MERGE }
#endif
        SEAM(pb + 5);
#define SITE_GOUT(XP_) if (EN(7) && IN(pb + 6)) { \
            const int row_off = layer ? NCTX : 0, M = NROW - row_off; \
            pg8::Gemm g{MIX + (size_t)row_off * DM, (const bf16*)(ws + (layer ? WS_WOUT1 : WS_WOUT0)), M, DM, DM}; pg8::StaticOrder S; S.init(M, DM, F.G, F.bx); \
            const float* gb = mod + (size_t)layer * 3 * 12288 + 2 * DM; \
            pg8::EpiOut E{XP_, row_off, gb, layer == 0 ? F.in[2] : nullptr, layer == 0 ? F.in[0] : nullptr}; \
            pg8::gemm_phase<pg8::EpiOut, pg8::StaticOrder, true, true>(F.lds, g, S, E); \
              \
            if (layer == 0 && TAILCONV && F.G == 256 && F.bx >= 16) { conv_unit<8>(F, 0, 142 + F.bx - 16); if (F.bx < 18) conv_unit<8>(F, 0, 382 + F.bx - 16); } }
        SITE_GOUT(X)
#if DUP_SITE == 7
        if (DUP_LAYER == layer) { xcd_barrier(bar); SITE_GOUT((float*)(ws + WS_Z)) }
#endif
        SEAM(pb + 6);
        if (EN(8) && IN(pb + 7)) phase_route(F, layer);
#if DUP_SITE == 8
        if (DUP_LAYER == layer) { xcd_barrier(bar); phase_route(F, layer, 1); }
#endif
        SEAM(pb + 7);
#define SITE_GATHER if (EN(9) && IN(pb + 8)) phase_gather(F, layer);
        SITE_GATHER
#if DUP_SITE == 9
        if (DUP_LAYER == layer) { xcd_barrier(bar); SITE_GATHER }
#endif
        SEAM(pb + 8);
#define SITE_MOE1 if (EN(10) && IN(pb + 9)) { \
            moe_offsets(F, layer); \
            pg8::Gemm g{Zb, (const bf16*)(ws + WS_WM13) + (size_t)layer * 16 * 2048 * DM, 0, 0, DM}; \
            pg8::MoeOrder S{F.G, F.bx, __builtin_amdgcn_readfirstlane(toff[16]), toff}; pg8::EpiMoe1 E{ACT}; \
            pg8::gemm_phase<pg8::EpiMoe1, pg8::MoeOrder, true, true>(F.lds, g, S, E); }
        SITE_MOE1
#if DUP_SITE == 10
        if (DUP_LAYER == layer) { xcd_barrier(bar); SITE_MOE1 }
#endif
        SEAM(pb + 9);
#define SITE_MOE2 if (EN(11) && IN(pb + 10)) { \
            moe_offsets(F, layer); \
            pg8::Gemm g{ACT, (const bf16*)(ws + WS_WM2) + (size_t)layer * 16 * 2048 * DFF, 0, 0, DFF}; \
            pg8::MoeOrder S{F.G, F.bx, __builtin_amdgcn_readfirstlane(toff[16]), toff}; pg8::EpiStore E{(bf16*)(ws + WS_W), DM, 7, 8, nullptr}; \
            pg8::gemm_phase<pg8::EpiStore, pg8::MoeOrder, true, true>(F.lds, g, S, E); }
        SITE_MOE2
#if DUP_SITE == 11
        if (DUP_LAYER == layer) { xcd_barrier(bar); SITE_MOE2 }
#endif
        SEAM(pb + 10);
#undef SITE_NORM
#undef SITE_GIN
#undef SITE_PREMIX
#undef SITE_PREPASS
#undef SITE_MIXER
#undef SITE_MERGE
#undef SITE_GATHER
#undef SITE_GOUT
#undef SITE_MOE1
#undef SITE_MOE2
    }
    {
        constexpr int layer = 1;
        const int pb = 2 + 11 * layer;
#define SITE_NORM if (EN(2) && IN(pb)) { if (layer == 0) { route_fold(F); phase_norm<0>(F, 0); } else phase_norm<1>(F, 1); }
        SITE_NORM
#if DUP_SITE == 2
        if (DUP_LAYER == layer) { xcd_barrier(bar); SITE_NORM }
#endif
        SEAM(pb);
#define SITE_GIN if (EN(3) && IN(pb + 1)) { \
            const int N = layer ? ODC : EVN; \
            pg8::Gemm g{H, (const bf16*)(ws + (layer ? WS_WIN1 : WS_WIN0)), NROW, N, DM}; pg8::StaticOrder S; S.init(NROW, N, F.G, F.bx); \
            pg8::EpiStore E{Zb, layer ? ODC : ZC0, 0x7fffffff, layer ? 18 : 24, (float*)(ws + WS_LR)}; \
            pg8::gemm_phase<pg8::EpiStore, pg8::StaticOrder, true, true>(F.lds, g, S, E); \
              \
            if (layer == 0 && TAILCONV && F.G == 256 && F.bx >= 114) conv_unit<8>(F, 0, F.bx - 114); }
        SITE_GIN
#if DUP_SITE == 3
        if (DUP_LAYER == layer) { xcd_barrier(bar); SITE_GIN }
#endif
        SEAM(pb + 1);
#define SITE_PREMIX(REP_) if (EN(4) && IN(pb + 2)) { if (layer == 0) { phase_ht(F); __syncthreads(); \
                if ((REP_) == 0) { PreRegs PR; __syncthreads(); prepass_load<true>(F, F.bx, threadIdx.x, PR); for (int pu = F.bx; pu < 2112; pu += F.G) prepass_unit<true>(F, pu, pu + F.G, PR); __syncthreads(); }     \
                  \
                pg8::Gemm g{(const bf16*)(ws + WS_W3S), (const bf16*)(ws + WS_HDS), 4096, 8192, 256}; pg8::StaticOrder S; S.init(4096, 8192, F.G, F.bx); \
                pg8::EpiFilt E{ws}; \
                pg8::gemm_phase<pg8::EpiFilt, pg8::StaticOrder, true, true>(F.lds, g, S, E); } \
            else phase_prep(F, REP_); }
        SITE_PREMIX(0)
#if DUP_SITE == 4
        if (DUP_LAYER == layer) { xcd_barrier(bar); SITE_PREMIX(1) }
#endif
        SEAM(pb + 2);
#define SITE_PREPASS if (EN(13) && IN(pb + 3)) { \
            if (layer != 0) { PreRegs PR; __syncthreads(); prepass_load<false>(F, F.bx, threadIdx.x, PR); for (int pu = F.bx; pu < 2112; pu += F.G) prepass_unit<false>(F, pu, pu + F.G, PR); __syncthreads(); } }
        SITE_PREPASS
#if DUP_SITE == 13
        if (DUP_LAYER == layer) { xcd_barrier(bar); SITE_PREPASS }
#endif
        if (layer != 0) SEAM(pb + 3);
#define SITE_MIXER(REP_, MEN_, HYV_) if (EN(5) && IN(pb + 4)) { \
            unsigned* qhead = (unsigned*)(ws + WS_CTL) + (layer == 0 ? CW_HYQ : CW_ATQ) + 16 * (REP_); \
            const int nunits = layer == 0 ? 2048 : 512 + 1536; \
            for (int u = F.bx; u < 64; u += F.G) { __syncthreads(); if (layer == 0) { if ((MEN_) & 1) scan_unit<true, ((HYV_) & 8) != 0, ((HYV_) & 16) != 0, ((HYV_) & 32) != 0>(F, u); } else { if ((MEN_) & 2) scan_unit<false, ((HYV_) & 8) != 0, ((HYV_) & 16) != 0, ((HYV_) & 32) != 0>(F, u); } } \
            for (;;) { \
                __syncthreads(); \
                if (threadIdx.x == 0) *(LAS int*)(F.lds + QSLOT_OFF) = (int)__hip_atomic_fetch_add(qhead, 1u, __ATOMIC_RELAXED, __HIP_MEMORY_SCOPE_AGENT); \
                __syncthreads(); \
                const int u = *(LAS int*)(F.lds + QSLOT_OFF); \
                if (u >= nunits) break; \
                if (layer == 0) { if ((MEN_) & 4) { if (u < 1024) hyena_unit<HYV_, 1>(F, u); else hyena_unit<HYV_, 2>(F, u - 1024); } } else if (u < 512) { if ((MEN_) & 8) attn_unit(F, u); } else { if ((MEN_) & 16) conv_unit<2>(F, 1, u - 512); } \
            } \
            __syncthreads(); }
        SITE_MIXER(0, MIX_EN, 0)
#if DUP_SITE == 5
        if (DUP_LAYER == layer) { xcd_barrier(bar); SITE_MIXER(1, DUP_MIX_EN, DUP_HYV) }
#endif
        SEAM(pb + 4);
#define SITE_MERGE if (EN(6) && IN(pb + 5)) { \
            if (layer == 0) { merge_heads(F, F.in[12], ZC0, 0); __syncthreads(); merge_hyena(F); } \
            else merge_heads(F, F.in[23], ODC, NCTX); }
        SITE_MERGE
#if DUP_SITE == 6
        if (DUP_LAYER == layer) { xcd_barrier(bar); SITE_MERGE }
#endif
        SEAM(pb + 5);
#define SITE_GOUT(XP_) if (EN(7) && IN(pb + 6)) { \
            const int row_off = layer ? NCTX : 0, M = NROW - row_off; \
            pg8::Gemm g{MIX + (size_t)row_off * DM, (const bf16*)(ws + (layer ? WS_WOUT1 : WS_WOUT0)), M, DM, DM}; pg8::StaticOrder S; S.init(M, DM, F.G, F.bx); \
            const float* gb = mod + (size_t)layer * 3 * 12288 + 2 * DM; \
            pg8::EpiOut E{XP_, row_off, gb, layer == 0 ? F.in[2] : nullptr, layer == 0 ? F.in[0] : nullptr}; \
            pg8::gemm_phase<pg8::EpiOut, pg8::StaticOrder, true, true>(F.lds, g, S, E); \
              \
            if (layer == 0 && TAILCONV && F.G == 256 && F.bx >= 16) { conv_unit<8>(F, 0, 142 + F.bx - 16); if (F.bx < 18) conv_unit<8>(F, 0, 382 + F.bx - 16); } }
        SITE_GOUT(X)
#if DUP_SITE == 7
        if (DUP_LAYER == layer) { xcd_barrier(bar); SITE_GOUT((float*)(ws + WS_Z)) }
#endif
        SEAM(pb + 6);
        if (EN(8) && IN(pb + 7)) phase_route(F, layer);
#if DUP_SITE == 8
        if (DUP_LAYER == layer) { xcd_barrier(bar); phase_route(F, layer, 1); }
#endif
        SEAM(pb + 7);
#define SITE_GATHER if (EN(9) && IN(pb + 8)) phase_gather(F, layer);
        SITE_GATHER
#if DUP_SITE == 9
        if (DUP_LAYER == layer) { xcd_barrier(bar); SITE_GATHER }
#endif
        SEAM(pb + 8);
#define SITE_MOE1 if (EN(10) && IN(pb + 9)) { \
            moe_offsets(F, layer); \
            pg8::Gemm g{Zb, (const bf16*)(ws + WS_WM13) + (size_t)layer * 16 * 2048 * DM, 0, 0, DM}; \
            pg8::MoeOrder S{F.G, F.bx, __builtin_amdgcn_readfirstlane(toff[16]), toff}; pg8::EpiMoe1 E{ACT}; \
            pg8::gemm_phase<pg8::EpiMoe1, pg8::MoeOrder, true, true>(F.lds, g, S, E); }
        SITE_MOE1
#if DUP_SITE == 10
        if (DUP_LAYER == layer) { xcd_barrier(bar); SITE_MOE1 }
#endif
        SEAM(pb + 9);
#define SITE_MOE2 if (EN(11) && IN(pb + 10)) { \
            moe_offsets(F, layer); \
            pg8::Gemm g{ACT, (const bf16*)(ws + WS_WM2) + (size_t)layer * 16 * 2048 * DFF, 0, 0, DFF}; \
            pg8::MoeOrder S{F.G, F.bx, __builtin_amdgcn_readfirstlane(toff[16]), toff}; pg8::EpiStore E{(bf16*)(ws + WS_W), DM, 7, 8, nullptr}; \
            pg8::gemm_phase<pg8::EpiStore, pg8::MoeOrder, true, true>(F.lds, g, S, E); }
        SITE_MOE2
#if DUP_SITE == 11
        if (DUP_LAYER == layer) { xcd_barrier(bar); SITE_MOE2 }
#endif
        SEAM(pb + 10);
#undef SITE_NORM
#undef SITE_GIN
#undef SITE_PREMIX
#undef SITE_PREPASS
#undef SITE_MIXER
#undef SITE_MERGE
#undef SITE_GATHER
#undef SITE_GOUT
#undef SITE_MOE1
#undef SITE_MOE2
    }
    if (EN(12) && IN(24)) phase_norm<2>(F, 1);
#undef IN
#undef SEAM
}

extern "C" void kernel_launch(void* const* d_in, const int* in_sizes, int n_in, void* d_out, int out_size, void* d_ws, size_t ws_size, hipStream_t stream) {
    static int grid = 0;
    if (grid == 0) {
        if (n_in != 32 || out_size != NLAT * DM || ws_size < WS_END) { fprintf(stderr, "kernel_launch: unexpected shapes (n_in %d, out %d, ws %zu < %zu)\n", n_in, out_size, ws_size, (size_t)WS_END); grid = -1; return; }
        int dev = 0, cus = 0;
        if (hipGetDevice(&dev) != hipSuccess || hipDeviceGetAttribute(&cus, hipDeviceAttributeMultiprocessorCount, dev) != hipSuccess) { grid = -1; return; }
        if (hipFuncSetAttribute((const void*)mk_fwd, hipFuncAttributeMaxDynamicSharedMemorySize, LDS_BYTES) != hipSuccess) { fprintf(stderr, "kernel_launch: hipFuncSetAttribute failed\n"); grid = -1; return; }
        int per_cu = 0;
        if (hipOccupancyMaxActiveBlocksPerMultiprocessor(&per_cu, (const void*)mk_fwd, NTHR, LDS_BYTES) != hipSuccess || per_cu < 1) { fprintf(stderr, "kernel_launch: occupancy query says %d\n", per_cu); }
        (void)hipGetLastError();
        grid = cus;
    }
    if (grid < 0) return;
    if (hipMemsetAsync((char*)d_ws + WS_CTL, 0, CTL_ZERO_BYTES, stream) != hipSuccess) return;
    Args a{};
    for (int i = 0; i < 32; ++i) a.in[i] = (const float*)d_in[i];
    a.out = (float*)d_out; a.ws = (unsigned char*)d_ws;
#if MK_ONE_LAUNCH
    a.ph_lo = 0; a.ph_hi = N_PHASES;
    hipLaunchKernelGGL(mk_fwd, dim3(grid), dim3(NTHR), LDS_BYTES, stream, a);
#else
    for (int p = 0; p < N_PHASES; ++p) { a.ph_lo = p; a.ph_hi = p + 1; hipLaunchKernelGGL(mk_fwd, dim3(grid), dim3(NTHR), LDS_BYTES, stream, a); }
#endif
}
```

```cpp
#include <hip/hip_runtime.h>
#include <cstdio>
#include <cstdint>
#include <cmath>

#ifndef MK_ONE_LAUNCH
#define MK_ONE_LAUNCH 1
#endif
#ifndef SCAN_DPP
#define SCAN_DPP 1
#endif
namespace pg8 {
#define PG8_LAS __attribute__((address_space(3)))
typedef unsigned short bf16_t;
typedef short bf16x8 __attribute__((ext_vector_type(8)));
typedef float f32x4 __attribute__((ext_vector_type(4)));
typedef unsigned u32x4 __attribute__((ext_vector_type(4)));
constexpr int BM = 256, BK = 64, HALF = 128, HTB = HALF * BK * 2  , STAGE_BYTES = 8 * HTB, NXCD = 8, WGM = 8;

__host__ __device__ __forceinline__ int lds_byte(int r, int c) { const int st = (r >> 4) * 2 + (c >> 5), rr = r & 15, cc = c & 31, ob = rr * 64 + cc * 2; return st * 1024 + (ob ^ (((ob >> 9) & 1) << 5)); }
__host__ __device__ __forceinline__ void stage_rc(int b, int& R, int& C) { const int st = b / 1024, sb = b % 1024, swz = sb ^ (((sb >> 9) & 1) << 5); R = (st >> 1) * 16 + swz / 64; C = (st & 1) * 32 + (swz % 64) / 2; }
__host__ __device__ __forceinline__ int perm32(int rho) { const int n = rho >> 4, i = rho & 15; return 8 * (i >> 2) + 4 * n + (i & 3); }

struct Unit { int pm, pn; };
struct Gemm { const bf16_t* A; const bf16_t* Bt; int M, N, K; };

struct StaticOrder {
    int nM, nN, nwg, G, c;
    __host__ __device__ void init(int M, int N, int G_, int c_) { nM = M / BM; nN = N / BM; nwg = nM * nN; G = G_; c = c_; }
    __host__ __device__ bool next(int i, Unit& u) const {
        const long L = (long)i * G + c; if (L >= nwg) return false;
        int wgid = (int)L; { const int q = nwg / NXCD, r = nwg % NXCD, xcd = wgid % NXCD, off = wgid / NXCD; wgid = (xcd < r ? xcd * (q + 1) : r * (q + 1) + (xcd - r) * q) + off; }
        const int nig = WGM * nN, gid = wgid / nig, fm = gid * WGM, gsz = (nM - fm) < WGM ? (nM - fm) : WGM;
        u.pm = fm + ((wgid % nig) % gsz); u.pn = (wgid % nig) / gsz; return true;
    }
    __device__ __forceinline__ void a_ready(const Unit&) const {}
    __device__ __forceinline__ void done(const Unit&) const {}
};

__device__ __forceinline__ unsigned cvt_pk_bf16(float lo, float hi) { unsigned r; asm volatile("v_cvt_pk_bf16_f32 %0, %1, %2" : "=v"(r) : "v"(lo), "v"(hi)); return r; }
typedef float f32x2 __attribute__((ext_vector_type(2)));

template <class Epi, class Sched, bool ALIGN_EPI = false, bool SP2 = false>
__device__ __forceinline__ void gemm_phase(PG8_LAS unsigned char* lds, const Gemm g, const Sched& S, const Epi& E) {
    const int tid = threadIdx.x, wid = __builtin_amdgcn_readfirstlane(tid >> 6), lane = tid & 63, wr = wid >> 2, wc = wid & 3, fr = lane & 15, fq = lane >> 4;
    const int K = g.K, nt = K / BK;
    unsigned voffA[2], voffB[2];
#pragma unroll
    for (int i = 0; i < 2; ++i) { int R, C; stage_rc(tid * 16 + i * 8192, R, C); const int Rb = Epi::PERM ? ((R & ~31) + perm32(R & 31)) : R;
        voffA[i] = (unsigned)(R * K + C) * 2u; voffB[i] = (unsigned)(Rb * K + C) * 2u; }
    const size_t kstep = (size_t)(BK * 2);
    const size_t hstep = (size_t)HALF * K * 2;
    const size_t tstep = 2 * hstep;
    const unsigned ldsw = (unsigned)wid * 1024u;
    const int aoff = lds_byte(wr * 64 + fr, fq * 8), boff = lds_byte(wc * 32 + fr, fq * 8);
#define PG8_SA(b, h) (((b) * 2 + (h)) * HTB)
#define PG8_SB(b, h) ((4 + (b) * 2 + (h)) * HTB)
#define PG8_STAGE(bufoff, gbase, voff) do { _Pragma("unroll") for (int _i = 0; _i < 2; ++_i) \
        __builtin_amdgcn_global_load_lds((const unsigned*)((const char*)(gbase) + (voff)[_i]), (PG8_LAS unsigned*)(lds + (bufoff) + ldsw + _i * 8192), 16, 0, 0); } while (0)
#define PG8_LDA(dst, b, h) do { _Pragma("unroll") for (int m = 0; m < 4; ++m) _Pragma("unroll") for (int k = 0; k < 2; ++k) dst[m][k] = *(const PG8_LAS bf16x8*)(lds + PG8_SA(b, h) + aoff + m * 2048 + k * 1024); } while (0)
#define PG8_LDB(dst, b, h) do { _Pragma("unroll") for (int n = 0; n < 2; ++n) _Pragma("unroll") for (int k = 0; k < 2; ++k) dst[n][k] = *(const PG8_LAS bf16x8*)(lds + PG8_SB(b, h) + boff + n * 2048 + k * 1024); } while (0)
#define PG8_MMA(ai, bj, At, Bt) do { __builtin_amdgcn_s_setprio(1); _Pragma("unroll") for (int m = 0; m < 4; ++m) _Pragma("unroll") for (int n = 0; n < 2; ++n) _Pragma("unroll") for (int k = 0; k < 2; ++k) \
        acc[ai][bj][m][n] = __builtin_amdgcn_mfma_f32_16x16x32_bf16(Bt[n][k], At[m][k], acc[ai][bj][m][n], 0, 0, 0); __builtin_amdgcn_s_setprio(0); } while (0)
#define PG8_WAIT_V(n) asm volatile("s_waitcnt vmcnt(" #n ")" ::: "memory")
#define PG8_WAIT_L(n) asm volatile("s_waitcnt lgkmcnt(" #n ")" ::: "memory")
#define PG8_BAR __builtin_amdgcn_s_barrier()
#define PG8_SCHED __builtin_amdgcn_sched_barrier(0)
    Unit cur, nxt; int ui = 0;
    if (!S.next(0, cur)) return;
    f32x4 acc[2][2][4][2];
#pragma unroll
    for (int a = 0; a < 2; ++a)
#pragma unroll
        for (int b = 0; b < 2; ++b)
#pragma unroll
            for (int m = 0; m < 4; ++m)
#pragma unroll
                for (int n = 0; n < 2; ++n) acc[a][b][m][n] = (f32x4){0.f, 0.f, 0.f, 0.f};
    bf16x8 At[4][2], B0[2][2], B1[2][2];
    const char* cA = (const char*)g.A + (size_t)cur.pm * tstep; const char* cB = (const char*)g.Bt + (size_t)cur.pn * tstep;
    S.a_ready(cur);
    if constexpr (SP2) {
        PG8_STAGE(PG8_SB(0, 0), cB, voffB); PG8_STAGE(PG8_SB(0, 1), cB + hstep, voffB); PG8_STAGE(PG8_SA(0, 0), cA, voffA); PG8_STAGE(PG8_SA(0, 1), cA + hstep, voffA);
        if (wr == 1) PG8_BAR;
        PG8_WAIT_V(2); PG8_BAR;
        PG8_STAGE(PG8_SB(1, 0), cB + kstep, voffB); PG8_STAGE(PG8_SA(1, 0), cA + kstep, voffA); PG8_STAGE(PG8_SB(1, 1), cB + hstep + kstep, voffB);
        PG8_WAIT_V(6); PG8_BAR;
    } else {
        PG8_STAGE(PG8_SB(0, 0), cB, voffB); PG8_STAGE(PG8_SA(0, 0), cA, voffA); PG8_STAGE(PG8_SB(0, 1), cB + hstep, voffB); PG8_STAGE(PG8_SA(0, 1), cA + hstep, voffA);
        if (wr == 1) PG8_BAR;
        PG8_WAIT_V(4); PG8_BAR;
        PG8_STAGE(PG8_SB(1, 0), cB + kstep, voffB); PG8_STAGE(PG8_SA(1, 0), cA + kstep, voffA); PG8_STAGE(PG8_SB(1, 1), cB + hstep + kstep, voffB);
        PG8_WAIT_V(6); PG8_BAR;
    }
    for (;;) {
        const bool has_next = S.next(ui + 1, nxt);
        const char* nA = has_next ? (const char*)g.A + (size_t)nxt.pm * tstep : cA; const char* nB = has_next ? (const char*)g.Bt + (size_t)nxt.pn * tstep : cB;
        for (int t = 0; t < nt; t += 2) {
            const bool last = (t == nt - 2);
            const char* a1 = cA + (size_t)(t + 1) * kstep;
            const char* a2 = last ? nA : cA + (size_t)(t + 2) * kstep; const char* b2 = last ? nB : cB + (size_t)(t + 2) * kstep;
            const char* a3 = a2 + kstep; const char* b3 = b2 + kstep;
            if (last && has_next) S.a_ready(nxt);
            if constexpr (SP2) {
            PG8_LDB(B0, 0, 0); PG8_LDB(B1, 0, 1); PG8_SCHED; PG8_LDA(At, 0, 0); PG8_STAGE(PG8_SA(1, 1), a1 + hstep, voffA);
            PG8_WAIT_V(8); PG8_WAIT_L(0); PG8_BAR; PG8_MMA(0, 0, At, B0); PG8_MMA(0, 1, At, B1); PG8_BAR; PG8_SCHED;
            PG8_LDA(At, 0, 1); PG8_STAGE(PG8_SB(0, 0), b2, voffB); PG8_STAGE(PG8_SB(0, 1), b2 + hstep, voffB); PG8_STAGE(PG8_SA(0, 0), a2, voffA);
            PG8_WAIT_V(8); PG8_WAIT_L(0); PG8_BAR; PG8_MMA(1, 0, At, B0); PG8_MMA(1, 1, At, B1); PG8_BAR; PG8_SCHED;
            PG8_LDB(B0, 1, 0); PG8_LDB(B1, 1, 1); PG8_SCHED; PG8_LDA(At, 1, 0); PG8_STAGE(PG8_SA(0, 1), a2 + hstep, voffA);
            PG8_WAIT_V(8); PG8_WAIT_L(0); PG8_BAR; PG8_MMA(0, 0, At, B0); PG8_MMA(0, 1, At, B1); PG8_BAR; PG8_SCHED;
            PG8_LDA(At, 1, 1); PG8_STAGE(PG8_SB(1, 0), b3, voffB); PG8_STAGE(PG8_SB(1, 1), b3 + hstep, voffB); PG8_STAGE(PG8_SA(1, 0), a3, voffA);
            PG8_WAIT_V(8); PG8_WAIT_L(0); PG8_BAR; PG8_MMA(1, 0, At, B0); PG8_MMA(1, 1, At, B1); PG8_BAR; PG8_SCHED;
            } else {
            PG8_LDB(B0, 0, 0); PG8_SCHED; PG8_LDA(At, 0, 0); PG8_STAGE(PG8_SA(1, 1), a1 + hstep, voffA);
            PG8_WAIT_L(8); PG8_BAR; PG8_WAIT_L(0); PG8_MMA(0, 0, At, B0); PG8_BAR; PG8_SCHED;
            PG8_LDB(B1, 0, 1); PG8_STAGE(PG8_SB(0, 0), b2, voffB);
            PG8_BAR; PG8_WAIT_L(0); PG8_MMA(0, 1, At, B1); PG8_BAR;
            PG8_LDA(At, 0, 1); PG8_STAGE(PG8_SA(0, 0), a2, voffA);
            PG8_BAR; PG8_WAIT_L(0); PG8_MMA(1, 0, At, B0); PG8_BAR; PG8_SCHED;
            PG8_STAGE(PG8_SB(0, 1), b2 + hstep, voffB);
            PG8_WAIT_V(6); PG8_BAR; PG8_MMA(1, 1, At, B1); PG8_BAR;
            PG8_LDB(B0, 1, 0); PG8_SCHED; PG8_LDA(At, 1, 0); PG8_STAGE(PG8_SA(0, 1), a2 + hstep, voffA);
            PG8_WAIT_L(8); PG8_BAR; PG8_WAIT_L(0); PG8_MMA(0, 0, At, B0); PG8_BAR; PG8_SCHED;
            PG8_LDB(B1, 1, 1); PG8_STAGE(PG8_SB(1, 0), b3, voffB);
            PG8_BAR; PG8_WAIT_L(0); PG8_MMA(0, 1, At, B1); PG8_BAR;
            PG8_LDA(At, 1, 1); PG8_STAGE(PG8_SA(1, 0), a3, voffA);
            PG8_BAR; PG8_WAIT_L(0); PG8_MMA(1, 0, At, B0); PG8_BAR; PG8_SCHED;
            PG8_STAGE(PG8_SB(1, 1), b3 + hstep, voffB);
            PG8_WAIT_V(6); PG8_BAR; PG8_MMA(1, 1, At, B1); PG8_BAR;
            }
        }
        if constexpr (ALIGN_EPI) { if (wr == 0) PG8_BAR; }
        if constexpr (!Epi::AFTER_DRAIN) { E(acc, cur, wr, wc, fr, fq); S.done(cur); }
        if (!has_next) break;
#pragma unroll
        for (int a = 0; a < 2; ++a)
#pragma unroll
            for (int b = 0; b < 2; ++b)
#pragma unroll
                for (int m = 0; m < 4; ++m)
#pragma unroll
                    for (int n = 0; n < 2; ++n) acc[a][b][m][n] = (f32x4){0.f, 0.f, 0.f, 0.f};
        cur = nxt; cA = nA; cB = nB; ++ui;
        if constexpr (ALIGN_EPI) { if (wr == 1) PG8_BAR; }
    }
    PG8_WAIT_V(0);
    if constexpr (!ALIGN_EPI) { if (wr == 0) PG8_BAR; }
    PG8_BAR;
    if constexpr (Epi::AFTER_DRAIN) { E.fused(acc, cur, wr, wc, fr, fq, lds, wid, lane); S.done(cur); }
#undef PG8_SA
#undef PG8_SB
#undef PG8_STAGE
#undef PG8_LDA
#undef PG8_LDB
#undef PG8_MMA
#undef PG8_WAIT_V
#undef PG8_WAIT_L
#undef PG8_BAR
#undef PG8_SCHED
}
}
namespace pg8 {
struct EpiStore {
    static constexpr bool PERM = true, AFTER_DRAIN = false;
    bf16_t* O; int ldo; int pn_mask; int nz; float* LR;
    __device__ __forceinline__ void operator()(const f32x4 (&acc)[2][2][4][2], const Unit& u, int wr, int wc, int fr, int fq) const {
        const int row0 = u.pm * BM + wr * 64 + fr; const int ct = u.pn & pn_mask;
        if (ct < nz) {
            const int col0 = ct * BM + wc * 32 + 8 * fq;
#pragma unroll
            for (int ai = 0; ai < 2; ++ai)
#pragma unroll
                for (int m = 0; m < 4; ++m) { bf16_t* rowp = O + (size_t)(row0 + ai * HALF + m * 16) * ldo + col0;
#pragma unroll
                    for (int bj = 0; bj < 2; ++bj) { const f32x4 v0 = acc[ai][bj][m][0], v1 = acc[ai][bj][m][1];
                        u32x4 w; w.x = cvt_pk_bf16(v0[0], v0[1]); w.y = cvt_pk_bf16(v0[2], v0[3]); w.z = cvt_pk_bf16(v1[0], v1[1]); w.w = cvt_pk_bf16(v1[2], v1[3]);
                        *(u32x4*)(rowp + bj * HALF) = w; } }
        } else if (wc == 0) {
#pragma unroll
            for (int ai = 0; ai < 2; ++ai)
#pragma unroll
                for (int m = 0; m < 4; ++m) { float* rp = LR + (size_t)(row0 + ai * HALF + m * 16) * 32 + 8 * fq;
                    *(f32x4*)rp = acc[ai][0][m][0]; *(f32x4*)(rp + 4) = acc[ai][0][m][1]; }
        }
    }
};
struct EpiOut {
    static constexpr bool PERM = false, AFTER_DRAIN = false;
    float* X; int row_off; const float* gbase;
    const float* in_ctx; const float* in_lat;
    __device__ __forceinline__ void operator()(const f32x4 (&acc)[2][2][4][2], const Unit& u, int wr, int wc, int fr, int fq) const {
        const int rt = row_off + u.pm * BM; const int cls = rt < 512 ? 2 : (rt < 512 + 8192 ? 0 : 1); const float* gate = gbase + cls * 12288;
        const int row0 = rt + wr * 64 + fr, col0 = u.pn * BM + wc * 32 + 4 * fq;
        f32x4 gv[2][2];
#pragma unroll
        for (int bj = 0; bj < 2; ++bj)
#pragma unroll
            for (int n = 0; n < 2; ++n) gv[bj][n] = *(const f32x4*)(gate + col0 + bj * HALF + n * 16);
#pragma unroll
        for (int ai = 0; ai < 2; ++ai)
#pragma unroll
            for (int m = 0; m < 4; ++m) { const int rr = row0 + ai * HALF + m * 16; float* rowp = X + (size_t)rr * 2048 + col0;
                const float* srcp = in_lat ? (rt < 512 ? in_ctx + (size_t)rr * 2048 : in_lat + (size_t)(rr - 512) * 2048) + col0 : rowp;
#pragma unroll
                for (int bj = 0; bj < 2; ++bj)
#pragma unroll
                    for (int n = 0; n < 2; ++n) { const f32x4 o = *(const f32x4*)(srcp + bj * HALF + n * 16) + gv[bj][n] * acc[ai][bj][m][n]; *(f32x4*)(rowp + bj * HALF + n * 16) = o; }
                if (m == 3) asm volatile("" ::: "memory"); }
    }
};
struct EpiMoe1 {
    static constexpr bool PERM = true, AFTER_DRAIN = false;
    bf16_t* ACT;
    __device__ __forceinline__ void operator()(const f32x4 (&acc)[2][2][4][2], const Unit& u, int wr, int wc, int fr, int fq) const {
        const int row0 = u.pm * BM + wr * 64 + fr, col0 = (u.pn & 7) * HALF + wc * 32 + 8 * fq;
#pragma unroll
        for (int ai = 0; ai < 2; ++ai)
#pragma unroll
            for (int m = 0; m < 4; ++m) { float a[8];
#pragma unroll
                for (int n = 0; n < 2; ++n)
#pragma unroll
                    for (int j = 0; j < 4; ++j) { const float g = acc[ai][0][m][n][j], uu = acc[ai][1][m][n][j]; a[n * 4 + j] = g * __builtin_amdgcn_rcpf(1.0f + __expf(-g)) * uu; }
                u32x4 w; w.x = cvt_pk_bf16(a[0], a[1]); w.y = cvt_pk_bf16(a[2], a[3]); w.z = cvt_pk_bf16(a[4], a[5]); w.w = cvt_pk_bf16(a[6], a[7]);
                *(u32x4*)(ACT + (size_t)(row0 + ai * HALF + m * 16) * 1024 + col0) = w; }
    }
};
struct MoeOrder {
    int G, c, ntiles; const PG8_LAS int* toff;
    __device__ __forceinline__ bool next(int i, Unit& u) const {
        int pm, j;
        if (G == 256) { const int x = c & 7, q = c >> 3; pm = (i * 8 + (q >> 2)) * 4 + (x >> 1); j = (x & 1) * 4 + (q & 3); if (pm >= ntiles) return false; }
        else { const int L = i * G + c; if (L >= ntiles * 8) return false; pm = L >> 3; j = L & 7; }
        int e = 0;
#pragma unroll
        for (int k = 1; k < 16; ++k) e += (pm >= toff[k]) ? 1 : 0;
        u.pm = pm; u.pn = __builtin_amdgcn_readfirstlane(e * 8 + j); return true;
    }
    __device__ __forceinline__ void a_ready(const Unit&) const {}
    __device__ __forceinline__ void done(const Unit&) const {}
};
}
#define GAS __attribute__((address_space(1)))
#define LAS __attribute__((address_space(3)))
typedef unsigned short bf16;
typedef unsigned v4u __attribute__((ext_vector_type(4)));
typedef float f32x4 __attribute__((ext_vector_type(4)));
typedef short bf16x8 __attribute__((ext_vector_type(8)));
typedef GAS unsigned gu32;
typedef GAS unsigned long long gu64;
#define RLX_AGENT __ATOMIC_RELAXED, __HIP_MEMORY_SCOPE_AGENT
#define LDS_WAIT() asm volatile("s_waitcnt lgkmcnt(0)" ::: "memory")
#define VM_WAIT() asm volatile("s_waitcnt vmcnt(0)" ::: "memory")
__device__ __forceinline__ unsigned long long rt() { return __builtin_amdgcn_s_memrealtime(); }
__device__ __forceinline__ unsigned f2bf(float f) { unsigned u = __builtin_bit_cast(unsigned, f); return (u + 0x7fffu + ((u >> 16) & 1u)) >> 16; }
__device__ __forceinline__ unsigned pk2(float lo, float hi) { return f2bf(lo) | (f2bf(hi) << 16); }
#define XB_TMO      128
#define XB_XCNT(j)  (256  + 64 * (j))
#define XB_XSUB(j)  (1280 + 64 * (j))
#define XB_XGEN(j)  (2304 + 64 * (j))
#define XB_TOP      3328
#define XB_TOPGEN   3392
#define XCD_BAR_WORDS 3456
#define XB_SPIN_CAP (1u << 18)

__device__ __forceinline__ unsigned xb_ld(unsigned* p)              { return __hip_atomic_load(p, __ATOMIC_RELAXED, __HIP_MEMORY_SCOPE_AGENT); }
__device__ __forceinline__ unsigned xb_add(unsigned* p, unsigned v) { return __hip_atomic_fetch_add(p, v, __ATOMIC_RELAXED, __HIP_MEMORY_SCOPE_AGENT); }
__device__ __forceinline__ unsigned xb_xcc_id() { return (unsigned)__builtin_amdgcn_s_getreg((3 << 11) | 20) & 0xFu; }
#define XB_SPIN(cond, bar) do { unsigned _sp = 0; while (cond) { __builtin_amdgcn_s_sleep(1); \
    if ((++_sp & 255u) == 0u) { if (xb_ld(&(bar)[XB_TMO])) break; if (_sp > XB_SPIN_CAP) { atomicAdd(&(bar)[XB_TMO], 1u); break; } } } } while (0)

struct XcdBarrier {
    unsigned* bar; unsigned x;
    volatile LAS unsigned* st;
};

__device__ __forceinline__ XcdBarrier xcd_barrier_post(unsigned* bar, volatile LAS unsigned* st) {
    XcdBarrier b; b.bar = bar; b.x = xb_xcc_id(); b.st = st;
    if (threadIdx.x == 0) (void)xb_add(&bar[XB_XCNT(b.x)], 1u);
    return b;
}
__device__ __forceinline__ void xcd_barrier_complete(unsigned* bar, unsigned x, unsigned& nloc, unsigned& nx) {
    const unsigned G = gridDim.x * gridDim.y * gridDim.z;
    unsigned sum, cnt, mine, sp = 0u;
    for (;;) {
        sum = 0u; cnt = 0u; mine = 0u;
#pragma unroll
        for (unsigned j = 0; j < 16; ++j) { const unsigned c = xb_ld(&bar[XB_XCNT(j)]); sum += c; cnt += (c > 0u) ? 1u : 0u; mine = (j == x) ? c : mine; }
        if (sum == G) break;
        __builtin_amdgcn_s_sleep(1);
        if ((++sp & 255u) == 0u) { if (xb_ld(&bar[XB_TMO])) break; if (sp > XB_SPIN_CAP) { atomicAdd(&bar[XB_TMO], 1u); break; } }
    }
    nloc = mine > 0u ? mine : 1u; nx = cnt > 0u ? cnt : 1u;
}

__device__ __forceinline__ void xcd_barrier(const XcdBarrier& b) {
    asm volatile("s_waitcnt vmcnt(0)" ::: "memory");
    __syncthreads();
    if (threadIdx.x == 0) {
        unsigned* bar = b.bar;
        __builtin_amdgcn_s_waitcnt(0);
        unsigned nloc = b.st[0], nx = b.st[1];
        if (nloc == 0u) { xcd_barrier_complete(bar, b.x, nloc, nx); b.st[0] = nloc; b.st[1] = nx; }
        const unsigned old = xb_add(&bar[XB_XSUB(b.x)], 1u);
        const unsigned gen = old / nloc;
        if (old + 1u == (gen + 1u) * nloc) {
            __builtin_amdgcn_fence(__ATOMIC_RELEASE, "agent");
            asm volatile("s_waitcnt vmcnt(0)" ::: "memory");
            const unsigned og = xb_add(&bar[XB_TOP], 1u);
            const unsigned tg = og / nx;
            if (og + 1u == (tg + 1u) * nx) xb_add(&bar[XB_TOPGEN], 1u);
            else XB_SPIN(xb_ld(&bar[XB_TOPGEN]) == tg, bar);
            __builtin_amdgcn_fence(__ATOMIC_ACQUIRE, "agent");
            xb_add(&bar[XB_XGEN(b.x)], 1u);
            asm volatile("s_waitcnt vmcnt(0)" ::: "memory");
        } else {
            XB_SPIN(xb_ld(&bar[XB_XGEN(b.x)]) == gen, bar);
            __builtin_amdgcn_fence(__ATOMIC_ACQUIRE, "agent");
            asm volatile("s_waitcnt vmcnt(0)" ::: "memory");
        }
    }
    __syncthreads();
}
constexpr int NWAVES = 8, NTHR = 512;
constexpr int DM = 2048, NBATCH = 2, SEQ = 8192, CTXL = 256;
constexpr int NCTX = NBATCH * CTXL;
constexpr int NLAT = NBATCH * SEQ;
constexpr int NROW = NCTX + NLAT;
constexpr int EVC = 6176, EVN = 6400, ZC0 = 6144;
constexpr int ODC = 4608;
constexpr int NEXP = 16, DFF = 1024;
constexpr int MP_MAX = 37888;
constexpr float EPSN = 1e-6f;
constexpr int FFTN = 16384;

constexpr size_t MiB = 1u << 20;
constexpr size_t WS_CTL = 0, CTL_ZERO_BYTES = 1 * MiB;
constexpr size_t WS_MODP = 1 * MiB;
constexpr size_t WS_MOD = 11 * MiB;
constexpr size_t WS_HDNL = 12 * MiB;
constexpr size_t WS_HDNC = 14 * MiB;
constexpr size_t WS_ROUTE = 15 * MiB;
constexpr size_t WS_LR = 16 * MiB;
constexpr size_t WS_WIN0 = 19 * MiB;
constexpr size_t WS_WOUT0 = 44 * MiB;
constexpr size_t WS_WIN1 = 52 * MiB;
constexpr size_t WS_WOUT1 = 70 * MiB;
constexpr size_t WS_WM13 = 78 * MiB;
constexpr size_t WS_WM2 = 334 * MiB;
constexpr size_t WS_X = 462 * MiB;
constexpr size_t WS_H = 594 * MiB;
constexpr size_t WS_Z = 660 * MiB;
constexpr size_t WS_W = 858 * MiB;
constexpr size_t WS_OF = WS_W, WS_OB = WS_W + 33 * MiB, WS_MIX = WS_W + 66 * MiB;
constexpr size_t WS_ACT = 1006 * MiB;
constexpr size_t WS_W3S = 1088 * MiB;
constexpr size_t WS_HDS = 1090 * MiB;
constexpr size_t WS_QKD = 1094 * MiB;
constexpr size_t WS_END = 1178 * MiB;
constexpr size_t WS_FILT0 = WS_MIX, WS_FILT1 = WS_MIX + 32 * MiB, WS_FILT2 = WS_H + 34 * MiB, WS_FILT3 = WS_ACT + 50 * MiB;
constexpr size_t HYS_BYTES = 196608 + 256;
static_assert(WS_QKD + (size_t)2112 * 41472 <= WS_END, "ws map 4");
static_assert(WS_MODP + (size_t)2 * 32 * 3 * 12288 * 4 <= WS_MOD && WS_LR + (size_t)NROW * 32 * 4 <= WS_WIN0 && WS_WIN0 + (size_t)EVN * DM * 2 <= WS_WOUT0 && WS_WIN1 + (size_t)ODC * DM * 2 <= WS_WOUT1, "ws map 1");
static_assert(WS_X + (size_t)NROW * DM * 4 <= WS_H && WS_H + (size_t)NROW * DM * 2 <= WS_Z && WS_Z + (size_t)NROW * ZC0 * 2 <= WS_W && WS_Z + (size_t)MP_MAX * DM * 2 <= WS_W, "ws map 2");
static_assert(WS_W + (size_t)MP_MAX * DM * 2 <= WS_ACT && WS_MIX + (size_t)NROW * DM * 2 <= WS_ACT && WS_ACT + (size_t)MP_MAX * DFF * 2 <= WS_END && WS_ACT + 256 * HYS_BYTES <= WS_FILT3 && WS_FILT3 + 32 * MiB <= WS_W3S && WS_FILT2 + 32 * MiB <= WS_Z && WS_H + (size_t)1024 * NROW * 2 <= WS_FILT2, "ws map 3");
constexpr int CW_CNT = 8192;
constexpr int CW_HYQ = 256;
constexpr int CW_ATQ = 320;
constexpr int CW_BAR = 4096;

constexpr int RING_BYTES = 139264;
constexpr int LDSCTL_OFF = RING_BYTES;
constexpr int MISC_OFF = LDSCTL_OFF + 320;
constexpr int LDS_BYTES = 147456;
namespace pg8 {
struct EpiFilt {
    static constexpr bool PERM = false, AFTER_DRAIN = false;
    unsigned char* base;
    __device__ __forceinline__ void operator()(const f32x4 (&acc)[2][2][4][2], const Unit& u, int wr, int wc, int fr, int fq) const {
        const int q = u.pm >> 2; size_t off = WS_FILT0; if (q == 1) off = WS_FILT1; if (q == 2) off = WS_FILT2; if (q == 3) off = WS_FILT3;
        float* C = (float*)(base + off);
        const int row0 = (u.pm & 3) * BM + wr * 64 + fr, col0 = u.pn * BM + wc * 32 + 4 * fq;
#pragma unroll
        for (int ai = 0; ai < 2; ++ai)
#pragma unroll
            for (int m = 0; m < 4; ++m) { float* rowp = C + (size_t)(row0 + ai * HALF + m * 16) * 8192 + col0;
#pragma unroll
                for (int bj = 0; bj < 2; ++bj)
#pragma unroll
                    for (int n = 0; n < 2; ++n) *(f32x4*)(rowp + bj * HALF + n * 16) = acc[ai][bj][m][n]; }
    }
};
}
constexpr int TOFF_OFF = LDSCTL_OFF + 512;
typedef float f32x2v __attribute__((ext_vector_type(2)));
typedef unsigned v2u __attribute__((ext_vector_type(2)));
typedef short bf16x4 __attribute__((ext_vector_type(4)));

struct Args { const float* in[32]; float* out; unsigned char* ws; int ph_lo, ph_hi; };

struct Frame {
    LAS unsigned char* lds;
    int G, bx, NGW;
    const float* const __attribute__((address_space(4)))* in;
    float* out; unsigned char* ws;
};

__device__ __forceinline__ float bf2f(unsigned h) { return __uint_as_float(h << 16); }
__device__ __forceinline__ float bflo(unsigned w) { return __uint_as_float(w << 16); }
__device__ __forceinline__ float bfhi(unsigned w) { return __uint_as_float(w & 0xffff0000u); }
__device__ __forceinline__ float wave_sum(float v) {
#pragma unroll
    for (int o = 1; o < 64; o <<= 1) v += __shfl_xor(v, o);
    return v;
}
__device__ __forceinline__ float wave_max(float v) {
#pragma unroll
    for (int o = 1; o < 64; o <<= 1) v = fmaxf(v, __shfl_xor(v, o));
    return v;
}
__device__ __forceinline__ float silu_f(float x) { return x / (1.0f + __expf(-x)); }
__device__ __forceinline__ f32x4 mfma_bf16(bf16x8 a, bf16x8 b, f32x4 c) { return __builtin_amdgcn_mfma_f32_16x16x32_bf16(a, b, c, 0, 0, 0); }
__device__ __forceinline__ int row_cls(int row) { return row < NCTX ? 2 : ((row - NCTX) >> 13); }
#define PHASE_LOCALS int tid = threadIdx.x; asm volatile("" : "+v"(tid)); const int lane = tid & 63, wave = __builtin_amdgcn_readfirstlane(tid >> 6), gw = F.bx * NWAVES + wave; (void)lane; (void)wave; (void)gw;
template <int N> __device__ __forceinline__ float row_shr(float v) { return __builtin_bit_cast(float, __builtin_amdgcn_update_dpp(0, __builtin_bit_cast(int, v), 0x110 + N, 0xF, 0xF, true)); }
template <int N> __device__ __forceinline__ float row_ror(float v) { return __builtin_bit_cast(float, __builtin_amdgcn_update_dpp(0, __builtin_bit_cast(int, v), 0x120 + N, 0xF, 0xF, false)); }
typedef __bf16 bf16x2n __attribute__((ext_vector_type(2)));
__device__ __forceinline__ unsigned cvt_pk(float lo, float hi) { const f32x2v v = {lo, hi}; return __builtin_bit_cast(unsigned, __builtin_convertvector(v, bf16x2n)); }
#define LDS_BARRIER() do { asm volatile("s_waitcnt lgkmcnt(0)" ::: "memory"); __builtin_amdgcn_s_barrier(); asm volatile("" ::: "memory"); } while (0)
__device__ __forceinline__ void tr_item(const float* W, int N, int ncols, bf16* WT, int K, int k0, int n0, int drow0, int drow1, LAS float* scr, int lane) {
    const int cc = 4 * (lane & 15);
    f32x4 v[16];
#pragma unroll
    for (int i = 0; i < 16; ++i) {
        const int r = 4 * i + (lane >> 4);
        v[i] = (f32x4){0.f, 0.f, 0.f, 0.f};
        if (cc < ncols) v[i] = *(const f32x4*)(W + (size_t)(k0 + r) * N + n0 + cc);
    }
#pragma unroll
    for (int i = 0; i < 16; ++i) { const int r = 4 * i + (lane >> 4); LAS float* s = scr + r * 65 + cc; s[0] = v[i][0]; s[1] = v[i][1]; s[2] = v[i][2]; s[3] = v[i][3]; }
    LDS_WAIT();
    const int c = lane & 7;
#pragma unroll
    for (int j = 0; j < 8; ++j) {
        const int n = (lane >> 3) + 8 * j;
        if (n < ncols) {
            const LAS float* s = scr + (8 * c) * 65 + n;
            v4u o; o.x = cvt_pk(s[0], s[65]); o.y = cvt_pk(s[2 * 65], s[3 * 65]); o.z = cvt_pk(s[4 * 65], s[5 * 65]); o.w = cvt_pk(s[6 * 65], s[7 * 65]);
            const int drow = n < 32 ? drow0 + n : drow1 + (n - 32);
            *(v4u*)(WT + (size_t)drow * K + k0 + 8 * c) = o;
        }
    }
    LDS_WAIT();
}
__device__ __forceinline__ int map_evin(int c0) { return c0 < 3072 ? c0 : (c0 < 3104 ? 6144 + (c0 - 3072) : c0 - 32); }

__device__ __forceinline__ void tr_moe_item(Frame& F, int layer, int r, LAS float* scr, int lane) {
    bf16* wm13 = (bf16*)(F.ws + WS_WM13) + (size_t)layer * 16 * 2048 * DM; bf16* wm2 = (bf16*)(F.ws + WS_WM2) + (size_t)layer * 16 * 2048 * DFF;
    if (r < 16384) {
        const int which = r >= 8192 ? 1 : 0; if (which) r -= 8192;
        const int e = r / 512, q = r % 512, kb = q / 16, nb = q % 16, n0 = nb * 64, le = layer * 16 + e;
        const float* W = (which ? F.in[30] : F.in[29]) + (size_t)le * DM * DFF;
        const int d0 = e * 2048 + (n0 >> 7) * 256 + which * 128 + (n0 & 127);
        tr_item(W, DFF, 64, wm13, DM, kb * 64, n0, d0, d0 + 32, scr, lane);
    } else {
        r -= 16384;
        const int e = r / 512, q = r % 512, kb = q / 32, nb = q % 32, n0 = nb * 64, le = layer * 16 + e;
        const float* W = F.in[31] + (size_t)le * DFF * DM;
        tr_item(W, DM, 64, wm2, DFF, kb * 64, n0, e * 2048 + n0, e * 2048 + n0 + 32, scr, lane);
    }
}
struct TrDesc { const float* src; bf16* dst; int N, K; };
__device__ __forceinline__ TrDesc moe_desc(Frame& F, int layer, int r) {
    TrDesc d;
    if (r < 16384) {
        const int which = r >= 8192 ? 1 : 0; if (which) r -= 8192;
        const int e = r / 512, q = r % 512, kb = q % 32, nb = q / 32, n0 = nb * 64, le = layer * 16 + e;
        const float* W = (which ? F.in[30] : F.in[29]) + (size_t)le * DM * DFF;
        const int d0 = e * 2048 + (n0 >> 7) * 256 + which * 128 + (n0 & 127);
        d.src = W + (size_t)(kb * 64) * DFF + n0; d.N = DFF; d.K = DM;
        d.dst = (bf16*)(F.ws + WS_WM13) + (size_t)layer * 16 * 2048 * DM + (size_t)d0 * DM + kb * 64;
    } else {
        r -= 16384;
        const int e = r / 512, q = r % 512, kb = q % 16, nb = q / 16, n0 = nb * 64, le = layer * 16 + e;
        const float* W = F.in[31] + (size_t)le * DFF * DM;
        d.src = W + (size_t)(kb * 64) * DM + n0; d.N = DM; d.K = DFF;
        d.dst = (bf16*)(F.ws + WS_WM2) + (size_t)layer * 16 * 2048 * DFF + (size_t)(e * 2048 + n0) * DFF + kb * 64;
    }
    return d;
}
__device__ __forceinline__ void tr_load(const TrDesc& d, int lane, f32x4 (&v)[16]) {
#pragma unroll
    for (int i = 0; i < 16; ++i) v[i] = *(const f32x4*)(d.src + (size_t)(4 * i + (lane >> 4)) * d.N + 4 * (lane & 15));
}
__device__ __forceinline__ void tr_commit(const TrDesc& d, const f32x4 (&v)[16], LAS float* scr, int lane) {
    const int cc = 4 * (lane & 15);
#pragma unroll
    for (int i = 0; i < 16; ++i) { const int r = 4 * i + (lane >> 4); LAS float* s = scr + r * 65 + cc; s[0] = v[i][0]; s[1] = v[i][1]; s[2] = v[i][2]; s[3] = v[i][3]; }
    LDS_WAIT();
    const int c = lane & 7;
#pragma unroll
    for (int j = 0; j < 8; ++j) {
        const int n = (lane >> 3) + 8 * j;
        const LAS float* s = scr + (8 * c) * 65 + n;
        v4u o; o.x = cvt_pk(s[0], s[65]); o.y = cvt_pk(s[2 * 65], s[3 * 65]); o.z = cvt_pk(s[4 * 65], s[5 * 65]); o.w = cvt_pk(s[6 * 65], s[7 * 65]);
        *(v4u*)(d.dst + (size_t)n * d.K + 8 * c) = o;
    }
    LDS_WAIT();
}
template <int NI>
__device__ __forceinline__ void conv_unit(Frame& F, int layer, int cu) {
    PHASE_LOCALS
    LAS float* scr = (LAS float*)(F.lds) + wave * (64 * 65);
    __syncthreads();
    const int r0 = cu * (8 * NI) + wave * NI;
    f32x4 va[16], vb[16];
    TrDesc da = moe_desc(F, layer, r0), db = da;
    tr_load(da, lane, va);
#pragma unroll
    for (int i = 0; i < NI; i += 2) {
        db = moe_desc(F, layer, r0 + i + 1); tr_load(db, lane, vb);
        tr_commit(da, va, scr, lane);
        if (i + 2 < NI) { da = moe_desc(F, layer, r0 + i + 2); tr_load(da, lane, va); }
        tr_commit(db, vb, scr, lane);
    }
    __syncthreads();
}

__device__ __forceinline__ void phase_pre(Frame& F) {
    PHASE_LOCALS
    {
        LAS float* sv = (LAS float*)F.lds;
        const float* cvec = F.in[1]; const float* cctx = F.in[3]; const float* adaw = F.in[4];
        float* modp = (float*)(F.ws + WS_ACT);
        for (int u = F.bx; u < 768; u += F.G) {
            const int layer = u / 384, r = u % 384, kc = r / 6, cb = r % 6, k0 = kc * 32;
            __syncthreads();
            if (tid < 96) { const int v = tid >> 5, k = tid & 31; const float c = v < 2 ? cvec[v * DM + k0 + k] : cctx[k0 + k]; sv[tid] = silu_f(c); }
            __syncthreads();
            const int col0 = cb * 2048 + tid * 4;
            const float* wp = adaw + ((size_t)layer * DM + k0) * 12288 + col0;
            f32x4 a0 = {0.f, 0.f, 0.f, 0.f}, a1 = a0, a2 = a0;
#pragma unroll 8
            for (int k = 0; k < 32; ++k) { const f32x4 w = *(const f32x4*)(wp + (size_t)k * 12288); a0 += w * sv[k]; a1 += w * sv[32 + k]; a2 += w * sv[64 + k]; }
            float* op = modp + ((size_t)(layer * 64 + kc) * 3) * 12288 + col0;
            *(f32x4*)op = a0; *(f32x4*)(op + 12288) = a1; *(f32x4*)(op + 2 * 12288) = a2;
        }
        __syncthreads();
    }
    {
        const float* w1 = F.in[15]; const float* b1 = F.in[16]; const float* w2 = F.in[17]; const float* b2 = F.in[18];
        float* hdn = (float*)(F.ws + WS_HDNL);
        for (int rr = gw; rr < 8192 + 256; rr += F.NGW) {
            const int L = rr < 8192 ? 8192 : 256, l = rr < 8192 ? rr : rr - 8192;
            const float t = (float)l / (float)(L - 1);
            const float w = (float)(2.0 * 3.14159265358979323846 / (double)L) * (float)l;
            float h1 = b1[lane] + t * w1[lane];
            const float band = 1e-4f + (float)(lane & 15) * ((15.0f - 1e-4f) / 15.0f);
            float sn, cs; sincosf(band * w, &sn, &cs);
#pragma unroll
            for (int i = 0; i < 16; ++i) h1 += __shfl(cs, i) * w1[(1 + i) * 64 + lane] - __shfl(sn, i) * w1[(17 + i) * 64 + lane];
            h1 = sinf(h1);
            float h2 = b2[lane];
#pragma unroll 8
            for (int i = 0; i < 64; ++i) h2 += __shfl(h1, i) * w2[i * 64 + lane];
            const float hv = sinf(h2);
            hdn[(size_t)rr * 64 + lane] = hv;
            if (rr < 8192) {
                bf16* hs = (bf16*)(F.ws + WS_HDS) + (size_t)rr * 256;
                const unsigned hi = f2bf(hv), lo = f2bf(hv - bf2f(hi));
                hs[lane] = (bf16)hi; hs[64 + lane] = (bf16)lo; hs[128 + lane] = (bf16)hi; hs[192 + lane] = (bf16)0;
            }
        }
        const float* w3 = F.in[19]; bf16* w3s = (bf16*)(F.ws + WS_W3S);
        for (int r = gw; r < 4096; r += F.NGW) {
            const float wv = w3[(size_t)lane * 4096 + r];
            const unsigned hi = f2bf(wv), lo = f2bf(wv - bf2f(hi));
            bf16* o = w3s + (size_t)r * 256;
            o[lane] = (bf16)hi; o[64 + lane] = (bf16)hi; o[128 + lane] = (bf16)lo; o[192 + lane] = (bf16)0;
        }
    }
    {
        LAS float* scr = (LAS float*)(F.lds) + wave * (64 * 65);
        bf16* win0 = (bf16*)(F.ws + WS_WIN0); bf16* wout0 = (bf16*)(F.ws + WS_WOUT0); bf16* win1 = (bf16*)(F.ws + WS_WIN1); bf16* wout1 = (bf16*)(F.ws + WS_WOUT1);
        constexpr int I0 = 32 * 97, I1 = 32 * 32, I2 = 32 * 72, I3 = 32 * 32;
        constexpr int NITEMS = I0 + I1 + I2 + I3;
        for (int it = gw; it < NITEMS; it += F.NGW) {
            int r = it;
            if (r < I0) { const int kb = r / 97, nb = r % 97, n0 = nb * 64; tr_item(F.in[8], EVC, nb == 96 ? 32 : 64, win0, DM, kb * 64, n0, map_evin(n0), map_evin(n0 + 32), scr, lane); continue; } r -= I0;
            if (r < I1) { const int kb = r / 32, nb = r % 32, n0 = nb * 64; tr_item(F.in[9], DM, 64, wout0, DM, kb * 64, n0, n0, n0 + 32, scr, lane); continue; } r -= I1;
            if (r < I2) { const int kb = r / 72, nb = r % 72, n0 = nb * 64; tr_item(F.in[21], ODC, 64, win1, DM, kb * 64, n0, n0, n0 + 32, scr, lane); continue; } r -= I2;
            { const int kb = r / 32, nb = r % 32, n0 = nb * 64; tr_item(F.in[22], DM, 64, wout1, DM, kb * 64, n0, n0, n0 + 32, scr, lane); }
        }
        if (F.G != 256) for (int it = gw; it < 24576; it += F.NGW) tr_moe_item(F, 0, it, scr, lane);
    }
}
__device__ __forceinline__ void phase_modfin(Frame& F) {
    PHASE_LOCALS
    const float* adab = F.in[5]; const float* modp = (const float*)(F.ws + WS_ACT); float* mod = (float*)(F.ws + WS_MOD);
    for (int idx = F.bx * NTHR + tid; idx < 2 * 3 * 12288; idx += F.G * NTHR) {
        const int layer = idx / 36864, rem = idx % 36864, v = rem / 12288, col = rem % 12288;
        float s = adab[layer * 12288 + col];
        for (int kc = 0; kc < 64; ++kc) s += modp[((size_t)(layer * 64 + kc) * 3 + v) * 12288 + col];
        mod[idx] = s;
    }
}
template <int MODE>
__device__ __forceinline__ void phase_norm(Frame& F, int layer) {
    PHASE_LOCALS
    float* X = (float*)(F.ws + WS_X); bf16* H = (bf16*)(F.ws + WS_H);
    const float* mod = (const float*)(F.ws + WS_MOD); const bf16* yperm = (const bf16*)(F.ws + WS_W);
    const unsigned* route = (const unsigned*)(F.ws + WS_ROUTE);
    const float* gain = F.in[6] + layer * DM;
    const int r_begin = MODE == 2 ? NCTX : 0;
    v4u rt_next = {0u, 0u, 0u, 0u};
    if (MODE != 0 && r_begin + gw < NROW) rt_next = *(const v4u*)(route + (size_t)(r_begin + gw) * 8 + 4);
    for (int row = r_begin + gw; row < NROW; row += F.NGW) {
        const int cls = row_cls(row);
        const v4u rt = rt_next;
        if (MODE != 0 && row + F.NGW < NROW) rt_next = *(const v4u*)(route + (size_t)(row + F.NGW) * 8 + 4);
        f32x4 v[8];
        if (MODE == 0) {
            const float* src = row < NCTX ? F.in[2] + (size_t)row * DM : F.in[0] + (size_t)(row - NCTX) * DM;
#pragma unroll
            for (int j = 0; j < 8; ++j) v[j] = *(const f32x4*)(src + 256 * j + 4 * lane);
        } else {
            const float* src = X + (size_t)row * DM;
            const float w0 = __uint_as_float(rt.x), w1 = __uint_as_float(rt.y);
            const bf16* y0 = yperm + (size_t)rt.z * DM; const bf16* y1 = yperm + (size_t)rt.w * DM;
            const float* g2 = mod + (size_t)((layer - (MODE == 1 ? 1 : 0)) * 3 + cls) * 12288 + 5 * DM;
#pragma unroll
            for (int j = 0; j < 8; ++j) {
                const int e = 256 * j + 4 * lane;
                const f32x4 x = *(const f32x4*)(src + e), g = *(const f32x4*)(g2 + e);
                const v2u a = *(const v2u*)(y0 + e), b = *(const v2u*)(y1 + e);
                f32x4 y; y[0] = w0 * bflo(a.x) + w1 * bflo(b.x); y[1] = w0 * bfhi(a.x) + w1 * bfhi(b.x); y[2] = w0 * bflo(a.y) + w1 * bflo(b.y); y[3] = w0 * bfhi(a.y) + w1 * bfhi(b.y);
                v[j] = x + g * y;
            }
        }
        if (MODE == 2) {
            float* o = F.out + (size_t)(row - NCTX) * DM;
#pragma unroll
            for (int j = 0; j < 8; ++j) *(f32x4*)(o + 256 * j + 4 * lane) = v[j];
        } else {
            float* xo = X + (size_t)row * DM; float ss = 0.f;
#pragma unroll
            for (int j = 0; j < 8; ++j) { if (MODE != 0) *(f32x4*)(xo + 256 * j + 4 * lane) = v[j]; ss += v[j][0] * v[j][0] + v[j][1] * v[j][1] + v[j][2] * v[j][2] + v[j][3] * v[j][3]; }
            const float rstd = rsqrtf(wave_sum(ss) * (1.0f / DM) + EPSN);
            const float* mrow = mod + (size_t)(layer * 3 + cls) * 12288;
            bf16* ho = H + (size_t)row * DM;
#pragma unroll
            for (int j = 0; j < 8; ++j) {
                const int e = 256 * j + 4 * lane;
                const f32x4 gn = *(const f32x4*)(gain + e), sh = *(const f32x4*)(mrow + e), sc = *(const f32x4*)(mrow + DM + e);
                const f32x4 h = v[j] * rstd * gn * (sc + 1.0f) + sh;
                v2u o; o.x = pk2(h[0], h[1]); o.y = pk2(h[2], h[3]); *(v2u*)(ho + e) = o;
            }
        }
    }
}
constexpr size_t WS_RWT = WS_HDNC + 128 * 1024, WS_RB = WS_HDNC + 64 * 1024;
__device__ __forceinline__ void route_fold(Frame& F) {
    PHASE_LOCALS
    const float* mod = (const float*)(F.ws + WS_MOD); const float* rw = F.in[27];
    float* rwt = (float*)(F.ws + WS_RWT); float* rbv = (float*)(F.ws + WS_RB);
    for (int idx = F.bx * NTHR + tid; idx < 2 * 3 * 16 * DM; idx += F.G * NTHR) {
        const int d = idx & (DM - 1), e = (idx >> 11) & 15, lc = idx >> 15;
        const int layer = lc / 3;
        rwt[idx] = F.in[7][layer * DM + d] * (1.0f + mod[(size_t)lc * 12288 + 4 * DM + d]) * rw[d * 16 + e];
    }
    if (gw < 96) {
        const int e = gw & 15, lc = gw >> 4; float s = 0.f;
        for (int d = lane; d < DM; d += 64) s += mod[(size_t)lc * 12288 + 3 * DM + d] * rw[d * 16 + e];
        s = wave_sum(s); if (lane == 0) rbv[gw] = s;
    }
}
template <int J> __device__ __forceinline__ float quad_bcast(float v) { return __builtin_bit_cast(float, __builtin_amdgcn_update_dpp(0, __builtin_bit_cast(int, v), J * 0x55, 0xF, 0xF, false)); }
__device__ __forceinline__ float row_sum16(float v) { v += row_ror<8>(v); v += row_ror<4>(v); v += row_ror<2>(v); v += row_ror<1>(v); return v; }
__device__ __forceinline__ float row_max16(float v) { v = fmaxf(v, row_ror<8>(v)); v = fmaxf(v, row_ror<4>(v)); v = fmaxf(v, row_ror<2>(v)); v = fmaxf(v, row_ror<1>(v)); return v; }
__device__ __forceinline__ void phase_route(Frame& F, int layer, int rep = 0) {
    PHASE_LOCALS
    const float* X = (const float*)(F.ws + WS_X); bf16* H = (bf16*)(F.ws + WS_H);
    const float* mod = (const float*)(F.ws + WS_MOD);
    unsigned* route = (unsigned*)(F.ws + WS_ROUTE) + (rep ? 8 * NROW : 0);
    unsigned* cnt = (unsigned*)(F.ws + WS_CTL) + CW_CNT + 64 * 16 * (2 * layer + rep);
    const float* gain = F.in[7] + layer * DM; const float* rb = F.in[28];
    constexpr int XS = DM + 4;
    LAS float* XT = (LAS float*)F.lds;
    LAS float* RSTD = (LAS float*)(F.lds + LDSCTL_OFF + 1024);
    LAS unsigned* lcnt = (LAS unsigned*)(F.lds + LDSCTL_OFF + 768);
    static_assert(16 * XS * 4 <= RING_BYTES, "route LDS map");
    __syncthreads();
    if (tid < 32) lcnt[tid] = 0u;
    const int r_begin = layer == 0 ? 0 : NCTX, ntile = (NROW - r_begin) / 16;
    const int m = lane & 15, kq = lane >> 4;
    for (int tl = F.bx; tl < ntile; tl += F.G) {
        const int row0 = r_begin + 16 * tl, cls = row_cls(row0);
        const float* mrow = mod + (size_t)(layer * 3 + cls) * 12288 + 3 * DM;
        __syncthreads();
#pragma unroll
        for (int rr = 0; rr < 2; ++rr) {
            const int mr = 2 * wave + rr, row = row0 + mr;
            const float* src = X + (size_t)row * DM;
            f32x4 v[8]; float ss = 0.f;
#pragma unroll
            for (int j = 0; j < 8; ++j) { v[j] = *(const f32x4*)(src + 256 * j + 4 * lane); ss += v[j][0] * v[j][0] + v[j][1] * v[j][1] + v[j][2] * v[j][2] + v[j][3] * v[j][3]; }
#pragma unroll
            for (int j = 0; j < 8; ++j) *(LAS f32x4*)(XT + mr * XS + 256 * j + 4 * lane) = v[j];
            const float rstd = rsqrtf(wave_sum(ss) * (1.0f / DM) + EPSN);
            if (lane == 0) RSTD[mr] = rstd;
            bf16* ho = H + (size_t)row * DM;
#pragma unroll
            for (int j = 0; j < 8; ++j) {
                const int e = 256 * j + 4 * lane;
                const f32x4 gn = *(const f32x4*)(gain + e), sh = *(const f32x4*)(mrow + e), sc = *(const f32x4*)(mrow + DM + e);
                const f32x4 h = v[j] * rstd * gn * (sc + 1.0f) + sh;
                v2u o; o.x = cvt_pk(h[0], h[1]); o.y = cvt_pk(h[2], h[3]); *(v2u*)(ho + e) = o;
            }
        }
        __syncthreads();
        const float* rwt = (const float*)(F.ws + WS_RWT) + (size_t)(layer * 3 + cls) * 16 * DM + (size_t)m * DM + 256 * wave + 4 * kq;
        const LAS float* xa = XT + m * XS + 256 * wave + 4 * kq;
        f32x4 acc0 = {0.f, 0.f, 0.f, 0.f}, acc1 = acc0;
#pragma unroll 4
        for (int j = 0; j < 16; ++j) {
            const f32x4 a4 = *(const LAS f32x4*)(xa + 16 * j), b4 = *(const f32x4*)(rwt + 16 * j);
            acc0 = __builtin_amdgcn_mfma_f32_16x16x4f32(a4[0], b4[0], acc0, 0, 0, 0); acc1 = __builtin_amdgcn_mfma_f32_16x16x4f32(a4[1], b4[1], acc1, 0, 0, 0);
            acc0 = __builtin_amdgcn_mfma_f32_16x16x4f32(a4[2], b4[2], acc0, 0, 0, 0); acc1 = __builtin_amdgcn_mfma_f32_16x16x4f32(a4[3], b4[3], acc1, 0, 0, 0);
        }
        acc0 += acc1;
        __syncthreads();
        LAS float* PART = XT;
#pragma unroll
        for (int i = 0; i < 4; ++i) PART[wave * 256 + (4 * kq + i) * 16 + m] = acc0[i];
        __syncthreads();
        if (tid < 256) {
            const int mr = tid >> 4, e = tid & 15, row = row0 + mr;
            float s = 0.f;
#pragma unroll
            for (int w8 = 0; w8 < 8; ++w8) s += PART[w8 * 256 + mr * 16 + e];
            const float logit = RSTD[mr] * s + ((const float*)(F.ws + WS_RB))[(layer * 3 + cls) * 16 + e];
            const float mx = row_max16(logit), ex = expf(logit - mx), score = ex / row_sum16(ex), sel = score + rb[e];
            const float q0 = quad_bcast<0>(sel), q1 = quad_bcast<1>(sel), q2 = quad_bcast<2>(sel), q3 = quad_bcast<3>(sel);
            const float hi1 = fmaxf(q0, q1), lo1 = fminf(q0, q1), hi2 = fmaxf(q2, q3), lo2 = fminf(q2, q3);
            const float gs = fmaxf(hi1, hi2) + fmaxf(fminf(hi1, hi2), fmaxf(lo1, lo2));
            const int G = e >> 2, jq = e & 3;
            const float Gf = (float)G;
            const float g1 = row_ror<4>(gs), g2 = row_ror<8>(gs), g3 = row_ror<12>(gs);
            const float G1 = row_ror<4>(Gf), G2 = row_ror<8>(Gf), G3 = row_ror<12>(Gf);
            const bool in_best = (gs > g1 || (gs == g1 && Gf < G1)) && (gs > g2 || (gs == g2 && Gf < G2)) && (gs > g3 || (gs == g3 && Gf < G3));
            const int rank = ((q0 > sel || (q0 == sel && 0 < jq)) ? 1 : 0) + ((q1 > sel || (q1 == sel && 1 < jq)) ? 1 : 0) + ((q2 > sel || (q2 == sel && 2 < jq)) ? 1 : 0) + ((q3 > sel || (q3 == sel && 3 < jq)) ? 1 : 0);
            const bool is0 = in_best && rank == 0, is1 = in_best && rank == 1;
            const float e0f = row_sum16(is0 ? (float)e : 0.f), e1f = row_sum16(is1 ? (float)e : 0.f);
            float w0 = row_sum16(is0 ? score : 0.f), w1 = row_sum16(is1 ? score : 0.f);
            const float wsn = 1.0f / (w0 + w1); w0 *= wsn; w1 *= wsn;
            if (e == 0) {
                const int e0 = (int)e0f, e1 = (int)e1f;
                const unsigned r0 = __hip_atomic_fetch_add(lcnt + e0, 1u, __ATOMIC_RELAXED, __HIP_MEMORY_SCOPE_WORKGROUP);
                const unsigned r1 = __hip_atomic_fetch_add(lcnt + e1, 1u, __ATOMIC_RELAXED, __HIP_MEMORY_SCOPE_WORKGROUP);
                v4u a; a.x = (unsigned)e0; a.y = (unsigned)e1; a.z = r0; a.w = r1;
                v4u b; b.x = __float_as_uint(w0); b.y = __float_as_uint(w1); b.z = 0u; b.w = 0u;
                *(v4u*)(route + (size_t)row * 8) = a; *(v4u*)(route + (size_t)row * 8 + 4) = b;
            }
        }
    }
    __syncthreads();
    if (tid < 16) { const unsigned n = lcnt[tid]; lcnt[16 + tid] = n ? __hip_atomic_fetch_add(cnt + 64 * tid, n, __ATOMIC_RELAXED, __HIP_MEMORY_SCOPE_AGENT) : 0u; }
    __syncthreads();
    for (int tl = F.bx; tl < ntile; tl += F.G)
        if (tid < 16) {
            const int row = r_begin + 16 * tl + tid;
            v4u a = *(const v4u*)(route + (size_t)row * 8);
            a.z += lcnt[16 + a.x]; a.w += lcnt[16 + a.y];
            *(v4u*)(route + (size_t)row * 8) = a;
        }
    __syncthreads();
}
__device__ __forceinline__ void moe_offsets(Frame& F, int layer) {
    PHASE_LOCALS
    LAS int* toff = (LAS int*)(F.lds + TOFF_OFF);
    __syncthreads();
    if (tid == 0) {
        const unsigned* cnt = (const unsigned*)(F.ws + WS_CTL) + CW_CNT + 64 * 16 * (2 * layer); int acc = 0;
        for (int e = 0; e < 16; ++e) { toff[e] = acc; acc += (int)((__hip_atomic_load(cnt + 64 * e, __ATOMIC_RELAXED, __HIP_MEMORY_SCOPE_AGENT) + 255u) >> 8); }
        toff[16] = acc;
    }
    __syncthreads();
}
__device__ __forceinline__ void phase_gather(Frame& F, int layer) {
    PHASE_LOCALS
    moe_offsets(F, layer);
    const LAS int* toff = (const LAS int*)(F.lds + TOFF_OFF);
    const bf16* H = (const bf16*)(F.ws + WS_H); bf16* hperm = (bf16*)(F.ws + WS_Z);
    unsigned* route = (unsigned*)(F.ws + WS_ROUTE);
    const int r_begin = layer == 0 ? 0 : NCTX;
    v4u a_next = {0u, 0u, 0u, 0u};
    if (r_begin + gw < NROW) a_next = *(const v4u*)(route + (size_t)(r_begin + gw) * 8);
    for (int row = r_begin + gw; row < NROW; row += F.NGW) {
        const v4u a = a_next;
        if (row + F.NGW < NROW) a_next = *(const v4u*)(route + (size_t)(row + F.NGW) * 8);
        const unsigned p0 = (unsigned)toff[a.x] * 256u + a.z, p1 = (unsigned)toff[a.y] * 256u + a.w;
        const v4u* src = (const v4u*)(H + (size_t)row * DM); v4u* d0 = (v4u*)(hperm + (size_t)p0 * DM); v4u* d1 = (v4u*)(hperm + (size_t)p1 * DM);
#pragma unroll
        for (int j = 0; j < 4; ++j) { const v4u x = src[64 * j + lane]; d0[64 * j + lane] = x; d1[64 * j + lane] = x; }
        if (lane == 0) { v2u pp; pp.x = p0; pp.y = p1; *(v2u*)(route + (size_t)row * 8 + 6) = pp; }
    }
}
__device__ __forceinline__ void phase_ht(Frame& F) {
    PHASE_LOCALS
    const bf16* Z = (const bf16*)(F.ws + WS_Z); bf16* UT = (bf16*)F.out;
    const float* cw = F.in[13]; const float* cb = F.in[14];
    constexpr int NCB = 3072 / 64, NRB = NROW / 64;
    for (int it = gw; it < NCB * NRB; it += F.NGW) {
        const int cblk = it % NCB, rblk = it / NCB, ch = cblk * 64 + lane, r0 = rblk * 64;
        const float w0 = cw[ch], w1 = cw[3072 + ch], w2 = cw[2 * 3072 + ch], bb = cb[ch];
        const bool first = (r0 < NCTX) ? ((r0 & 255) == 0) : (((r0 - NCTX) & 8191) == 0);
        const bool last = (r0 < NCTX) ? (((r0 + 64) & 255) == 0) : (((r0 + 64 - NCTX) & 8191) == 0);
        const bf16* zp = Z + (size_t)r0 * ZC0 + 3072 + ch;
        unsigned short x[66];
        x[0] = first ? (unsigned short)0 : zp[-(ptrdiff_t)ZC0];
#pragma unroll
        for (int r = 0; r < 64; ++r) x[1 + r] = zp[(size_t)r * ZC0];
        x[65] = last ? (unsigned short)0 : zp[(size_t)64 * ZC0];
        LAS unsigned short* tl = (LAS unsigned short*)F.lds + wave * (64 * 72);
#pragma unroll
        for (int g8 = 0; g8 < 8; ++g8) {
            float o[8];
#pragma unroll
            for (int q = 0; q < 8; ++q) { const int r = g8 * 8 + q; o[q] = w0 * bf2f(x[r]) + w1 * bf2f(x[r + 1]) + w2 * bf2f(x[r + 2]) + bb; }
            v4u w; w.x = cvt_pk(o[0], o[1]); w.y = cvt_pk(o[2], o[3]); w.z = cvt_pk(o[4], o[5]); w.w = cvt_pk(o[6], o[7]);
            *(LAS v4u*)(tl + lane * 72 + g8 * 8) = w;
        }
        LDS_WAIT();
#pragma unroll
        for (int i = 0; i < 8; ++i) { const int cch = i * 8 + (lane >> 3), pc = lane & 7;
            *(v4u*)(UT + (size_t)(cblk * 64 + cch) * NROW + r0 + pc * 8) = *(const LAS v4u*)(tl + cch * 72 + pc * 8); }
        LDS_WAIT();
    }
}
__device__ __forceinline__ void merge_heads(Frame& F, const float* gain, int ldz, int r_begin) {
    PHASE_LOCALS
    const bf16* OF = (const bf16*)(F.ws + WS_OF); const bf16* OB = (const bf16*)(F.ws + WS_OB); const bf16* Z = (const bf16*)(F.ws + WS_Z);
    bf16* MIX = (bf16*)(F.ws + WS_MIX);
    const f32x4 gn = *(const f32x4*)(gain + 4 * lane);
    for (int row = r_begin + gw; row < NROW; row += F.NGW) {
#pragma unroll
        for (int h = 0; h < 4; ++h) {
            const size_t off = (size_t)row * 1024 + h * 256 + 4 * lane;
            const v2u a = *(const v2u*)(OF + off), b = *(const v2u*)(OB + off), g = *(const v2u*)(Z + (size_t)row * ldz + 2048 + h * 256 + 4 * lane);
            f32x4 o; o[0] = bflo(a.x) + bflo(b.x); o[1] = bfhi(a.x) + bfhi(b.x); o[2] = bflo(a.y) + bflo(b.y); o[3] = bfhi(a.y) + bfhi(b.y);
            const float ss = wave_sum(o[0] * o[0] + o[1] * o[1] + o[2] * o[2] + o[3] * o[3]);
            const float rstd = rsqrtf(ss * (1.0f / 256.0f) + EPSN);
            f32x4 gg; gg[0] = silu_f(bflo(g.x)); gg[1] = silu_f(bfhi(g.x)); gg[2] = silu_f(bflo(g.y)); gg[3] = silu_f(bfhi(g.y));
            const f32x4 r = o * rstd * gn * gg;
            v2u w; w.x = pk2(r[0], r[1]); w.y = pk2(r[2], r[3]);
            *(v2u*)(MIX + (size_t)row * DM + h * 256 + 4 * lane) = w;
        }
    }
}
__device__ __forceinline__ void merge_hyena(Frame& F) {
    PHASE_LOCALS
    const bf16* HYO = (const bf16*)(F.ws + WS_H); bf16* MIX = (bf16*)(F.ws + WS_MIX);
    LAS unsigned short* tl = (LAS unsigned short*)F.lds + wave * (64 * 72);
    constexpr int NCB = 1024 / 64, NRB = NROW / 64;
    for (int it = gw; it < NCB * NRB; it += F.NGW) {
        const int cblk = it % NCB, rblk = it / NCB, c0 = cblk * 64, r0 = rblk * 64;
#pragma unroll
        for (int i = 0; i < 8; ++i) {
            const int c = i * 8 + (lane >> 3), ch = lane & 7;
            const v4u x = *(const v4u*)(HYO + (size_t)(c0 + c) * NROW + r0 + ch * 8);
            *(LAS v4u*)(tl + c * 72 + ch * 8) = x;
        }
        LDS_WAIT();
#pragma unroll
        for (int i = 0; i < 8; ++i) {
            const int r = i * 8 + (lane >> 3), cq = (lane & 7) * 8;
            unsigned short e[8];
#pragma unroll
            for (int q = 0; q < 8; ++q) e[q] = tl[(cq + q) * 72 + r];
            v4u w; w.x = e[0] | ((unsigned)e[1] << 16); w.y = e[2] | ((unsigned)e[3] << 16); w.z = e[4] | ((unsigned)e[5] << 16); w.w = e[6] | ((unsigned)e[7] << 16);
            *(v4u*)(MIX + (size_t)(r0 + r) * DM + 1024 + c0 + cq) = w;
        }
        LDS_WAIT();
    }
}
__device__ __forceinline__ void phase_prep(Frame& F, int rep = 0) {
    PHASE_LOCALS
    bf16* Z = (bf16*)(F.ws + WS_Z); bf16* ZD = rep ? (bf16*)(F.ws + WS_W) : Z;
    const float* qn = F.in[24]; const float* kn = F.in[25];
    const float rsq = 0.08838834764831845f;
    const float inv_ret = powf(10000.0f, -(float)lane / 63.0f);
    const float inv_ax = powf(10000.0f, -(float)(lane & 31) / 32.0f);
    for (int row = gw; row < NROW; row += F.NGW) {
        const bool latent = row >= NCTX; const int pos = latent ? ((row - NCTX) & 8191) : 0;
        bf16* zr = Z + (size_t)row * ODC; bf16* zd = ZD + (size_t)row * ODC;
        float sr = 0.f, cr = 1.f, s1 = 0.f, c1 = 1.f, s2 = 0.f, c2 = 1.f;
        if (latent) { sincosf((float)pos * inv_ret, &sr, &cr); sincosf((float)(pos >> 6) * inv_ax, &s1, &c1); sincosf((float)(pos & 63) * inv_ax, &s2, &c2); }
#pragma unroll
        for (int sg = 0; sg < 8; ++sg) {
            bf16* p = zr + sg * 128; bf16* pd = zd + sg * 128;
            const float x1 = bf2f(p[lane]), x2 = bf2f(p[64 + lane]);
            float o1 = x1 * cr - x2 * sr, o2 = x2 * cr + x1 * sr;
            if (sg >= 4) { o1 *= rsq; o2 *= rsq; }
            pd[lane] = (bf16)f2bf(o1); pd[64 + lane] = (bf16)f2bf(o2);
        }
#pragma unroll
        for (int sg = 0; sg < 10; ++sg) {
            bf16* p = zr + 3072 + sg * 128; bf16* pd = zd + 3072 + sg * 128; const float* gnp = sg < 8 ? qn : kn;
            float a = bf2f(p[lane]), b = bf2f(p[64 + lane]);
            const float rstd = rsqrtf(wave_sum(a * a + b * b) * (1.0f / 128.0f) + EPSN);
            a = a * rstd * gnp[lane]; b = b * rstd * gnp[64 + lane];
            const float ap = __shfl_xor(a, 32), bp = __shfl_xor(b, 32);
            float oa, ob;
            if (lane < 32) { oa = a * c1 - ap * s1; ob = b * c2 - bp * s2; }
            else { oa = a * c1 + ap * s1; ob = b * c2 + bp * s2; }
            if (sg < 8) { oa *= rsq; ob *= rsq; }
            pd[lane] = (bf16)f2bf(oa); pd[64 + lane] = (bf16)f2bf(ob);
        }
    }
}
__device__ __forceinline__ int scan_rowbase(int n, int b, int dir) {
    if (n < 4) { const int cc = dir ? 3 - n : n; return b * CTXL + cc * 64; }
    const int m = n - 4, cc = dir ? 127 - m : m; return NCTX + b * SEQ + cc * 64;
}
constexpr int QKD_UNIT = 16384 + 8192 + 16384 + 512;
__device__ __forceinline__ size_t qkd_off(int b, int h, int dir, int n) { return (size_t)((((b * 4 + h) * 2 + dir) * 132) + n) * QKD_UNIT; }
struct PreRegs { v4u q[2], k[2]; f32x4 lr; };
template <bool GLA>
__device__ __forceinline__ void prepass_load(Frame& F, int pu, int tid, PreRegs& R) {
    const int n = pu % 132, r_ = pu / 132, dir = r_ & 1, h = (r_ >> 1) & 3, b = r_ >> 3;
    const bf16* Z = (const bf16*)(F.ws + WS_Z);
    constexpr int ldz = GLA ? ZC0 : ODC;
    const bf16* Zq = Z + h * 128; const bf16* Zk = Z + 512 + h * 128;
    const float* LRp = (const float*)(F.ws + WS_LR) + dir * 16;
    const int rb = scan_rowbase(n, b, dir);
#pragma unroll
    for (int i = 0; i < 2; ++i) { const int idx = tid + 512 * i, r = idx >> 4, ch = idx & 15;
        R.q[i] = *(const v4u*)(Zq + (size_t)(rb + r) * ldz + ch * 8); R.k[i] = *(const v4u*)(Zk + (size_t)(rb + r) * ldz + ch * 8); }
    if (GLA && tid < 256) R.lr = *(const f32x4*)(LRp + (size_t)(rb + (tid >> 2)) * 32 + (tid & 3) * 4);
}
template <bool GLA>
__device__ __forceinline__ void prepass_unit(Frame& F, int pu, int pu_next, PreRegs& R) {
    const int n = pu % 132, r_ = pu / 132, dir = r_ & 1, h = (r_ >> 1) & 3, b = r_ >> 3;
    PHASE_LOCALS
    const int w = wave, l = lane, g = l >> 4, c = l & 15;
    LAS unsigned char* lds = F.lds;
    constexpr int S128 = 272, S64 = 144;
    constexpr int O_RQ = 0, O_RK = 17408, O_QE = 34816, O_KE = 52224, O_KDT = 69632, O_LR = 88064;
    const bf16* Z = (const bf16*)(F.ws + WS_Z);
    constexpr int ldz = GLA ? ZC0 : ODC;
    const bf16* Zq = Z + h * 128; const bf16* Zk = Z + 512 + h * 128;
    const float* LRp = (const float*)(F.ws + WS_LR) + dir * 16;
    unsigned char* qkd = F.ws + WS_QKD + qkd_off(b, h, dir, n);
    const float qscale = GLA ? 0.08838834764831845f : 1.0f;
    float wgv[4] = {0.f, 0.f, 0.f, 0.f}, bgv[4] = {0.f, 0.f, 0.f, 0.f}; float lgv = 0.f;
    if (GLA) {
        const float* wg = F.in[10] + dir * 16 * 512 + h * 128 + 16 * w; const float* bg = F.in[11] + dir * 512 + h * 128 + 16 * w;
#pragma unroll
        for (int ks = 0; ks < 4; ++ks) wgv[ks] = wg[(4 * ks + g) * 512 + c];
#pragma unroll
        for (int i = 0; i < 4; ++i) bgv[i] = bg[4 * g + i];
    } else {
        const int hh = dir ? 3 - h : h; lgv = log2f(1.0f - exp2f(-5.0f - (float)hh));
    }
    {
#pragma unroll
        for (int i = 0; i < 2; ++i) { const int idx = tid + 512 * i, r = idx >> 4, ch = idx & 15;
            *(LAS v4u*)(lds + O_RQ + r * S128 + ch * 16) = R.q[i]; *(LAS v4u*)(lds + O_RK + r * S128 + ch * 16) = R.k[i]; }
        if (GLA && tid < 256) { LAS float* lr = (LAS float*)(lds + O_LR) + (tid >> 2) * 17 + (tid & 3) * 4; lr[0] = R.lr[0]; lr[1] = R.lr[1]; lr[2] = R.lr[2]; lr[3] = R.lr[3]; }
        if (pu_next < 2112) prepass_load<GLA>(F, pu_next, tid, R);
        LDS_BARRIER();
        f32x4 cum[4]; float tot[4];
        if (GLA) {
            const LAS float* lrs = (const LAS float*)(lds + O_LR);
            f32x4 la[4];
#pragma unroll
            for (int tt = 0; tt < 4; ++tt) {
                f32x4 a = {0.f, 0.f, 0.f, 0.f};
#pragma unroll
                for (int ks = 0; ks < 4; ++ks) a = __builtin_amdgcn_mfma_f32_16x16x4f32(wgv[ks], lrs[(16 * tt + c) * 17 + 4 * ks + g], a, 0, 0, 0);
#pragma unroll
                for (int i = 0; i < 4; ++i) {
                    const float y = (a[i] + bgv[i]) * -1.44269504089f;
                    la[tt][i] = (fmaxf(y, 0.f) + __builtin_amdgcn_logf(1.0f + __builtin_amdgcn_exp2f(-fabsf(y)))) * -0.0625f; }
            }
            float carry[4] = {0.f, 0.f, 0.f, 0.f};
#pragma unroll
            for (int tt = 0; tt < 4; ++tt)
#pragma unroll
                for (int i = 0; i < 4; ++i) {
                    const float x = la[tt][i];
#if SCAN_DPP
                    float v = x; v += row_shr<1>(v); v += row_shr<2>(v); v += row_shr<4>(v); v += row_shr<8>(v);
                    float r = x; r += row_ror<8>(r); r += row_ror<4>(r); r += row_ror<2>(r); r += row_ror<1>(r);
#else
                    float v = x, u;
                    u = __shfl_up(v, 1, 16); if (c >= 1) v += u;
                    u = __shfl_up(v, 2, 16); if (c >= 2) v += u;
                    u = __shfl_up(v, 4, 16); if (c >= 4) v += u;
                    u = __shfl_up(v, 8, 16); if (c >= 8) v += u;
                    const float r = __shfl(v, 15, 16);
#endif
                    cum[tt][i] = v + carry[i]; carry[i] += r;
                }
#pragma unroll
            for (int i = 0; i < 4; ++i) tot[i] = carry[i];
            if (dir) {
#pragma unroll
                for (int tt = 0; tt < 4; ++tt)
#pragma unroll
                    for (int i = 0; i < 4; ++i) cum[tt][i] = tot[i] - cum[tt][i] + la[tt][i];
            }
        } else {
#pragma unroll
            for (int tt = 0; tt < 4; ++tt) { const int t = 16 * tt + c; const float cv = dir ? (float)(64 - t) * lgv : (float)(t + 1) * lgv;
#pragma unroll
                for (int i = 0; i < 4; ++i) cum[tt][i] = cv; }
#pragma unroll
            for (int i = 0; i < 4; ++i) tot[i] = 64.0f * lgv;
        }
        float dec[4];
#pragma unroll
        for (int i = 0; i < 4; ++i) dec[i] = __builtin_amdgcn_exp2f(tot[i]);
#pragma unroll
        for (int tt = 0; tt < 4; ++tt) {
            const int t = 16 * tt + c;
            const v2u q4 = *(const LAS v2u*)(lds + O_RQ + t * S128 + (16 * w + 4 * g) * 2), k4 = *(const LAS v2u*)(lds + O_RK + t * S128 + (16 * w + 4 * g) * 2);
            const float qv[4] = {bflo(q4.x), bfhi(q4.x), bflo(q4.y), bfhi(q4.y)}, kv[4] = {bflo(k4.x), bfhi(k4.x), bflo(k4.y), bfhi(k4.y)};
            float qe[4], ke[4], kd[4];
            if (GLA) {
#pragma unroll
                for (int i = 0; i < 4; ++i) { const float e1 = __builtin_amdgcn_exp2f(cum[tt][i]), e2 = __builtin_amdgcn_exp2f(-cum[tt][i]);
                    qe[i] = qv[i] * qscale * e1; ke[i] = kv[i] * e2; kd[i] = ke[i] * dec[i]; }
            } else {
                const float e1 = __builtin_amdgcn_exp2f(cum[tt][0]), e2 = __builtin_amdgcn_exp2f(-cum[tt][0]), e3 = e2 * dec[0];
#pragma unroll
                for (int i = 0; i < 4; ++i) { qe[i] = qv[i] * e1; ke[i] = kv[i] * e2; kd[i] = kv[i] * e3; }
            }
            const unsigned d01 = cvt_pk(kd[0], kd[1]), d23 = cvt_pk(kd[2], kd[3]);
            *(LAS unsigned short*)(lds + O_KDT + (16 * w + 4 * g + 0) * S64 + t * 2) = (unsigned short)(d01 & 0xffffu);
            *(LAS unsigned short*)(lds + O_KDT + (16 * w + 4 * g + 1) * S64 + t * 2) = (unsigned short)(d01 >> 16);
            *(LAS unsigned short*)(lds + O_KDT + (16 * w + 4 * g + 2) * S64 + t * 2) = (unsigned short)(d23 & 0xffffu);
            *(LAS unsigned short*)(lds + O_KDT + (16 * w + 4 * g + 3) * S64 + t * 2) = (unsigned short)(d23 >> 16);
            v2u o; o.x = cvt_pk(qe[0], qe[1]); o.y = cvt_pk(qe[2], qe[3]); *(LAS v2u*)(lds + O_QE + t * S128 + (16 * w + 4 * g) * 2) = o;
            o.x = cvt_pk(ke[0], ke[1]); o.y = cvt_pk(ke[2], ke[3]); *(LAS v2u*)(lds + O_KE + t * S128 + (16 * w + 4 * g) * 2) = o;
        }
        if (c == 0) { f32x4 dv; dv[0] = dec[0]; dv[1] = dec[1]; dv[2] = dec[2]; dv[3] = dec[3]; *(f32x4*)(qkd + 40960 + (16 * w + 4 * g) * 4) = dv; }
        LDS_BARRIER();
        {
            const int it = w >> 1, p = w & 1;
            f32x4 sa[2];
#pragma unroll
            for (int jj = 0; jj < 2; ++jj) {
                const int jt = 2 * p + jj;
                sa[jj] = (f32x4){0.f, 0.f, 0.f, 0.f};
#pragma unroll
                for (int ks = 0; ks < 4; ++ks) { const bf16x8 a = *(const LAS bf16x8*)(lds + O_KE + (16 * jt + c) * S128 + (32 * ks + 8 * g) * 2), qf = *(const LAS bf16x8*)(lds + O_QE + (16 * it + c) * S128 + (32 * ks + 8 * g) * 2);
                    sa[jj] = mfma_bf16(a, qf, sa[jj]); }
                const int itok = 16 * it + c;
#pragma unroll
                for (int r = 0; r < 4; ++r) { const int j = 16 * jt + 4 * g + r; const bool keep = dir ? (j >= itok) : (j <= itok); sa[jj][r] = keep ? sa[jj][r] : 0.f; }
            }
            v4u t4; t4.x = cvt_pk(sa[0][0], sa[0][1]); t4.y = cvt_pk(sa[0][2], sa[0][3]); t4.z = cvt_pk(sa[1][0], sa[1][1]); t4.w = cvt_pk(sa[1][2], sa[1][3]);
            *(v4u*)(qkd + 16384 + ((it * 2 + p) * 64 + l) * 16) = t4;
        }
#pragma unroll
        for (int i = 0; i < 2; ++i) { const int idx = tid + 512 * i, ll = idx & 63, cc = ll & 15, gg = ll >> 4;
            { const int it2 = idx >> 8, ks = (idx >> 6) & 3;
              *(v4u*)(qkd + idx * 16) = *(const LAS v4u*)(lds + O_QE + (16 * it2 + cc) * S128 + (32 * ks + 8 * gg) * 2); }
            { const int w2 = idx >> 7, pp = (idx >> 6) & 1, r = 16 * w2 + cc;
              const v2u lo = *(const LAS v2u*)(lds + O_KDT + r * S64 + (32 * pp + 4 * gg) * 2), hi = *(const LAS v2u*)(lds + O_KDT + r * S64 + (32 * pp + 16 + 4 * gg) * 2);
              v4u o; o.x = lo.x; o.y = lo.y; o.z = hi.x; o.w = hi.y; *(v4u*)(qkd + 24576 + idx * 16) = o; } }
        LDS_BARRIER();
    }
}
typedef short trv4 __attribute__((ext_vector_type(4)));
template <bool GLA, bool NOSTORE = false, bool NOLOAD = false, bool NOBAR = false>
__device__ __forceinline__ void scan_unit(Frame& F, int unit) {
    const int s = unit & 3, dir = (unit >> 2) & 1, h = (unit >> 3) & 3, b = unit >> 5;
    PHASE_LOCALS
    const int w = wave, l = lane, g = l >> 4, c = l & 15;
    LAS unsigned char* lds = F.lds;
    constexpr int S128 = 272, S64 = 144;
    constexpr int O_VT = 0, O_ST = 18432, O_OI = 18432 + 34816;
    const bf16* Z = (const bf16*)(F.ws + WS_Z);
    constexpr int ldz = GLA ? ZC0 : ODC;
    const bf16* Zv = Z + 1024 + h * 256 + s * 64;
    bf16* O = (bf16*)(F.ws + (dir ? WS_OB : WS_OF)) + h * 256 + s * 64;
    const unsigned char* qkd0 = F.ws + WS_QKD + qkd_off(b, h, dir, 0);
    const int it = w >> 1, ep = w & 1;
    for (int i = tid; i < 17408 / 4; i += NTHR) ((LAS unsigned*)(lds + O_ST))[i] = 0u;
    f32x4 S[4];
#pragma unroll
    for (int et = 0; et < 4; ++et) S[et] = (f32x4){0.f, 0.f, 0.f, 0.f};
    struct StepRegs { v4u qf[4], P[2], ka[2], rv; f32x4 dec; };
    StepRegs RA, RB, RC;
#define SCAN_LOAD(R_, n_) do { const unsigned char* q_ = qkd0 + (size_t)(n_) * QKD_UNIT; const int rb_ = scan_rowbase((n_), b, dir); \
        _Pragma("unroll") for (int ks_ = 0; ks_ < 4; ++ks_) R_.qf[ks_] = *(const v4u*)(q_ + ((it * 4 + ks_) * 64 + l) * 16); \
        _Pragma("unroll") for (int p_ = 0; p_ < 2; ++p_) { R_.P[p_] = *(const v4u*)(q_ + 16384 + ((it * 2 + p_) * 64 + l) * 16); R_.ka[p_] = *(const v4u*)(q_ + 24576 + ((w * 2 + p_) * 64 + l) * 16); } \
        R_.dec = *(const f32x4*)(q_ + 40960 + (16 * w + 4 * g) * 4); \
        if ((n_) + 1 < 132) { const int rb1_ = scan_rowbase((n_) + 1, b, dir); R_.rv = *(const v4u*)(Zv + (size_t)(rb1_ + (tid >> 3)) * ldz + (tid & 7) * 8); } (void)rb_; } while (0)
#define OI_STORE(n_, buf_) do { const int rbp_ = scan_rowbase((n_), b, dir); \
        *(v4u*)(O + (size_t)(rbp_ + (tid >> 3)) * 1024 + (tid & 7) * 8) = *(const LAS v4u*)(lds + O_OI + (buf_) * 9216 + (tid >> 3) * S64 + (tid & 7) * 16); } while (0)
#define VT_WRITE(R_, buf_) do { *(LAS v4u*)(lds + O_VT + (buf_) * 9216 + (tid >> 3) * S64 + (tid & 7) * 16) = R_.rv; } while (0)
#define SCAN_STEP(R_, R1_, R2_, n_) do { \
        if (!NOSTORE && (n_) >= 1 && (GLA || (n_) >= 5)) OI_STORE((n_) - 1, cur ^ 1);     \
        if (!NOLOAD && (n_) + 2 < 132) SCAN_LOAD(R2_, (n_) + 2); \
        const LAS unsigned char* vtc = lds + O_VT + cur * 9216; const LAS unsigned char* stc = lds + O_ST + cur * 17408; \
          \
          \
        v4u vfr[4][2]; bf16x8 sf[2][4]; \
        _Pragma("unroll") for (int et = 0; et < 4; ++et) \
            _Pragma("unroll") for (int p = 0; p < 2; ++p) { \
                const trv4 lo = __builtin_amdgcn_ds_read_tr16_b64_v4i16((LAS trv4*)(vtc + (32 * p + 4 * g + (c >> 2)) * S64 + (16 * et + 4 * (c & 3)) * 2)); \
                const trv4 hi = __builtin_amdgcn_ds_read_tr16_b64_v4i16((LAS trv4*)(vtc + (32 * p + 16 + 4 * g + (c >> 2)) * S64 + (16 * et + 4 * (c & 3)) * 2)); \
                const v2u l2 = __builtin_bit_cast(v2u, lo), h2 = __builtin_bit_cast(v2u, hi); vfr[et][p] = (v4u){l2.x, l2.y, h2.x, h2.y}; } \
        _Pragma("unroll") for (int en = 0; en < 2; ++en) \
            _Pragma("unroll") for (int ks = 0; ks < 4; ++ks) sf[en][ks] = *(const LAS bf16x8*)(stc + (16 * (2 * ep + en) + c) * S128 + (32 * ks + 8 * g) * 2); \
        if ((n_) + 1 < 132) VT_WRITE(R_, cur ^ 1); \
        _Pragma("unroll") for (int en = 0; en < 2; ++en) { \
            const int et = 2 * ep + en; f32x4 acc = {0.f, 0.f, 0.f, 0.f}; \
            _Pragma("unroll") for (int p = 0; p < 2; ++p) acc = mfma_bf16(__builtin_bit_cast(bf16x8, en == 0 ? (ep == 0 ? vfr[0][p] : vfr[2][p]) : (ep == 0 ? vfr[1][p] : vfr[3][p])), __builtin_bit_cast(bf16x8, R_.P[p]), acc); \
            _Pragma("unroll") for (int ks = 0; ks < 4; ++ks) acc = mfma_bf16(sf[en][ks], __builtin_bit_cast(bf16x8, R_.qf[ks]), acc); \
            { v2u o; o.x = cvt_pk(acc[0], acc[1]); o.y = cvt_pk(acc[2], acc[3]); *(LAS v2u*)(lds + O_OI + cur * 9216 + (16 * it + c) * S64 + (16 * et + 4 * g) * 2) = o; } } \
        { LAS unsigned char* stn = lds + O_ST + (cur ^ 1) * 17408; \
            _Pragma("unroll") for (int et = 0; et < 4; ++et) { \
                _Pragma("unroll") for (int i = 0; i < 4; ++i) S[et][i] *= R_.dec[i]; \
                _Pragma("unroll") for (int p = 0; p < 2; ++p) S[et] = mfma_bf16(__builtin_bit_cast(bf16x8, R_.ka[p]), __builtin_bit_cast(bf16x8, vfr[et][p]), S[et]); \
                v2u o; o.x = cvt_pk(S[et][0], S[et][1]); o.y = cvt_pk(S[et][2], S[et][3]); \
                *(LAS v2u*)(stn + (16 * et + c) * S128 + (16 * w + 4 * g) * 2) = o; } } \
        cur ^= 1; \
        if (!NOBAR) LDS_BARRIER(); } while (0)
    { const int rb0 = scan_rowbase(0, b, dir); RC.rv = *(const v4u*)(Zv + (size_t)(rb0 + (tid >> 3)) * ldz + (tid & 7) * 8); }
    SCAN_LOAD(RA, 0); SCAN_LOAD(RB, 1); if (NOLOAD) SCAN_LOAD(RC, 2);
    int cur = 0;
    VT_WRITE(RC, 0);
    LDS_BARRIER();
#pragma unroll 1
    for (int n = 0; n < 132; n += 3) { SCAN_STEP(RA, RB, RC, n); SCAN_STEP(RB, RC, RA, n + 1); SCAN_STEP(RC, RA, RB, n + 2); }
    if (!NOSTORE) OI_STORE(131, cur ^ 1);
#undef VT_WRITE
#undef OI_STORE
#undef SCAN_STEP
    __syncthreads();
#undef SCAN_LOAD
}
__device__ __forceinline__ f32x2v cmul(f32x2v a, f32x2v b) { return (f32x2v){a.x * b.x - a.y * b.y, a.x * b.y + a.y * b.x}; }
__device__ __forceinline__ f32x2v twid(float turns) { return (f32x2v){__builtin_amdgcn_cosf(turns), __builtin_amdgcn_sinf(turns)}; }
__device__ __forceinline__ int rev4_14(int p) { const unsigned y = __brev((unsigned)p) >> 18; return (int)(((y & 0x1555u) << 1) | ((y >> 1) & 0x1555u)); }

__device__ __forceinline__ int fpad(int i) { return i + ((i >> 6) << 2); }
__device__ __forceinline__ f32x2v cmulp(f32x2v a, f32x2v w) { f32x2v r = a.x * w; r += a.y * (f32x2v){-w.y, w.x}; return r; }
__device__ __forceinline__ f32x2v cmulc(f32x2v a, f32x2v w) { f32x2v r = a.x * (f32x2v){w.x, -w.y}; r += a.y * (f32x2v){w.y, w.x}; return r; }
__device__ __forceinline__ f32x2v mul_mi(f32x2v t) { return (f32x2v){t.y, -t.x}; }
__device__ __forceinline__ f32x2v mul_pi(f32x2v t) { return (f32x2v){-t.y, t.x}; }
#define BF4F(A0, A1, A2, A3) do { const f32x2v b0_ = A0 + A2, b1_ = A0 - A2, b2_ = A1 + A3, b3_ = mul_mi(A1 - A3); A0 = b0_ + b2_; A1 = b1_ + b3_; A2 = b0_ - b2_; A3 = b1_ - b3_; } while (0)
#define BF4I(A0, A1, A2, A3) do { const f32x2v b0_ = A0 + A2, b1_ = A0 - A2, b2_ = A1 + A3, b3_ = mul_pi(A1 - A3); A0 = b0_ + b2_; A1 = b1_ + b3_; A2 = b0_ - b2_; A3 = b1_ - b3_; } while (0)
#define W16_1 ((f32x2v){0.92387953251f, -0.38268343236f})
#define W16_2 ((f32x2v){0.70710678118f, -0.70710678118f})
#define W16_3 ((f32x2v){0.38268343236f, -0.92387953251f})
#define W16_6 ((f32x2v){-0.70710678118f, -0.70710678118f})
#define W16_9 ((f32x2v){-0.92387953251f, 0.38268343236f})
template <int M, bool ZPAD>
__device__ __forceinline__ void fft_fwd16(LAS f32x2v* x, int tid) {
    constexpr int Q16 = M / 16;
#pragma unroll 1
    for (int i = 0; i < 2; ++i) {
        const int bf = tid + 512 * i, blk = bf / Q16, k = bf % Q16, base = blk * M + k;
        f32x2v a[16];
#pragma unroll
        for (int j = 0; j < 16; ++j) a[j] = (ZPAD && j >= 8) ? (f32x2v){0.f, 0.f} : x[fpad(base + j * Q16)];
        const f32x2v w1 = twid(-(float)k * (1.0f / (float)M)), w2 = cmulp(w1, w1), w3 = cmulp(w2, w1), w4 = cmulp(w2, w2), w8 = cmulp(w4, w4), w12 = cmulp(w8, w4);
#pragma unroll
        for (int jp = 0; jp < 4; ++jp) {
            if (ZPAD) { const f32x2v a0 = a[jp], a1 = a[jp + 4], b3 = mul_mi(a1); a[jp] = a0 + a1; a[jp + 4] = a0 + b3; a[jp + 8] = a0 - a1; a[jp + 12] = a0 - b3; }
            else BF4F(a[jp], a[jp + 4], a[jp + 8], a[jp + 12]);
            a[jp + 4] = cmulp(a[jp + 4], w1); a[jp + 8] = cmulp(a[jp + 8], w2); a[jp + 12] = cmulp(a[jp + 12], w3);
        }
        a[5] = cmulp(a[5], W16_1); a[9] = cmulp(a[9], W16_2); a[13] = cmulp(a[13], W16_3);
        a[6] = cmulp(a[6], W16_2); a[10] = mul_mi(a[10]);      a[14] = cmulp(a[14], W16_6);
        a[7] = cmulp(a[7], W16_3); a[11] = cmulp(a[11], W16_6); a[15] = cmulp(a[15], W16_9);
#pragma unroll
        for (int q = 0; q < 4; ++q) {
            BF4F(a[4 * q], a[4 * q + 1], a[4 * q + 2], a[4 * q + 3]);
            a[4 * q + 1] = cmulp(a[4 * q + 1], w4); a[4 * q + 2] = cmulp(a[4 * q + 2], w8); a[4 * q + 3] = cmulp(a[4 * q + 3], w12);
        }
#pragma unroll
        for (int j = 0; j < 16; ++j) x[fpad(base + j * Q16)] = a[j];
    }
    __syncthreads();
}
template <int M, bool HALF>
__device__ __forceinline__ void fft_inv16(LAS f32x2v* x, int tid) {
    constexpr int Q16 = M / 16;
#pragma unroll 1
    for (int i = 0; i < 2; ++i) {
        const int bf = tid + 512 * i, blk = bf / Q16, k = bf % Q16, base = blk * M + k;
        f32x2v a[16];
#pragma unroll
        for (int j = 0; j < 16; ++j) a[j] = x[fpad(base + j * Q16)];
        const f32x2v w1 = twid(-(float)k * (1.0f / (float)M)), w2 = cmulp(w1, w1), w3 = cmulp(w2, w1), w4 = cmulp(w2, w2), w8 = cmulp(w4, w4), w12 = cmulp(w8, w4);
#pragma unroll
        for (int q = 0; q < 4; ++q) {
            a[4 * q + 1] = cmulc(a[4 * q + 1], w4); a[4 * q + 2] = cmulc(a[4 * q + 2], w8); a[4 * q + 3] = cmulc(a[4 * q + 3], w12);
            BF4I(a[4 * q], a[4 * q + 1], a[4 * q + 2], a[4 * q + 3]);
        }
        a[5] = cmulc(a[5], W16_1); a[9] = cmulc(a[9], W16_2); a[13] = cmulc(a[13], W16_3);
        a[6] = cmulc(a[6], W16_2); a[10] = mul_pi(a[10]);      a[14] = cmulc(a[14], W16_6);
        a[7] = cmulc(a[7], W16_3); a[11] = cmulc(a[11], W16_6); a[15] = cmulc(a[15], W16_9);
#pragma unroll
        for (int jp = 0; jp < 4; ++jp) {
            a[jp + 4] = cmulc(a[jp + 4], w1); a[jp + 8] = cmulc(a[jp + 8], w2); a[jp + 12] = cmulc(a[jp + 12], w3);
            if (HALF) { const f32x2v b0 = a[jp] + a[jp + 8], b1 = a[jp] - a[jp + 8], b2 = a[jp + 4] + a[jp + 12], b3 = mul_pi(a[jp + 4] - a[jp + 12]); a[jp] = b0 + b2; a[jp + 4] = b1 + b3; }
            else BF4I(a[jp], a[jp + 4], a[jp + 8], a[jp + 12]);
        }
#pragma unroll
        for (int j = 0; j < (HALF ? 8 : 16); ++j) x[fpad(base + j * Q16)] = a[j];
    }
    __syncthreads();
}
template <bool INV>
__device__ __forceinline__ void fft_r4(LAS f32x2v* x, int tid) {
#pragma unroll 2
    for (int i = 0; i < 8; ++i) {
        const int bf = tid + 512 * i; LAS f32x4* p = (LAS f32x4*)(x + fpad(4 * bf));
        const f32x4 u = p[0], v = p[1];
        f32x2v a0 = {u[0], u[1]}, a1 = {u[2], u[3]}, a2 = {v[0], v[1]}, a3 = {v[2], v[3]};
        if (INV) BF4I(a0, a1, a2, a3); else BF4F(a0, a1, a2, a3);
        p[0] = (f32x4){a0.x, a0.y, a1.x, a1.y}; p[1] = (f32x4){a2.x, a2.y, a3.x, a3.y};
    }
    __syncthreads();
}
template <bool ZPAD> __device__ __forceinline__ void fft_fwd(LAS f32x2v* x, int tid) { fft_fwd16<16384, ZPAD>(x, tid); fft_fwd16<1024, false>(x, tid); fft_fwd16<64, false>(x, tid); fft_r4<false>(x, tid); }
template <bool HALF> __device__ __forceinline__ void fft_inv(LAS f32x2v* x, int tid) { fft_r4<true>(x, tid); fft_inv16<64, false>(x, tid); fft_inv16<1024, false>(x, tid); fft_inv16<16384, HALF>(x, tid); }
__device__ __forceinline__ void spec_mul(LAS f32x2v* x, const f32x2v* ks, float kny, int tid) {
#pragma unroll 1
    for (int h = 0; h < 2; ++h) {
        f32x2v kv[8];
#pragma unroll
        for (int i = 0; i < 8; ++i) kv[i] = ks[tid + 512 * (8 * h + i)];
#pragma unroll
        for (int i = 0; i < 8; ++i) {
            const int idx = tid + 512 * (8 * h + i), p = (idx >> 1) * 4 + (idx & 1), f = rev4_14(p), pp = rev4_14((FFTN - f) & (FFTN - 1));
            const f32x2v k = kv[i];
            const int ip = fpad(p), iq = fpad(pp);
            const f32x2v xp = x[ip], xq = x[iq];
            x[ip] = cmulp(xp, k);
            if (pp != p) x[iq] = cmulc(xq, k);
            if (idx == 0) { const f32x2v x2 = x[2]; x[2] = x2 * kny; }
        }
    }
    __syncthreads();
}
__device__ __forceinline__ float block_sum2(LAS float* red, float v, int tid, int wave, int lane, int slot) {
    v = wave_sum(v); if (lane == 0) red[slot * 8 + wave] = v; __syncthreads();
    float s = 0.f;
#pragma unroll
    for (int i = 0; i < 8; ++i) s += red[slot * 8 + i];
    return s;
}
template <int HYV, int PART = 0>
__device__ __forceinline__ void hyena_unit(Frame& F, int ch) {
    PHASE_LOCALS
    LAS f32x2v* cb = (LAS f32x2v*)F.lds;
    LAS float* cbf = (LAS float*)F.lds;
    LAS float* w3c = (LAS float*)(F.lds + LDSCTL_OFF + 2048);
    LAS float* red = (LAS float*)(F.lds + LDSCTL_OFF + 3072);
    const bf16* UT = (const bf16*)F.out; bf16* HYO = (bf16*)(F.ws + (HYV ? WS_END : WS_H));
    const float* hdnL = (const float*)(F.ws + WS_HDNL); const float* hdnC = (const float*)(F.ws + WS_HDNC);
    unsigned char* hs = F.ws + WS_ACT + (size_t)F.bx * HYS_BYTES;
    f32x2v* KA = (f32x2v*)hs; f32x2v* KB = (f32x2v*)(hs + 65536); f32x2v* ZS = (f32x2v*)(hs + 131072); float* KX = (float*)(hs + 196608);
    const float bias0 = F.in[20][ch], bias1 = F.in[20][1024 + ch];
    const float delta = fabsf(-3.0701134573253945f + (-15.350567286626972f + 3.0701134573253945f) * ((float)ch / 1023.0f));
    const bf16* uz = UT + (size_t)ch * NROW; const bf16* ug1 = UT + (size_t)(1024 + ch) * NROW; const bf16* ug2 = UT + (size_t)(2048 + ch) * NROW;
    bf16* ho = HYO + (size_t)ch * NROW;
    __syncthreads();
    if (PART != 1 && tid < 256) { const int q = tid >> 6, j = tid & 63; w3c[tid] = F.in[19][(size_t)j * 4096 + q * 1024 + ch]; }
    __syncthreads();
    if (!(HYV & 2) && PART != 1) {
        LAS float* kf = cbf;
        LAS float* zc = cbf + 1024;
        LAS float* g1c = cbf + 1536; LAS float* g2c = cbf + 2048; LAS float* y1c = cbf + 2560;
        float s0 = 0.f, s1 = 0.f;
        if (tid < 256) {
            const int l = tid; const float* hr = hdnC + l * 64; float a[4] = {0.f, 0.f, 0.f, 0.f};
#pragma unroll
            for (int jj = 0; jj < 16; ++jj) { const f32x4 hv = *(const f32x4*)(hr + 4 * jj);
#pragma unroll
                for (int q = 0; q < 4; ++q) { const f32x4 wv = *(const LAS f32x4*)(w3c + q * 64 + 4 * jj); a[q] += hv[0] * wv[0] + hv[1] * wv[1] + hv[2] * wv[2] + hv[3] * wv[3]; } }
            const float mult = __expf(-((float)l / 255.0f) * delta) + 0.05f;
#pragma unroll
            for (int q = 0; q < 4; ++q) { a[q] *= mult; kf[q * 256 + l] = a[q]; }
            s0 = fabsf(a[0]) + (l >= 1 ? fabsf(a[1]) : 0.f); s1 = fabsf(a[2]) + (l >= 1 ? fabsf(a[3]) : 0.f);
        }
        zc[tid] = bf2f(uz[tid]); g1c[tid] = bf2f(ug1[tid]); g2c[tid] = bf2f(ug2[tid]);
        const float n0 = block_sum2(red, s0, tid, wave, lane, 0), n1 = block_sum2(red, s1, tid, wave, lane, 1);
        const int bb = tid >> 8, t = tid & 255;
        float y = 0.f;
        for (int sidx = 0; sidx < 256; ++sidx) { const int m = t - sidx; const float kv = m >= 0 ? kf[m] : kf[256 - m]; y += kv * zc[bb * 256 + sidx]; }
        const float y1 = g1c[tid] * (y / n0 + zc[tid] * bias0);
        y1c[tid] = y1;
        __syncthreads();
        y = 0.f;
        for (int sidx = 0; sidx < 256; ++sidx) { const int m = t - sidx; const float kv = m >= 0 ? kf[512 + m] : kf[768 - m]; y += kv * y1c[bb * 256 + sidx]; }
        const float o = g2c[tid] * (y / n1 + y1 * bias1);
        ho[tid] = (bf16)f2bf(o);
        __syncthreads();
    }
    if (PART == 2) return;
    if (!(HYV & 4)) {
        float s0 = 0.f, s1 = 0.f;
        const float* f0p = (const float*)(F.ws + WS_FILT0) + (size_t)ch * 8192; const float* f1p = (const float*)(F.ws + WS_FILT1) + (size_t)ch * 8192;
        const float* f2p = (const float*)(F.ws + WS_FILT2) + (size_t)ch * 8192; const float* f3p = (const float*)(F.ws + WS_FILT3) + (size_t)ch * 8192;
#pragma unroll
        for (int i = 0; i < 4; ++i) {
            const int l4 = (tid + 512 * i) * 4;
            const f32x4 a0 = *(const f32x4*)(f0p + l4), a1 = *(const f32x4*)(f1p + l4), a2 = *(const f32x4*)(f2p + l4), a3 = *(const f32x4*)(f3p + l4);
#pragma unroll
            for (int j = 0; j < 4; ++j) {
                const int l = l4 + j;
                const float mult = __expf(-((float)l / 8191.0f) * delta) + 0.05f;
                const float b0 = a0[j] * mult, b1 = a1[j] * mult, b2 = a2[j] * mult, b3 = a3[j] * mult;
                cb[fpad(l)] = (f32x2v){b0, b2};
                if (l >= 1) { cb[fpad(FFTN - l)] = (f32x2v){b1, b3}; s0 += fabsf(b1); s1 += fabsf(b3); } else cb[fpad(8192)] = (f32x2v){0.f, 0.f};
                s0 += fabsf(b0); s1 += fabsf(b2);
            }
        }
        const float n0 = block_sum2(red, s0, tid, wave, lane, 2), n1 = block_sum2(red, s1, tid, wave, lane, 3);
        if (!(HYV & 1)) fft_fwd<false>(cb, tid);
        const float sc0 = 1.0f / (n0 * (float)FFTN), sc1 = 1.0f / (n1 * (float)FFTN);
#pragma unroll 2
        for (int i = 0; i < 16; ++i) {
            const int idx = tid + 512 * i, p = (idx >> 1) * 4 + (idx & 1), f = rev4_14(p), pp = rev4_14((FFTN - f) & (FFTN - 1));
            const f32x2v zf = cb[fpad(p)], zq = cb[fpad(pp)]; const f32x2v zc = (f32x2v){zq.x, -zq.y};
            const f32x2v sm = zf + zc, df = zf - zc;
            KA[idx] = sm * (0.5f * sc0); KB[idx] = (f32x2v){df.y, -df.x} * (0.5f * sc1);
            if (idx == 0) { const f32x2v z2 = cb[2]; KX[0] = z2.x * sc0; KX[1] = z2.y * sc1; }
        }
        __syncthreads();
    }
    const float kny0 = KX[0], kny1 = KX[1];
#pragma unroll
    for (int i = 0; i < 2; ++i) {
        const int t8 = (tid + 512 * i) * 8;
        const v4u a = *(const v4u*)(uz + NCTX + t8), b = *(const v4u*)(uz + NCTX + SEQ + t8);
        const unsigned av[4] = {a.x, a.y, a.z, a.w}, bv[4] = {b.x, b.y, b.z, b.w};
#pragma unroll
        for (int q = 0; q < 4; ++q) { cb[fpad(t8) + 2 * q] = (f32x2v){bflo(av[q]), bflo(bv[q])}; cb[fpad(t8) + 2 * q + 1] = (f32x2v){bfhi(av[q]), bfhi(bv[q])}; }
    }
    __syncthreads();
    if (!(HYV & 1)) fft_fwd<true>(cb, tid); spec_mul(cb, KA, kny0, tid); if (!(HYV & 1)) fft_inv<true>(cb, tid);
#pragma unroll
    for (int i = 0; i < 2; ++i) {
        const int t8 = (tid + 512 * i) * 8;
        const v4u a = *(const v4u*)(uz + NCTX + t8), b = *(const v4u*)(uz + NCTX + SEQ + t8), ga = *(const v4u*)(ug1 + NCTX + t8), gb = *(const v4u*)(ug1 + NCTX + SEQ + t8);
        const unsigned av[4] = {a.x, a.y, a.z, a.w}, bv[4] = {b.x, b.y, b.z, b.w}, gav[4] = {ga.x, ga.y, ga.z, ga.w}, gbv[4] = {gb.x, gb.y, gb.z, gb.w};
#pragma unroll
        for (int q = 0; q < 8; ++q) {
            const float z0 = (q & 1) ? bfhi(av[q >> 1]) : bflo(av[q >> 1]), z1 = (q & 1) ? bfhi(bv[q >> 1]) : bflo(bv[q >> 1]);
            const float g0 = (q & 1) ? bfhi(gav[q >> 1]) : bflo(gav[q >> 1]), g1 = (q & 1) ? bfhi(gbv[q >> 1]) : bflo(gbv[q >> 1]);
            const f32x2v cv = cb[fpad(t8) + q];
            const f32x2v y = (f32x2v){g0 * (cv.x + z0 * bias0), g1 * (cv.y + z1 * bias0)};
            cb[fpad(t8) + q] = y; ZS[t8 + q] = y;
        }
    }
    __syncthreads();
    if (!(HYV & 1)) fft_fwd<true>(cb, tid); spec_mul(cb, KB, kny1, tid); if (!(HYV & 1)) fft_inv<true>(cb, tid);
#pragma unroll
    for (int i = 0; i < 2; ++i) {
        const int t8 = (tid + 512 * i) * 8;
        const v4u ga = *(const v4u*)(ug2 + NCTX + t8), gb = *(const v4u*)(ug2 + NCTX + SEQ + t8);
        const unsigned gav[4] = {ga.x, ga.y, ga.z, ga.w}, gbv[4] = {gb.x, gb.y, gb.z, gb.w};
        float o0[8], o1[8];
#pragma unroll
        for (int q = 0; q < 8; ++q) {
            const float g0 = (q & 1) ? bfhi(gav[q >> 1]) : bflo(gav[q >> 1]), g1 = (q & 1) ? bfhi(gbv[q >> 1]) : bflo(gbv[q >> 1]);
            const f32x2v cv = cb[fpad(t8) + q], y1 = ZS[t8 + q];
            o0[q] = g0 * (cv.x + y1.x * bias1); o1[q] = g1 * (cv.y + y1.y * bias1);
        }
        v4u w0, w1; w0.x = pk2(o0[0], o0[1]); w0.y = pk2(o0[2], o0[3]); w0.z = pk2(o0[4], o0[5]); w0.w = pk2(o0[6], o0[7]);
        w1.x = pk2(o1[0], o1[1]); w1.y = pk2(o1[2], o1[3]); w1.z = pk2(o1[4], o1[5]); w1.w = pk2(o1[6], o1[7]);
        *(v4u*)(ho + NCTX + t8) = w0; *(v4u*)(ho + NCTX + SEQ + t8) = w1;
    }
    __syncthreads();
}
__device__ __forceinline__ void attn_unit(Frame& F, int unit) {
    const int qb = unit & 127, kvh = (unit >> 7) & 1, b = unit >> 8;
    PHASE_LOCALS
    const int w = wave, l = lane, g = l >> 4, c = l & 15;
    const int hq = w >> 1, th = w & 1, head = kvh * 4 + hq, q0 = qb * 64;
    LAS unsigned char* lds = F.lds;
    constexpr int O_KT = 0, O_VT = 17408;
    const bf16* Z = (const bf16*)(F.ws + WS_Z); bf16* MIX = (bf16*)(F.ws + WS_MIX);
    bf16x8 qf[2][4];
#pragma unroll
    for (int it = 0; it < 2; ++it)
#pragma unroll
        for (int ks = 0; ks < 4; ++ks) qf[it][ks] = *(const bf16x8*)(Z + (size_t)(NCTX + b * SEQ + q0 + 32 * th + 16 * it + c) * ODC + 3072 + head * 128 + 32 * ks + 8 * g);
    const float sink = F.in[26][head];
    float m_run[2] = {sink, sink}, l_run[2] = {1.f, 1.f};
    f32x4 Oa[8][2];
#pragma unroll
    for (int dt = 0; dt < 8; ++dt) { Oa[dt][0] = (f32x4){0.f, 0.f, 0.f, 0.f}; Oa[dt][1] = (f32x4){0.f, 0.f, 0.f, 0.f}; }
    v4u kvr[2], vvr[2];
#define ATTN_LOAD(kt_) do { _Pragma("unroll") for (int i = 0; i < 2; ++i) { \
            const int idx = tid + 512 * i, key = idx >> 4, chn = idx & 15; int row; bool valid = true; \
            if ((kt_) < 4) row = b * CTXL + 64 * (kt_) + key; \
            else { const int pos = q0 - 128 + 64 * ((kt_) - 4) + key; valid = pos >= 0 && pos < SEQ; row = NCTX + b * SEQ + pos; } \
            kvr[i] = (v4u){0u, 0u, 0u, 0u}; vvr[i] = (v4u){0u, 0u, 0u, 0u}; \
            if (valid) { const bf16* zr = Z + (size_t)row * ODC; kvr[i] = *(const v4u*)(zr + 4096 + kvh * 128 + chn * 8); vvr[i] = *(const v4u*)(zr + 4352 + kvh * 128 + chn * 8); } } } while (0)
    ATTN_LOAD(0);
    __syncthreads();
#pragma unroll 1
    for (int kt = 0; kt < 9; ++kt) {
        if (kt) LDS_BARRIER();
#pragma unroll
        for (int i = 0; i < 2; ++i) {
            const int idx = tid + 512 * i, key = idx >> 4, chn = idx & 15;
            *(LAS v4u*)(lds + O_KT + key * 272 + chn * 16) = kvr[i];
            *(LAS v4u*)(lds + O_VT + key * 272 + chn * 16) = vvr[i];
        }
        if (kt + 1 < 9) ATTN_LOAD(kt + 1);
        LDS_BARRIER();
        f32x4 sa[4][2];
#pragma unroll
        for (int jt = 0; jt < 4; ++jt) {
            sa[jt][0] = (f32x4){0.f, 0.f, 0.f, 0.f}; sa[jt][1] = (f32x4){0.f, 0.f, 0.f, 0.f};
#pragma unroll
            for (int ks = 0; ks < 4; ++ks) { const bf16x8 a = *(const LAS bf16x8*)(lds + O_KT + (16 * jt + c) * 272 + (32 * ks + 8 * g) * 2);
                sa[jt][0] = mfma_bf16(a, qf[0][ks], sa[jt][0]); sa[jt][1] = mfma_bf16(a, qf[1][ks], sa[jt][1]); }
        }
        if (kt >= 4) {
#pragma unroll
            for (int jt = 0; jt < 4; ++jt)
#pragma unroll
                for (int it = 0; it < 2; ++it)
#pragma unroll
                    for (int r = 0; r < 4; ++r) {
                        const int kpos = q0 - 128 + 64 * (kt - 4) + 16 * jt + 4 * g + r, qpos = q0 + 32 * th + 16 * it + c, d = qpos - kpos;
                        const bool ok = kpos >= 0 && kpos < SEQ && d <= 128 && d >= -128;
                        sa[jt][it][r] = ok ? sa[jt][it][r] : -1.0e30f;
                    }
        }
        bf16x8 P[2][2];
#pragma unroll
        for (int it = 0; it < 2; ++it) {
            float mx = -3.0e38f;
#pragma unroll
            for (int jt = 0; jt < 4; ++jt)
#pragma unroll
                for (int r = 0; r < 4; ++r) mx = fmaxf(mx, sa[jt][it][r]);
            mx = fmaxf(mx, __shfl_xor(mx, 16)); mx = fmaxf(mx, __shfl_xor(mx, 32));
            const float mn = fmaxf(m_run[it], mx), alpha = __expf(m_run[it] - mn);
            float rs = 0.f;
#pragma unroll
            for (int jt = 0; jt < 4; ++jt)
#pragma unroll
                for (int r = 0; r < 4; ++r) { const float p = __expf(sa[jt][it][r] - mn); sa[jt][it][r] = p; rs += p; }
            rs += __shfl_xor(rs, 16); rs += __shfl_xor(rs, 32);
            l_run[it] = l_run[it] * alpha + rs; m_run[it] = mn;
#pragma unroll
            for (int dt = 0; dt < 8; ++dt) Oa[dt][it] *= alpha;
#pragma unroll
            for (int p2 = 0; p2 < 2; ++p2) { v4u t4; t4.x = cvt_pk(sa[2 * p2][it][0], sa[2 * p2][it][1]); t4.y = cvt_pk(sa[2 * p2][it][2], sa[2 * p2][it][3]);
                t4.z = cvt_pk(sa[2 * p2 + 1][it][0], sa[2 * p2 + 1][it][1]); t4.w = cvt_pk(sa[2 * p2 + 1][it][2], sa[2 * p2 + 1][it][3]); P[p2][it] = __builtin_bit_cast(bf16x8, t4); }
        }
#pragma unroll
        for (int dt = 0; dt < 8; ++dt)
#pragma unroll
            for (int p2 = 0; p2 < 2; ++p2) {
                const trv4 lo4 = __builtin_amdgcn_ds_read_tr16_b64_v4i16((LAS trv4*)(lds + O_VT + (32 * p2 + 4 * g + (c >> 2)) * 272 + (16 * dt + 4 * (c & 3)) * 2));
                const trv4 hi4 = __builtin_amdgcn_ds_read_tr16_b64_v4i16((LAS trv4*)(lds + O_VT + (32 * p2 + 16 + 4 * g + (c >> 2)) * 272 + (16 * dt + 4 * (c & 3)) * 2));
                const v2u lo = __builtin_bit_cast(v2u, lo4), hi = __builtin_bit_cast(v2u, hi4);
                v4u a4; a4.x = lo.x; a4.y = lo.y; a4.z = hi.x; a4.w = hi.y; const bf16x8 a = __builtin_bit_cast(bf16x8, a4);
                Oa[dt][0] = mfma_bf16(a, P[p2][0], Oa[dt][0]); Oa[dt][1] = mfma_bf16(a, P[p2][1], Oa[dt][1]);
            }
    }
#pragma unroll
    for (int it = 0; it < 2; ++it) {
        const float inv = 1.0f / l_run[it];
        bf16* orow = MIX + (size_t)(NCTX + b * SEQ + q0 + 32 * th + 16 * it + c) * DM + 1024 + head * 128 + 4 * g;
#pragma unroll
        for (int dt = 0; dt < 8; ++dt) { const f32x4 o = Oa[dt][it] * inv; v2u wv; wv.x = cvt_pk(o[0], o[1]); wv.y = cvt_pk(o[2], o[3]); *(v2u*)(orow + 16 * dt) = wv; }
    }
#undef ATTN_LOAD
    __syncthreads();
}
constexpr int N_PHASES = 25;
constexpr int QSLOT_OFF = LDSCTL_OFF + 256;

__global__ void __launch_bounds__(NTHR, 2) mk_fwd(Args args) {
    extern __shared__ __attribute__((aligned(16))) unsigned char lds_raw[];
    Frame F;
    F.lds = (LAS unsigned char*)lds_raw;
    F.G = gridDim.x; F.bx = blockIdx.x; F.NGW = F.G * NWAVES;
    F.in = (const float* const __attribute__((address_space(4)))*)__builtin_amdgcn_kernarg_segment_ptr();
    F.out = args.out; F.ws = args.ws;
    for (int u = threadIdx.x; u < (LDS_BYTES - LDSCTL_OFF) / 4; u += NTHR) ((LAS unsigned*)(F.lds + LDSCTL_OFF))[u] = 0u;
    __syncthreads();
    const int lo = args.ph_lo, hi = args.ph_hi;
    XcdBarrier bar; bar.bar = (unsigned*)(F.ws + WS_CTL) + CW_BAR; bar.x = 0; bar.st = nullptr;
    if (hi - lo > 1) bar = xcd_barrier_post((unsigned*)(F.ws + WS_CTL) + CW_BAR, (volatile LAS unsigned*)(F.lds + MISC_OFF) + 8);
#ifndef PHASE_ENABLE
#define PHASE_ENABLE 0xFFFFFFFFu
#endif
#ifndef DUP_SITE
#define DUP_SITE -1
#endif
#ifndef DUP_LAYER
#define DUP_LAYER 0
#endif
#define TAILCONV 1
#ifndef DUP_HYV
#define DUP_HYV 0
#endif
#ifndef DUP_MIX_EN
#define DUP_MIX_EN 15
#endif
#ifndef MIX_EN
#define MIX_EN 31
#endif
#define EN(s) (((PHASE_ENABLE) >> (s)) & 1u)
#define IN(k) (lo <= (k) && (k) < hi)
#define SEAM(k) do { if (IN(k) && IN((k) + 1)) { xcd_barrier(bar); if (DUP_SITE == 99) xcd_barrier(bar); } } while (0)
    unsigned char* ws = F.ws;
    float* X = (float*)(ws + WS_X); bf16* H = (bf16*)(ws + WS_H); bf16* Zb = (bf16*)(ws + WS_Z); bf16* MIX = (bf16*)(ws + WS_MIX); bf16* ACT = (bf16*)(ws + WS_ACT);
    const float* mod = (const float*)(ws + WS_MOD);
    const LAS int* toff = (const LAS int*)(F.lds + TOFF_OFF);

    if (EN(0) && IN(0)) phase_pre(F);
    if (DUP_SITE == 0) { xcd_barrier(bar); phase_pre(F); }
    SEAM(0);
    if (EN(1) && IN(1)) phase_modfin(F);
    SEAM(1);
    {
        constexpr int layer = 0;
        const int pb = 2 + 11 * layer;
#define SITE_NORM if (EN(2) && IN(pb)) { if (layer == 0) { route_fold(F); phase_norm<0>(F, 0); } else phase_norm<1>(F, 1); }
        SITE_NORM
#if DUP_SITE == 2
        if (DUP_LAYER == layer) { xcd_barrier(bar); SITE_NORM }
#endif
        SEAM(pb);
#define SITE_GIN if (EN(3) && IN(pb + 1)) { \
            const int N = layer ? ODC : EVN; \
            pg8::Gemm g{H, (const bf16*)(ws + (layer ? WS_WIN1 : WS_WIN0)), NROW, N, DM}; pg8::StaticOrder S; S.init(NROW, N, F.G, F.bx); \
            pg8::EpiStore E{Zb, layer ? ODC : ZC0, 0x7fffffff, layer ? 18 : 24, (float*)(ws + WS_LR)}; \
            pg8::gemm_phase<pg8::EpiStore, pg8::StaticOrder, true, true>(F.lds, g, S, E); \
              \
            if (layer == 0 && TAILCONV && F.G == 256 && F.bx >= 114) conv_unit<8>(F, 0, F.bx - 114); }
        SITE_GIN
#if DUP_SITE == 3
        if (DUP_LAYER == layer) { xcd_barrier(bar); SITE_GIN }
#endif
        SEAM(pb + 1);
#define SITE_PREMIX(REP_) if (EN(4) && IN(pb + 2)) { if (layer == 0) { phase_ht(F); __syncthreads(); \
                if ((REP_) == 0) { PreRegs PR; __syncthreads(); prepass_load<true>(F, F.bx, threadIdx.x, PR); for (int pu = F.bx; pu < 2112; pu += F.G) prepass_unit<true>(F, pu, pu + F.G, PR); __syncthreads(); }     \
                  \
                pg8::Gemm g{(const bf16*)(ws + WS_W3S), (const bf16*)(ws + WS_HDS), 4096, 8192, 256}; pg8::StaticOrder S; S.init(4096, 8192, F.G, F.bx); \
                pg8::EpiFilt E{ws}; \
                pg8::gemm_phase<pg8::EpiFilt, pg8::StaticOrder, true, true>(F.lds, g, S, E); } \
            else phase_prep(F, REP_); }
        SITE_PREMIX(0)
#if DUP_SITE == 4
        if (DUP_LAYER == layer) { xcd_barrier(bar); SITE_PREMIX(1) }
#endif
        SEAM(pb + 2);
#define SITE_PREPASS if (EN(13) && IN(pb + 3)) { \
            if (layer != 0) { PreRegs PR; __syncthreads(); prepass_load<false>(F, F.bx, threadIdx.x, PR); for (int pu = F.bx; pu < 2112; pu += F.G) prepass_unit<false>(F, pu, pu + F.G, PR); __syncthreads(); } }
        SITE_PREPASS
#if DUP_SITE == 13
        if (DUP_LAYER == layer) { xcd_barrier(bar); SITE_PREPASS }
#endif
        if (layer != 0) SEAM(pb + 3);
#define SITE_MIXER(REP_, MEN_, HYV_) if (EN(5) && IN(pb + 4)) { \
            unsigned* qhead = (unsigned*)(ws + WS_CTL) + (layer == 0 ? CW_HYQ : CW_ATQ) + 16 * (REP_); \
            const int nunits = layer == 0 ? 2048 : 512 + 1536; \
            for (int u = F.bx; u < 64; u += F.G) { __syncthreads(); if (layer == 0) { if ((MEN_) & 1) scan_unit<true, ((HYV_) & 8) != 0, ((HYV_) & 16) != 0, ((HYV_) & 32) != 0>(F, u); } else { if ((MEN_) & 2) scan_unit<false, ((HYV_) & 8) != 0, ((HYV_) & 16) != 0, ((HYV_) & 32) != 0>(F, u); } } \
            for (;;) { \
                __syncthreads(); \
                if (threadIdx.x == 0) *(LAS int*)(F.lds + QSLOT_OFF) = (int)__hip_atomic_fetch_add(qhead, 1u, __ATOMIC_RELAXED, __HIP_MEMORY_SCOPE_AGENT); \
                __syncthreads(); \
                const int u = *(LAS int*)(F.lds + QSLOT_OFF); \
                if (u >= nunits) break; \
                if (layer == 0) { if ((MEN_) & 4) { if (u < 1024) hyena_unit<HYV_, 1>(F, u); else hyena_unit<HYV_, 2>(F, u - 1024); } } else if (u < 512) { if ((MEN_) & 8) attn_unit(F, u); } else { if ((MEN_) & 16) conv_unit<2>(F, 1, u - 512); } \
            } \
            __syncthreads(); }
        SITE_MIXER(0, MIX_EN, 0)
#if DUP_SITE == 5
        if (DUP_LAYER == layer) { xcd_barrier(bar); SITE_MIXER(1, DUP_MIX_EN, DUP_HYV) }
#endif
        SEAM(pb + 4);
#define SITE_MERGE if (EN(6) && IN(pb + 5)) { \
            if (layer == 0) { merge_heads(F, F.in[12], ZC0, 0); __syncthreads(); merge_hyena(F); } \
            else merge_heads(F, F.in[23], ODC, NCTX); }
        SITE_MERGE
#if DUP_SITE == 6
        if (DUP_LAYER == layer) { xcd_barrier(bar); SITE_MERGE }
#endif
        SEAM(pb + 5);
#define SITE_GOUT(XP_) if (EN(7) && IN(pb + 6)) { \
            const int row_off = layer ? NCTX : 0, M = NROW - row_off; \
            pg8::Gemm g{MIX + (size_t)row_off * DM, (const bf16*)(ws + (layer ? WS_WOUT1 : WS_WOUT0)), M, DM, DM}; pg8::StaticOrder S; S.init(M, DM, F.G, F.bx); \
            const float* gb = mod + (size_t)layer * 3 * 12288 + 2 * DM; \
            pg8::EpiOut E{XP_, row_off, gb, layer == 0 ? F.in[2] : nullptr, layer == 0 ? F.in[0] : nullptr}; \
            pg8::gemm_phase<pg8::EpiOut, pg8::StaticOrder, true, true>(F.lds, g, S, E); \
              \
            if (layer == 0 && TAILCONV && F.G == 256 && F.bx >= 16) { conv_unit<8>(F, 0, 142 + F.bx - 16); if (F.bx < 18) conv_unit<8>(F, 0, 382 + F.bx - 16); } }
        SITE_GOUT(X)
#if DUP_SITE == 7
        if (DUP_LAYER == layer) { xcd_barrier(bar); SITE_GOUT((float*)(ws + WS_Z)) }
#endif
        SEAM(pb + 6);
        if (EN(8) && IN(pb + 7)) phase_route(F, layer);
#if DUP_SITE == 8
        if (DUP_LAYER == layer) { xcd_barrier(bar); phase_route(F, layer, 1); }
#endif
        SEAM(pb + 7);
#define SITE_GATHER if (EN(9) && IN(pb + 8)) phase_gather(F, layer);
        SITE_GATHER
#if DUP_SITE == 9
        if (DUP_LAYER == layer) { xcd_barrier(bar); SITE_GATHER }
#endif
        SEAM(pb + 8);
#define SITE_MOE1 if (EN(10) && IN(pb + 9)) { \
            moe_offsets(F, layer); \
            pg8::Gemm g{Zb, (const bf16*)(ws + WS_WM13) + (size_t)layer * 16 * 2048 * DM, 0, 0, DM}; \
            pg8::MoeOrder S{F.G, F.bx, __builtin_amdgcn_readfirstlane(toff[16]), toff}; pg8::EpiMoe1 E{ACT}; \
            pg8::gemm_phase<pg8::EpiMoe1, pg8::MoeOrder, true, true>(F.lds, g, S, E); }
        SITE_MOE1
#if DUP_SITE == 10
        if (DUP_LAYER == layer) { xcd_barrier(bar); SITE_MOE1 }
#endif
        SEAM(pb + 9);
#define SITE_MOE2 if (EN(11) && IN(pb + 10)) { \
            moe_offsets(F, layer); \
            pg8::Gemm g{ACT, (const bf16*)(ws + WS_WM2) + (size_t)layer * 16 * 2048 * DFF, 0, 0, DFF}; \
            pg8::MoeOrder S{F.G, F.bx, __builtin_amdgcn_readfirstlane(toff[16]), toff}; pg8::EpiStore E{(bf16*)(ws + WS_W), DM, 7, 8, nullptr}; \
            pg8::gemm_phase<pg8::EpiStore, pg8::MoeOrder, true, true>(F.lds, g, S, E); }
        SITE_MOE2
#if DUP_SITE == 11
        if (DUP_LAYER == layer) { xcd_barrier(bar); SITE_MOE2 }
#endif
        SEAM(pb + 10);
#undef SITE_NORM
#undef SITE_GIN
#undef SITE_PREMIX
#undef SITE_PREPASS
#undef SITE_MIXER
#undef SITE_MERGE
#undef SITE_GATHER
#undef SITE_GOUT
#undef SITE_MOE1
#undef SITE_MOE2
    }
    {
        constexpr int layer = 1;
        const int pb = 2 + 11 * layer;
#define SITE_NORM if (EN(2) && IN(pb)) { if (layer == 0) { route_fold(F); phase_norm<0>(F, 0); } else phase_norm<1>(F, 1); }
        SITE_NORM
#if DUP_SITE == 2
        if (DUP_LAYER == layer) { xcd_barrier(bar); SITE_NORM }
#endif
        SEAM(pb);
#define SITE_GIN if (EN(3) && IN(pb + 1)) { \
            const int N = layer ? ODC : EVN; \
            pg8::Gemm g{H, (const bf16*)(ws + (layer ? WS_WIN1 : WS_WIN0)), NROW, N, DM}; pg8::StaticOrder S; S.init(NROW, N, F.G, F.bx); \
            pg8::EpiStore E{Zb, layer ? ODC : ZC0, 0x7fffffff, layer ? 18 : 24, (float*)(ws + WS_LR)}; \
            pg8::gemm_phase<pg8::EpiStore, pg8::StaticOrder, true, true>(F.lds, g, S, E); \
              \
            if (layer == 0 && TAILCONV && F.G == 256 && F.bx >= 114) conv_unit<8>(F, 0, F.bx - 114); }
        SITE_GIN
#if DUP_SITE == 3
        if (DUP_LAYER == layer) { xcd_barrier(bar); SITE_GIN }
#endif
        SEAM(pb + 1);
#define SITE_PREMIX(REP_) if (EN(4) && IN(pb + 2)) { if (layer == 0) { phase_ht(F); __syncthreads(); \
                if ((REP_) == 0) { PreRegs PR; __syncthreads(); prepass_load<true>(F, F.bx, threadIdx.x, PR); for (int pu = F.bx; pu < 2112; pu += F.G) prepass_unit<true>(F, pu, pu + F.G, PR); __syncthreads(); }     \
                  \
                pg8::Gemm g{(const bf16*)(ws + WS_W3S), (const bf16*)(ws + WS_HDS), 4096, 8192, 256}; pg8::StaticOrder S; S.init(4096, 8192, F.G, F.bx); \
                pg8::EpiFilt E{ws}; \
                pg8::gemm_phase<pg8::EpiFilt, pg8::StaticOrder, true, true>(F.lds, g, S, E); } \
            else phase_prep(F, REP_); }
        SITE_PREMIX(0)
#if DUP_SITE == 4
        if (DUP_LAYER == layer) { xcd_barrier(bar); SITE_PREMIX(1) }
#endif
        SEAM(pb + 2);
#define SITE_PREPASS if (EN(13) && IN(pb + 3)) { \
            if (layer != 0) { PreRegs PR; __syncthreads(); prepass_load<false>(F, F.bx, threadIdx.x, PR); for (int pu = F.bx; pu < 2112; pu += F.G) prepass_unit<false>(F, pu, pu + F.G, PR); __syncthreads(); } }
        SITE_PREPASS
#if DUP_SITE == 13
        if (DUP_LAYER == layer) { xcd_barrier(bar); SITE_PREPASS }
#endif
        if (layer != 0) SEAM(pb + 3);
#define SITE_MIXER(REP_, MEN_, HYV_) if (EN(5) && IN(pb + 4)) { \
            unsigned* qhead = (unsigned*)(ws + WS_CTL) + (layer == 0 ? CW_HYQ : CW_ATQ) + 16 * (REP_); \
            const int nunits = layer == 0 ? 2048 : 512 + 1536; \
            for (int u = F.bx; u < 64; u += F.G) { __syncthreads(); if (layer == 0) { if ((MEN_) & 1) scan_unit<true, ((HYV_) & 8) != 0, ((HYV_) & 16) != 0, ((HYV_) & 32) != 0>(F, u); } else { if ((MEN_) & 2) scan_unit<false, ((HYV_) & 8) != 0, ((HYV_) & 16) != 0, ((HYV_) & 32) != 0>(F, u); } } \
            for (;;) { \
                __syncthreads(); \
                if (threadIdx.x == 0) *(LAS int*)(F.lds + QSLOT_OFF) = (int)__hip_atomic_fetch_add(qhead, 1u, __ATOMIC_RELAXED, __HIP_MEMORY_SCOPE_AGENT); \
                __syncthreads(); \
                const int u = *(LAS int*)(F.lds + QSLOT_OFF); \
                if (u >= nunits) break; \
                if (layer == 0) { if ((MEN_) & 4) { if (u < 1024) hyena_unit<HYV_, 1>(F, u); else hyena_unit<HYV_, 2>(F, u - 1024); } } else if (u < 512) { if ((MEN_) & 8) attn_unit(F, u); } else { if ((MEN_) & 16) conv_unit<2>(F, 1, u - 512); } \
            } \
            __syncthreads(); }
        SITE_MIXER(0, MIX_EN, 0)
#if DUP_SITE == 5
        if (DUP_LAYER == layer) { xcd_barrier(bar); SITE_MIXER(1, DUP_MIX_EN, DUP_HYV) }
#endif
        SEAM(pb + 4);
#define SITE_MERGE if (EN(6) && IN(pb + 5)) { \
            if (layer == 0) { merge_heads(F, F.in[12], ZC0, 0); __syncthreads(); merge_hyena(F); } \
            else merge_heads(F, F.in[23], ODC, NCTX); }
        SITE_MERGE
#if DUP_SITE == 6
        if (DUP_LAYER == layer) { xcd_barrier(bar); SITE_MERGE }
#endif
        SEAM(pb + 5);
#define SITE_GOUT(XP_) if (EN(7) && IN(pb + 6)) { \
            const int row_off = layer ? NCTX : 0, M = NROW - row_off; \
            pg8::Gemm g{MIX + (size_t)row_off * DM, (const bf16*)(ws + (layer ? WS_WOUT1 : WS_WOUT0)), M, DM, DM}; pg8::StaticOrder S; S.init(M, DM, F.G, F.bx); \
            const float* gb = mod + (size_t)layer * 3 * 12288 + 2 * DM; \
            pg8::EpiOut E{XP_, row_off, gb, layer == 0 ? F.in[2] : nullptr, layer == 0 ? F.in[0] : nullptr}; \
            pg8::gemm_phase<pg8::EpiOut, pg8::StaticOrder, true, true>(F.lds, g, S, E); \
              \
            if (layer == 0 && TAILCONV && F.G == 256 && F.bx >= 16) { conv_unit<8>(F, 0, 142 + F.bx - 16); if (F.bx < 18) conv_unit<8>(F, 0, 382 + F.bx - 16); } }
        SITE_GOUT(X)
#if DUP_SITE == 7
        if (DUP_LAYER == layer) { xcd_barrier(bar); SITE_GOUT((float*)(ws + WS_Z)) }
#endif
        SEAM(pb + 6);
        if (EN(8) && IN(pb + 7)) phase_route(F, layer);
#if DUP_SITE == 8
        if (DUP_LAYER == layer) { xcd_barrier(bar); phase_route(F, layer, 1); }
#endif
        SEAM(pb + 7);
#define SITE_GATHER if (EN(9) && IN(pb + 8)) phase_gather(F, layer);
        SITE_GATHER
#if DUP_SITE == 9
        if (DUP_LAYER == layer) { xcd_barrier(bar); SITE_GATHER }
#endif
        SEAM(pb + 8);
#define SITE_MOE1 if (EN(10) && IN(pb + 9)) { \
            moe_offsets(F, layer); \
            pg8::Gemm g{Zb, (const bf16*)(ws + WS_WM13) + (size_t)layer * 16 * 2048 * DM, 0, 0, DM}; \
            pg8::MoeOrder S{F.G, F.bx, __builtin_amdgcn_readfirstlane(toff[16]), toff}; pg8::EpiMoe1 E{ACT}; \
            pg8::gemm_phase<pg8::EpiMoe1, pg8::MoeOrder, true, true>(F.lds, g, S, E); }
        SITE_MOE1
#if DUP_SITE == 10
        if (DUP_LAYER == layer) { xcd_barrier(bar); SITE_MOE1 }
#endif
        SEAM(pb + 9);
#define SITE_MOE2 if (EN(11) && IN(pb + 10)) { \
            moe_offsets(F, layer); \
            pg8::Gemm g{ACT, (const bf16*)(ws + WS_WM2) + (size_t)layer * 16 * 2048 * DFF, 0, 0, DFF}; \
            pg8::MoeOrder S{F.G, F.bx, __builtin_amdgcn_readfirstlane(toff[16]), toff}; pg8::EpiStore E{(bf16*)(ws + WS_W), DM, 7, 8, nullptr}; \
            pg8::gemm_phase<pg8::EpiStore, pg8::MoeOrder, true, true>(F.lds, g, S, E); }
        SITE_MOE2
#if DUP_SITE == 11
        if (DUP_LAYER == layer) { xcd_barrier(bar); SITE_MOE2 }
#endif
        SEAM(pb + 10);
#undef SITE_NORM
#undef SITE_GIN
#undef SITE_PREMIX
#undef SITE_PREPASS
#undef SITE_MIXER
#undef SITE_MERGE
#undef SITE_GATHER
#undef SITE_GOUT
#undef SITE_MOE1
#undef SITE_MOE2
    }
    if (EN(12) && IN(24)) phase_norm<2>(F, 1);
#undef IN
#undef SEAM
}

extern "C" void kernel_launch(void* const* d_in, const int* in_sizes, int n_in, void* d_out, int out_size, void* d_ws, size_t ws_size, hipStream_t stream) {
    static int grid = 0;
    if (grid == 0) {
        if (n_in != 32 || out_size != NLAT * DM || ws_size < WS_END) { fprintf(stderr, "kernel_launch: unexpected shapes (n_in %d, out %d, ws %zu < %zu)\n", n_in, out_size, ws_size, (size_t)WS_END); grid = -1; return; }
        int dev = 0, cus = 0;
        if (hipGetDevice(&dev) != hipSuccess || hipDeviceGetAttribute(&cus, hipDeviceAttributeMultiprocessorCount, dev) != hipSuccess) { grid = -1; return; }
        if (hipFuncSetAttribute((const void*)mk_fwd, hipFuncAttributeMaxDynamicSharedMemorySize, LDS_BYTES) != hipSuccess) { fprintf(stderr, "kernel_launch: hipFuncSetAttribute failed\n"); grid = -1; return; }
        int per_cu = 0;
        if (hipOccupancyMaxActiveBlocksPerMultiprocessor(&per_cu, (const void*)mk_fwd, NTHR, LDS_BYTES) != hipSuccess || per_cu < 1) { fprintf(stderr, "kernel_launch: occupancy query says %d\n", per_cu); }
        (void)hipGetLastError();
        grid = cus;
    }
    if (grid < 0) return;
    if (hipMemsetAsync((char*)d_ws + WS_CTL, 0, CTL_ZERO_BYTES, stream) != hipSuccess) return;
    Args a{};
    for (int i = 0; i < 32; ++i) a.in[i] = (const float*)d_in[i];
    a.out = (float*)d_out; a.ws = (unsigned char*)d_ws;
#if MK_ONE_LAUNCH
    a.ph_lo = 0; a.ph_hi = N_PHASES;
    hipLaunchKernelGGL(mk_fwd, dim3(grid), dim3(NTHR), LDS_BYTES, stream, a);
#else
    for (int p = 0; p < N_PHASES; ++p) { a.ph_lo = p; a.ph_hi = p + 1; hipLaunchKernelGGL(mk_fwd, dim3(grid), dim3(NTHR), LDS_BYTES, stream, a); }
#endif
}
```
